# Optimizing an MI355X kernel written in HIP

```python
import math
import jax, jax.numpy as jnp
from jax import lax
import numpy as np

D_MODEL = 1024
BATCH = 4
SEQ = 8192
DEPTH = 1

POOL_WIDTH = D_MODEL // 2
POOL_WINDOWS = (2, 4, 8, 16)
POOL_GROUPS = len(POOL_WINDOWS)
POOL_GROUP_DIM = POOL_WIDTH // POOL_GROUPS
SSM_WIDTH = D_MODEL // 2
SSM_GROUP_DIM = 16
SSM_GROUPS = SSM_WIDTH // SSM_GROUP_DIM
SSM_STATE = 64
N_BRANCHES = 2
IN_WIDTH = POOL_WIDTH + SSM_WIDTH + N_BRANCHES * D_MODEL
MEM_LEN = 256
X_HEADS = 4
X_HEAD_DIM = D_MODEL // X_HEADS
N_EXPERT_GROUPS = 4
EXPERTS_PER_GROUP = 4
N_EXPERTS = N_EXPERT_GROUPS * EXPERTS_PER_GROUP
TOP_K_IN_GROUP = 2
D_EXPERT = 512
RMS_EPS = 1e-6
DT_MIN = 1e-3
DT_MAX = 1e-1

kernel_name = "hybrid_pool_s5_xattn_hmoe"


def rms_norm(x, g):
    xf = x.astype(jnp.float32)
    y = xf * lax.rsqrt(jnp.mean(xf * xf, axis=-1, keepdims=True) + RMS_EPS)
    return (y * g.astype(jnp.float32)).astype(x.dtype)


def pool_mixer(z, pool_w, pool_scale):
    b, s, _ = z.shape
    zf = z.astype(jnp.float32).reshape(b, s, POOL_GROUPS, POOL_GROUP_DIM)
    cs = jnp.cumsum(zf, axis=1)
    pos = jnp.arange(1, s + 1, dtype=jnp.float32)
    pooled = []
    for gi, w in enumerate(POOL_WINDOWS):
        c = cs[:, :, gi]
        lag = jnp.pad(c, ((0, 0), (w, 0), (0, 0)))[:, :s]
        cnt = jnp.minimum(pos, float(w))[:, None]
        pooled.append((c - lag) / cnt)
    pooled = jnp.stack(pooled, axis=2)
    mixed = jnp.einsum('bsgc,gcd->bsgd', pooled - zf, pool_w.astype(jnp.float32))
    out = mixed.reshape(b, s, POOL_WIDTH) * pool_scale.astype(jnp.float32)
    return out.astype(z.dtype)


def s5_ssm(v, a_re, a_im, log_dt, b_re, b_im, c_re, c_im, d_skip):
    bsz, s, _ = v.shape
    f32 = jnp.float32
    vf = v.astype(f32).reshape(bsz, s, SSM_GROUPS, SSM_GROUP_DIM)
    ar, ai = a_re.astype(f32), a_im.astype(f32)
    dt = jnp.exp(log_dt.astype(f32))[:, None]
    mag = jnp.exp(ar * dt)
    lb_re, lb_im = mag * jnp.cos(ai * dt), mag * jnp.sin(ai * dt)
    den = ar * ar + ai * ai
    nr, ni = lb_re - 1.0, lb_im
    f_re = ((nr * ar + ni * ai) / den)[..., None]
    f_im = ((ni * ar - nr * ai) / den)[..., None]
    br, bi = b_re.astype(f32), b_im.astype(f32)
    bb_re = f_re * br - f_im * bi
    bb_im = f_re * bi + f_im * br
    u_re = jnp.einsum('bsgc,gnc->sbgn', vf, bb_re)
    u_im = jnp.einsum('bsgc,gnc->sbgn', vf, bb_im)
    a_re_s = jnp.broadcast_to(lb_re, (s, 1, SSM_GROUPS, SSM_STATE))
    a_im_s = jnp.broadcast_to(lb_im, (s, 1, SSM_GROUPS, SSM_STATE))

    def combine(e1, e2):
        a1r, a1i, b1r, b1i = e1
        a2r, a2i, b2r, b2i = e2
        return (a1r * a2r - a1i * a2i,
                a1r * a2i + a1i * a2r,
                a2r * b1r - a2i * b1i + b2r,
                a2r * b1i + a2i * b1r + b2i)

    _, _, h_re, h_im = lax.associative_scan(combine, (a_re_s, a_im_s, u_re, u_im), axis=0)
    y = (jnp.einsum('sbgn,gcn->bsgc', h_re, c_re.astype(f32))
         - jnp.einsum('sbgn,gcn->bsgc', h_im, c_im.astype(f32)))
    y = y + d_skip.astype(f32).reshape(SSM_GROUPS, SSM_GROUP_DIM) * vf
    return y.reshape(bsz, s, SSM_WIDTH)


def memory_cross_attention(hn, memn, w_q, w_kv, w_o):
    b, s, _ = hn.shape
    m = memn.shape[1]
    q = (hn @ w_q).reshape(b, s, X_HEADS, X_HEAD_DIM)
    kv = memn @ w_kv
    k = kv[..., :D_MODEL].reshape(b, m, X_HEADS, X_HEAD_DIM)
    v = kv[..., D_MODEL:].reshape(b, m, X_HEADS, X_HEAD_DIM)
    scores = jnp.einsum('bshd,bmhd->bhsm', q.astype(jnp.float32), k.astype(jnp.float32)) * (X_HEAD_DIM ** -0.5)
    p = jax.nn.softmax(scores, axis=-1).astype(v.dtype)
    o = jnp.einsum('bhsm,bmhd->bshd', p, v).reshape(b, s, D_MODEL)
    return o @ w_o


def hierarchical_moe(zn, rg_w, rg_b, re_w, re_b, w1, w3, w2):
    b, s, d = zn.shape
    z = zn.reshape(b * s, d)
    f32 = jnp.float32
    g_logits = (z @ rg_w).astype(f32) + rg_b.astype(f32)
    g_prob = jax.nn.softmax(g_logits, axis=-1)
    g_idx = jnp.argmax(g_logits, axis=-1)
    g_gate = jnp.take_along_axis(g_prob, g_idx[:, None], axis=1)
    e_logits = jnp.einsum('td,dge->tge', z, re_w).astype(f32) + re_b.astype(f32)
    e_sel = jnp.take_along_axis(e_logits, g_idx[:, None, None], axis=1)[:, 0]
    top_v, top_i = lax.top_k(e_sel, TOP_K_IN_GROUP)
    top_w = jax.nn.softmax(top_v, axis=-1)
    e_w = jnp.sum(jax.nn.one_hot(top_i, EXPERTS_PER_GROUP, dtype=f32) * top_w[..., None], axis=1)
    comb = (jax.nn.one_hot(g_idx, N_EXPERT_GROUPS, dtype=f32)[:, :, None]
            * e_w[:, None, :] * g_gate[:, :, None]).reshape(-1, N_EXPERTS).astype(z.dtype)
    out = jnp.zeros_like(z)
    for e in range(N_EXPERTS):
        hid = jax.nn.silu(z @ w1[e]) * (z @ w3[e])
        out = out + comb[:, e:e + 1] * (hid @ w2[e])
    return out.reshape(b, s, d)


def setup_inputs(seed: int = 0) -> dict:
    key = jax.random.key(seed)
    ks = jax.random.split(key, 32)
    f32 = jnp.float32
    L, D = DEPTH, D_MODEL

    def nrm(k, shape, scale):
        return jax.random.normal(k, shape, f32) * scale

    def gain(k, shape):
        return 1.0 + 0.05 * jax.random.normal(k, shape, f32)

    n_idx = jnp.arange(SSM_STATE, dtype=f32)
    return {
        "x": jax.random.normal(ks[0], (BATCH, SEQ, D), f32),
        "mem": jax.random.normal(ks[1], (BATCH, MEM_LEN, D), f32),
        "norm_mix": gain(ks[2], (L, D)),
        "w_in": nrm(ks[3], (L, D, IN_WIDTH), D ** -0.5),
        "pool_w": nrm(ks[4], (L, POOL_GROUPS, POOL_GROUP_DIM, POOL_GROUP_DIM), POOL_GROUP_DIM ** -0.5),
        "pool_scale": gain(ks[5], (L, POOL_WIDTH)),
        "ssm_a_re": -0.5 + 0.01 * jax.random.normal(ks[6], (L, SSM_GROUPS, SSM_STATE), f32),
        "ssm_a_im": math.pi * n_idx + 0.01 * jax.random.normal(ks[7], (L, SSM_GROUPS, SSM_STATE), f32),
        "ssm_log_dt": jax.random.uniform(ks[8], (L, SSM_GROUPS), f32, math.log(DT_MIN), math.log(DT_MAX)),
        "ssm_b_re": nrm(ks[9], (L, SSM_GROUPS, SSM_STATE, SSM_GROUP_DIM), (2 * SSM_GROUP_DIM) ** -0.5),
        "ssm_b_im": nrm(ks[10], (L, SSM_GROUPS, SSM_STATE, SSM_GROUP_DIM), (2 * SSM_GROUP_DIM) ** -0.5),
        "ssm_c_re": nrm(ks[11], (L, SSM_GROUPS, SSM_GROUP_DIM, SSM_STATE), SSM_STATE ** -0.5),
        "ssm_c_im": nrm(ks[12], (L, SSM_GROUPS, SSM_GROUP_DIM, SSM_STATE), SSM_STATE ** -0.5),
        "ssm_d": nrm(ks[13], (L, SSM_WIDTH), 1.0),
        "glu_w": nrm(ks[14], (L, SSM_WIDTH, SSM_WIDTH), SSM_WIDTH ** -0.5),
        "glu_b": nrm(ks[15], (L, SSM_WIDTH), 0.02),
        "br_pool": nrm(ks[16], (L, POOL_WIDTH, D), POOL_WIDTH ** -0.5),
        "br_ssm": nrm(ks[17], (L, SSM_WIDTH, D), SSM_WIDTH ** -0.5),
        "w_out": nrm(ks[18], (L, D, D), D ** -0.5),
        "norm_x": gain(ks[19], (L, D)),
        "norm_mem": gain(ks[20], (L, D)),
        "x_wq": nrm(ks[21], (L, D, D), D ** -0.5),
        "x_wkv": nrm(ks[22], (L, D, 2 * D), D ** -0.5),
        "x_wo": nrm(ks[23], (L, D, D), D ** -0.5),
        "norm_ffn": gain(ks[24], (L, D)),
        "router_g_w": nrm(ks[25], (L, D, N_EXPERT_GROUPS), D ** -0.5),
        "router_g_b": nrm(ks[26], (L, N_EXPERT_GROUPS), 0.01),
        "router_e_w": nrm(ks[27], (L, D, N_EXPERT_GROUPS, EXPERTS_PER_GROUP), D ** -0.5),
        "router_e_b": nrm(ks[28], (L, N_EXPERT_GROUPS, EXPERTS_PER_GROUP), 0.01),
        "exp_w1": nrm(ks[29], (L, N_EXPERTS, D, D_EXPERT), D ** -0.5),
        "exp_w3": nrm(ks[30], (L, N_EXPERTS, D, D_EXPERT), D ** -0.5),
        "exp_w2": nrm(ks[31], (L, N_EXPERTS, D_EXPERT, D), D_EXPERT ** -0.5),
        "norm_final": gain(jax.random.fold_in(key, 99), (D,)),
    }


def reference(x, mem, norm_mix, w_in, pool_w, pool_scale, ssm_a_re, ssm_a_im, ssm_log_dt,
              ssm_b_re, ssm_b_im, ssm_c_re, ssm_c_im, ssm_d, glu_w, glu_b, br_pool, br_ssm,
              w_out, norm_x, norm_mem, x_wq, x_wkv, x_wo, norm_ffn, router_g_w, router_g_b,
              router_e_w, router_e_b, exp_w1, exp_w3, exp_w2, norm_final):
    h = x
    for l in range(DEPTH):
        u = rms_norm(h, norm_mix[l])
        proj = u @ w_in[l]
        z_pool = proj[..., :POOL_WIDTH]
        v_ssm = proj[..., POOL_WIDTH:POOL_WIDTH + SSM_WIDTH]
        gate_logits = proj[..., POOL_WIDTH + SSM_WIDTH:]
        y_pool = pool_mixer(z_pool, pool_w[l], pool_scale[l])
        y_s = s5_ssm(v_ssm, ssm_a_re[l], ssm_a_im[l], ssm_log_dt[l], ssm_b_re[l], ssm_b_im[l],
                     ssm_c_re[l], ssm_c_im[l], ssm_d[l])
        y_s = jax.nn.gelu(y_s)
        y_s = (y_s * jax.nn.sigmoid(y_s @ glu_w[l].astype(jnp.float32) + glu_b[l].astype(jnp.float32))).astype(h.dtype)
        gates = jax.nn.sigmoid(gate_logits.astype(jnp.float32)).astype(h.dtype)
        merged = gates[..., :D_MODEL] * (y_pool @ br_pool[l]) + gates[..., D_MODEL:] * (y_s @ br_ssm[l])
        h = h + merged @ w_out[l]
        h = h + memory_cross_attention(rms_norm(h, norm_x[l]), rms_norm(mem, norm_mem[l]),
                                       x_wq[l], x_wkv[l], x_wo[l])
        h = h + hierarchical_moe(rms_norm(h, norm_ffn[l]), router_g_w[l], router_g_b[l],
                                 router_e_w[l], router_e_b[l], exp_w1[l], exp_w3[l], exp_w2[l])
    return rms_norm(h, norm_final)
```

```cpp
#include <hip/hip_runtime.h>
#include <cstdio>
#include <cstdint>

#define GAS __attribute__((address_space(1)))
#define LAS __attribute__((address_space(3)))
typedef unsigned short bf16_t;
typedef float f32x4 __attribute__((ext_vector_type(4)));
typedef float f32x2 __attribute__((ext_vector_type(2)));
typedef unsigned u32x4 __attribute__((ext_vector_type(4)));
typedef unsigned u32x2 __attribute__((ext_vector_type(2)));
typedef short bf16x8 __attribute__((ext_vector_type(8)));
typedef GAS unsigned gu32;
#define RLX_AGENT __ATOMIC_RELAXED, __HIP_MEMORY_SCOPE_AGENT
#define LDS_WAIT() asm volatile("s_waitcnt lgkmcnt(0)" ::: "memory")
#define VM_WAIT() asm volatile("s_waitcnt vmcnt(0)" ::: "memory")
#define DI __device__ __forceinline__

#ifndef MK_PER_PHASE
#define MK_PER_PHASE 1
#endif

constexpr int BATCH = 4, SEQ = 8192, D = 1024, T = BATCH * SEQ;
constexpr int PW = 512, SW = 512, NSG = 32, GD = 16, NS = 64, INW = 3072;
constexpr int MEM = 256, XH = 4, XHD = 256, MROWS = BATCH * MEM;
constexpr int NE = 16, DE = 512;
constexpr float EPS = 1e-6f;
constexpr int NWAVES = 8;

constexpr size_t MiB = 1u << 20;
constexpr size_t WS_CTL = 0, CTL_ZERO_BYTES = 1 * MiB;
constexpr size_t WS_W1T = 1 * MiB;
constexpr size_t WS_WGLU = 7 * MiB;
constexpr size_t WS_WBRP = WS_WGLU + MiB / 2;
constexpr size_t WS_WBRS = WS_WBRP + MiB;
constexpr size_t WS_WOUT = WS_WBRS + MiB;
constexpr size_t WS_WQ = WS_WOUT + 2 * MiB;
constexpr size_t WS_WKV = WS_WQ + 2 * MiB;
constexpr size_t WS_WO = WS_WKV + 4 * MiB;
constexpr size_t WS_W13 = 20 * MiB;
constexpr size_t WS_W2T = 52 * MiB;
constexpr size_t WS_MEMN = 68 * MiB;
constexpr size_t WS_KC = 70 * MiB;
constexpr size_t WS_VT = 72 * MiB;
constexpr size_t WS_SSMT = 74 * MiB;
constexpr size_t WS_RT = 84 * MiB;
constexpr size_t WS_SSQ8 = 85 * MiB;
constexpr size_t WS_PTOK = 101 * MiB;
constexpr size_t WS_PCOMB = 103 * MiB;
constexpr size_t WS_PSCALE = 105 * MiB;
constexpr size_t WS_SLOC = 107 * MiB;
constexpr size_t WS_SSCAN = 109 * MiB;
constexpr size_t WS_A = 112 * MiB;
constexpr size_t WS_ZW = 176 * MiB;
constexpr size_t WS_VS = 208 * MiB;
constexpr size_t WS_MG = 176 * MiB;
constexpr size_t WS_Q = 176 * MiB;
constexpr size_t WS_G = 240 * MiB;
constexpr size_t WS_PK0 = 240 * MiB, WS_PK1 = 304 * MiB;
constexpr size_t WS_YP = 368 * MiB, WS_YG = 400 * MiB, WS_YS2 = 432 * MiB;
constexpr size_t WS_HID = 368 * MiB;
constexpr size_t WS_END = 464 * MiB;
constexpr int CW_TMO = 0, CW_CODE = 1;
constexpr int CW_BAR = 4096;
constexpr int CW_CNT = 16384;

constexpr int RING_OFF = 0, RING_BYTES = 131072;
constexpr int LDSCTL_OFF = RING_BYTES, MISC_OFF = LDSCTL_OFF + 320;
constexpr int XTAB_OFF = LDSCTL_OFF + 512;
constexpr int LDS_BYTES = 147456;

DI float bf2f(unsigned b) { return __uint_as_float(b << 16); }
DI unsigned f2bf(float f) { unsigned u = __float_as_uint(f); return (u + 0x7fffu + ((u >> 16) & 1u)) >> 16; }
DI unsigned pk2(float lo, float hi) { return f2bf(lo) | (f2bf(hi) << 16); }
DI float sigm(float x) { return 1.f / (1.f + __expf(-x)); }
DI float gelu_tanh(float x) { return x * sigm(1.5957691216057308f * (x + 0.044715f * x * x * x)); }
DI float wave_sum(float v) {
#pragma unroll
    for (int o = 1; o < 64; o <<= 1) v += __shfl_xor(v, o);
    return v;
}
DI float wave_max(float v) {
#pragma unroll
    for (int o = 1; o < 64; o <<= 1) v = fmaxf(v, __shfl_xor(v, o));
    return v;
}
DI void store8bf(bf16_t* p, const f32x4& a, const f32x4& b) {
    u32x4 w; w.x = pk2(a[0], a[1]); w.y = pk2(a[2], a[3]); w.z = pk2(b[0], b[1]); w.w = pk2(b[2], b[3]);
    *(u32x4*)p = w;
}
DI void load8bf(const bf16_t* p, f32x4& a, f32x4& b) {
    const u32x4 w = *(const u32x4*)p;
    a[0] = bf2f(w.x & 0xffffu); a[1] = bf2f(w.x >> 16); a[2] = bf2f(w.y & 0xffffu); a[3] = bf2f(w.y >> 16);
    b[0] = bf2f(w.z & 0xffffu); b[1] = bf2f(w.z >> 16); b[2] = bf2f(w.w & 0xffffu); b[3] = bf2f(w.w >> 16);
}

#define XB_TMO      128
#define XB_XCNT(j)  (256  + 64 * (j))
#define XB_XSUB(j)  (1280 + 64 * (j))
#define XB_XGEN(j)  (2304 + 64 * (j))
#define XB_TOP      3328
#define XB_TOPGEN   3392
#define XCD_BAR_WORDS 3456
#define XB_SPIN_CAP (1u << 18)
DI unsigned xb_ld(unsigned* p)              { return __hip_atomic_load(p, __ATOMIC_RELAXED, __HIP_MEMORY_SCOPE_AGENT); }
DI unsigned xb_add(unsigned* p, unsigned v) { return __hip_atomic_fetch_add(p, v, __ATOMIC_RELAXED, __HIP_MEMORY_SCOPE_AGENT); }
DI unsigned xb_xcc_id() { return (unsigned)__builtin_amdgcn_s_getreg((3 << 11) | 20) & 0xFu; }
#define XB_SPIN(cond, bar) do { unsigned _sp = 0; while (cond) { __builtin_amdgcn_s_sleep(1); \
    if ((++_sp & 255u) == 0u) { if (xb_ld(&(bar)[XB_TMO])) break; if (_sp > XB_SPIN_CAP) { atomicAdd(&(bar)[XB_TMO], 1u); break; } } } } while (0)
struct XcdBarrier { unsigned* bar; unsigned x; volatile LAS unsigned* st; };
DI XcdBarrier xcd_barrier_post(unsigned* bar, volatile LAS unsigned* st) {
    XcdBarrier b; b.bar = bar; b.x = xb_xcc_id(); b.st = st;
    if (threadIdx.x == 0) (void)xb_add(&bar[XB_XCNT(b.x)], 1u);
    return b;
}
DI void xcd_barrier_complete(unsigned* bar, unsigned x, unsigned& nloc, unsigned& nx) {
    const unsigned G = gridDim.x * gridDim.y * gridDim.z;
    unsigned sum, cnt, mine, sp = 0u;
    for (;;) {
        sum = 0u; cnt = 0u; mine = 0u;
#pragma unroll
        for (unsigned j = 0; j < 16; ++j) { const unsigned c = xb_ld(&bar[XB_XCNT(j)]); sum += c; cnt += (c > 0u) ? 1u : 0u; mine = (j == x) ? c : mine; }
        if (sum == G) break;
        __builtin_amdgcn_s_sleep(1);
        if ((++sp & 255u) == 0u) { if (xb_ld(&bar[XB_TMO])) break; if (sp > XB_SPIN_CAP) { atomicAdd(&bar[XB_TMO], 1u); break; } }
    }
    nloc = mine > 0u ? mine : 1u; nx = cnt > 0u ? cnt : 1u;
}
DI void xcd_barrier(const XcdBarrier& b) {
    asm volatile("s_waitcnt vmcnt(0)" ::: "memory");
    __syncthreads();
    if (threadIdx.x == 0) {
        unsigned* bar = b.bar;
        __builtin_amdgcn_s_waitcnt(0);
        unsigned nloc = b.st[0], nx = b.st[1];
        if (nloc == 0u) { xcd_barrier_complete(bar, b.x, nloc, nx); b.st[0] = nloc; b.st[1] = nx; }
        const unsigned old = xb_add(&bar[XB_XSUB(b.x)], 1u);
        const unsigned gen = old / nloc;
        if (old + 1u == (gen + 1u) * nloc) {
            __builtin_amdgcn_fence(__ATOMIC_RELEASE, "agent");
            asm volatile("s_waitcnt vmcnt(0)" ::: "memory");
            const unsigned og = xb_add(&bar[XB_TOP], 1u);
            const unsigned tg = og / nx;
            if (og + 1u == (tg + 1u) * nx) xb_add(&bar[XB_TOPGEN], 1u);
            else XB_SPIN(xb_ld(&bar[XB_TOPGEN]) == tg, bar);
            __builtin_amdgcn_fence(__ATOMIC_ACQUIRE, "agent");
            xb_add(&bar[XB_XGEN(b.x)], 1u);
            asm volatile("s_waitcnt vmcnt(0)" ::: "memory");
        } else {
            XB_SPIN(xb_ld(&bar[XB_XGEN(b.x)]) == gen, bar);
            __builtin_amdgcn_fence(__ATOMIC_ACQUIRE, "agent");
            asm volatile("s_waitcnt vmcnt(0)" ::: "memory");
        }
    }
    __syncthreads();
}

namespace pg8 {
constexpr int BM = 256, BK = 64, HALF = 128, NXCD = 8, WGM = 8;
struct Unit { int pm, pn, e; };
struct Gemm { const bf16_t* A; const bf16_t* Bt; int K; const bf16_t* A2; const bf16_t* Bt2; size_t bstride; };

struct StaticOrder {
    int nM, nN, nwg, G, c;
    DI void init(int M, int N, int G_, int c_) { nM = M / BM; nN = N / BM; nwg = nM * nN; G = G_; c = c_; }
    DI bool tile(int L, Unit& u) const {
        if (L >= nwg) return false;
        int wgid = L; { const int q = nwg / NXCD, r = nwg % NXCD, xcd = wgid % NXCD, off = wgid / NXCD; wgid = (xcd < r ? xcd * (q + 1) : r * (q + 1) + (xcd - r) * q) + off; }
        const int nig = WGM * nN, gid = wgid / nig, fm = gid * WGM, gsz = (nM - fm) < WGM ? (nM - fm) : WGM;
        u.pm = fm + ((wgid % nig) % gsz); u.pn = (wgid % nig) / gsz; u.e = 0; return true;
    }
    DI bool next(int i, Unit& u) const { return tile(i * G + c, u); }
    DI const bf16_t* a_base(const Gemm& g, const Unit&) const { return g.A; }
    DI const bf16_t* a_row(const Gemm& g, const Unit& u, int r) const { return g.A + (size_t)(u.pm * BM + r) * g.K; }
    DI const bf16_t* b_row(const Gemm& g, const Unit& u, int n) const { return g.Bt + (size_t)(u.pn * BM + n) * g.K; }
};
struct USched {
    int mode; StaticOrder so; const volatile LAS int* tp; const int* ptok; int nN;
    DI bool next(int i, Unit& u) const {
        if (mode == 0) return so.tile(i * so.G + so.c, u);
        if (mode == 1) { if (!so.tile((i >> 1) * so.G + so.c, u)) return false; u.e = i & 1; return true; }
        const int L = i * so.G + so.c, total = tp[16] * nN; if (L >= total) return false;
        const int mt = L / nN; int e = 0;
#pragma unroll
        for (int j = 1; j < 16; ++j) e += (mt >= tp[j]) ? 1 : 0;
        u.pm = __builtin_amdgcn_readfirstlane(mt); u.pn = __builtin_amdgcn_readfirstlane(L % nN); u.e = __builtin_amdgcn_readfirstlane(e); return true;
    }
    DI const bf16_t* a_base(const Gemm& g, const Unit& u) const { return (mode == 1 && u.e) ? g.A2 : g.A; }
    DI const bf16_t* a_row(const Gemm& g, const Unit& u, int r) const {
        if (mode == 2) {
            const int slot = (u.pm - tp[u.e]) * BM + r; const int cnt = tp[32 + u.e];
            const int tok = slot < cnt ? (ptok[u.e * T + slot] & 0x7fffffff) : 0;
            return g.A + (size_t)tok * g.K;
        }
        return a_base(g, u) + (size_t)(u.pm * BM + r) * g.K;
    }
    DI const bf16_t* b_row(const Gemm& g, const Unit& u, int n) const {
        const bf16_t* b = (mode == 1 && u.e) ? g.Bt2 : g.Bt;
        if (mode >= 2) b += (size_t)u.e * g.bstride;
        return b + (size_t)(u.pn * BM + n) * g.K;
    }
};


template <class Epi, class Sched>
DI void ngemm_phase(LAS unsigned char* lds, const Gemm g, const Sched& S, const Epi& E, const int tid) {
    LAS float* As = (LAS float*)lds;
    LAS float* Bs = As + 16 * 132;
    const int lr = tid >> 2, kq = tid & 3, tx = tid & 15, ty = tid >> 4;
    Unit u;
    for (int i = 0; S.next(i, u); ++i) {
        for (int sub = 0; sub < 4; ++sub) {
            const int sm = (sub >> 1) * 128, sn = (sub & 1) * 128;
            float acc[4][8];
#pragma unroll
            for (int r = 0; r < 4; ++r)
#pragma unroll
                for (int c = 0; c < 8; ++c) acc[r][c] = 0.f;
            const bf16_t* arow = S.a_row(g, u, sm + lr) + kq * 4;
            const bf16_t* brow = S.b_row(g, u, sn + lr) + kq * 4;
            for (int k0 = 0; k0 < g.K; k0 += 16) {
                __syncthreads();
                const u32x2 av = *(const u32x2*)(arow + k0), bv = *(const u32x2*)(brow + k0);
                As[(kq * 4 + 0) * 132 + lr] = bf2f(av.x & 0xffffu); As[(kq * 4 + 1) * 132 + lr] = bf2f(av.x >> 16);
                As[(kq * 4 + 2) * 132 + lr] = bf2f(av.y & 0xffffu); As[(kq * 4 + 3) * 132 + lr] = bf2f(av.y >> 16);
                Bs[(kq * 4 + 0) * 132 + lr] = bf2f(bv.x & 0xffffu); Bs[(kq * 4 + 1) * 132 + lr] = bf2f(bv.x >> 16);
                Bs[(kq * 4 + 2) * 132 + lr] = bf2f(bv.y & 0xffffu); Bs[(kq * 4 + 3) * 132 + lr] = bf2f(bv.y >> 16);
                __syncthreads();
#pragma unroll
                for (int k = 0; k < 16; ++k) {
                    const f32x4 a4 = *(const LAS f32x4*)(As + k * 132 + ty * 4);
                    const f32x4 b0 = *(const LAS f32x4*)(Bs + k * 132 + tx * 8), b1 = *(const LAS f32x4*)(Bs + k * 132 + tx * 8 + 4);
#pragma unroll
                    for (int r = 0; r < 4; ++r) {
#pragma unroll
                        for (int c = 0; c < 4; ++c) { acc[r][c] += a4[r] * b0[c]; acc[r][4 + c] += a4[r] * b1[c]; }
                    }
                }
            }
#pragma unroll
            for (int r = 0; r < 4; ++r) {
                f32x4 v0 = {acc[r][0], acc[r][1], acc[r][2], acc[r][3]}, v1 = {acc[r][4], acc[r][5], acc[r][6], acc[r][7]};
                E(u, u.pm * BM + sm + ty * 4 + r, u.pn * BM + sn + tx * 8, v0, v1);
            }
        }
    }
    __syncthreads();
}
}

struct FProj {
    bf16_t* zw; bf16_t* vs; bf16_t* g;
    DI void operator()(const pg8::Unit&, int row, int col, f32x4& v0, f32x4& v1) const {
        if (col < 512) store8bf(zw + (size_t)row * 512 + col, v0, v1);
        else if (col < 1024) store8bf(vs + (size_t)row * 512 + (col - 512), v0, v1);
        else {
            f32x4 a, b;
#pragma unroll
            for (int j = 0; j < 4; ++j) { a[j] = sigm(v0[j]); b[j] = sigm(v1[j]); }
            store8bf(g + (size_t)row * 2048 + (col - 1024), a, b);
        }
    }
};
struct FKV {
    bf16_t* kc; bf16_t* vt;
    DI void operator()(const pg8::Unit&, int row, int col, f32x4& v0, f32x4& v1) const {
        if (col < 1024) store8bf(kc + (size_t)row * 1024 + col, v0, v1);
        else {
            const int c = col - 1024, h = c >> 8, d = c & 255, b = row >> 8, key = row & 255;
            bf16_t* p = vt + ((size_t)((b * 4 + h) * 256 + d)) * 256 + key;
#pragma unroll
            for (int j = 0; j < 4; ++j) { p[(size_t)j * 256] = (bf16_t)f2bf(v0[j]); p[(size_t)(4 + j) * 256] = (bf16_t)f2bf(v1[j]); }
        }
    }
};
struct FGlu {
    const bf16_t* yg; const float* bias; bf16_t* ys2;
    DI void operator()(const pg8::Unit&, int row, int col, f32x4& v0, f32x4& v1) const {
        f32x4 y0, y1; load8bf(yg + (size_t)row * 512 + col, y0, y1);
        const f32x4 b0 = *(const f32x4*)(bias + col), b1 = *(const f32x4*)(bias + col + 4);
        f32x4 a, b;
#pragma unroll
        for (int j = 0; j < 4; ++j) { a[j] = y0[j] * sigm(v0[j] + b0[j]); b[j] = y1[j] * sigm(v1[j] + b1[j]); }
        store8bf(ys2 + (size_t)row * 512 + col, a, b);
    }
};
struct FBrNaive {
    const bf16_t* g; float* tmp; bf16_t* mg;
    DI void operator()(const pg8::Unit& u, int row, int col, f32x4& v0, f32x4& v1) const {
        f32x4 g0, g1; load8bf(g + (size_t)row * 2048 + (u.e ? 1024 : 0) + col, g0, g1);
        float* tp = tmp + (size_t)row * 1024 + col;
        if (u.e == 0) { *(f32x4*)tp = g0 * v0; *(f32x4*)(tp + 4) = g1 * v1; }
        else { const f32x4 t0 = *(const f32x4*)tp, t1 = *(const f32x4*)(tp + 4); store8bf(mg + (size_t)row * 1024 + col, t0 + g0 * v0, t1 + g1 * v1); }
    }
};
struct FWout {
    const float* x; float* out; bf16_t* hb; float* ssq8;
    DI void operator()(const pg8::Unit&, int row, int col, f32x4& v0, f32x4& v1) const {
        const size_t o = (size_t)row * 1024 + col;
        const f32x4 h0 = *(const f32x4*)(x + o) + v0, h1 = *(const f32x4*)(x + o + 4) + v1;
        *(f32x4*)(out + o) = h0; *(f32x4*)(out + o + 4) = h1;
        store8bf(hb + o, h0, h1);
        ssq8[(size_t)row * 128 + (col >> 3)] = (h0[0] * h0[0] + h0[1] * h0[1]) + (h0[2] * h0[2] + h0[3] * h0[3]) + (h1[0] * h1[0] + h1[1] * h1[1]) + (h1[2] * h1[2] + h1[3] * h1[3]);
    }
};
struct FStoreBf {
    bf16_t* o;
    DI void operator()(const pg8::Unit&, int row, int col, f32x4& v0, f32x4& v1) const { store8bf(o + (size_t)row * 1024 + col, v0, v1); }
};
struct FWo {
    float* out; bf16_t* hb;
    DI void operator()(const pg8::Unit&, int row, int col, f32x4& v0, f32x4& v1) const {
        const size_t o = (size_t)row * 1024 + col;
        const f32x4 h0 = *(const f32x4*)(out + o) + v0, h1 = *(const f32x4*)(out + o + 4) + v1;
        *(f32x4*)(out + o) = h0; *(f32x4*)(out + o + 4) = h1;
        store8bf(hb + o, h0, h1);
    }
};
struct FUp {
    const volatile LAS int* tp; const float* pscale; bf16_t* hid;
    DI void operator()(const pg8::Unit& u, int row, int col, f32x4& v0, f32x4& v1) const {
        const int slot = row - tp[u.e] * 256;
        if (slot < tp[32 + u.e]) {
            const float s = pscale[u.e * T + slot];
            u32x2 w; float h[4];
#pragma unroll
            for (int j = 0; j < 4; ++j) { const float a = v0[j] * s, b = v1[j] * s; h[j] = a * sigm(a) * b; }
            w.x = pk2(h[0], h[1]); w.y = pk2(h[2], h[3]);
            *(u32x2*)(hid + (size_t)row * 512 + (col >> 1)) = w;
        }
    }
};
struct FDown {
    const volatile LAS int* tp; const int* ptok; const float* pcomb; bf16_t* pk0; bf16_t* pk1;
    DI void operator()(const pg8::Unit& u, int row, int col, f32x4& v0, f32x4& v1) const {
        const int slot = row - tp[u.e] * 256;
        if (slot < tp[32 + u.e]) {
            const int t = ptok[u.e * T + slot]; const float c = pcomb[u.e * T + slot];
            bf16_t* dst = ((t < 0) ? pk1 : pk0) + (size_t)(t & 0x7fffffff) * 1024 + col;
            store8bf(dst, v0 * c, v1 * c);
        }
    }
};

enum { E_PROJ = 0, E_KV, E_GLU, E_BR, E_WOUT, E_Q, E_WO, E_UP, E_DOWN };
struct UEpi {
    int id; const volatile LAS int* tp; unsigned char* ws; const float* x; float* out; const float* glub;
    DI void operator()(const pg8::Unit& u, int row, int col, f32x4& v0, f32x4& v1) const {
        switch (id) {
        case E_PROJ: FProj{(bf16_t*)(ws + WS_ZW), (bf16_t*)(ws + WS_VS), (bf16_t*)(ws + WS_G)}(u, row, col, v0, v1); break;
        case E_KV:   FKV{(bf16_t*)(ws + WS_KC), (bf16_t*)(ws + WS_VT)}(u, row, col, v0, v1); break;
        case E_GLU:  FGlu{(const bf16_t*)(ws + WS_YG), glub, (bf16_t*)(ws + WS_YS2)}(u, row, col, v0, v1); break;
        case E_BR:   FBrNaive{(const bf16_t*)(ws + WS_G), out, (bf16_t*)(ws + WS_MG)}(u, row, col, v0, v1); break;
        case E_WOUT: FWout{x, out, (bf16_t*)(ws + WS_A), (float*)(ws + WS_SSQ8)}(u, row, col, v0, v1); break;
        case E_Q:    FStoreBf{(bf16_t*)(ws + WS_Q)}(u, row, col, v0, v1); break;
        case E_WO:   FWo{out, (bf16_t*)(ws + WS_A)}(u, row, col, v0, v1); break;
        case E_UP:   FUp{tp, (const float*)(ws + WS_PSCALE), (bf16_t*)(ws + WS_HID)}(u, row, col, v0, v1); break;
        default:     FDown{tp, (const int*)(ws + WS_PTOK), (const float*)(ws + WS_PCOMB), (bf16_t*)(ws + WS_PK0), (bf16_t*)(ws + WS_PK1)}(u, row, col, v0, v1); break;
        }
    }
};

struct Args { const float* in[33]; float* out; unsigned char* ws; int ph_lo, ph_hi, li, pad; };
struct Frame {
    LAS unsigned char* lds; volatile LAS unsigned* MISC; gu32* ctl;
    int tid, lane, wave, vcu, G, bid; unsigned char* ws;
};
typedef __attribute__((address_space(4))) const Args CArgs;
#if defined(__HIP_DEVICE_COMPILE__)
DI Args phase_args(CArgs* p) { asm volatile("" : "+s"(p)); return *p; }
#else
DI Args phase_args(CArgs* p) { return Args{}; }
#endif
DI Frame make_frame(const Args& a) {
    Frame F;
    extern __shared__ __attribute__((aligned(16))) unsigned char lds[];
    F.lds = (LAS unsigned char*)lds;
    F.MISC = (volatile LAS unsigned*)(F.lds + MISC_OFF);
    { int t = threadIdx.x; asm volatile("" : "+v"(t)); F.tid = t; }
    F.lane = F.tid & 63; F.wave = __builtin_amdgcn_readfirstlane(F.tid >> 6);
    int bx = blockIdx.x, gx = gridDim.x; asm volatile("" : "+s"(bx), "+s"(gx));
    F.G = gx; F.bid = bx; F.vcu = (F.G % 8 == 0) ? (bx % 8) * (F.G / 8) + bx / 8 : bx;
    F.ws = a.ws; F.ctl = (gu32*)(a.ws + WS_CTL);
    return F;
}
enum { I_X = 0, I_MEM, I_NMIX, I_WIN, I_POOLW, I_POOLS, I_ARE, I_AIM, I_LOGDT, I_BRE, I_BIM, I_CRE, I_CIM, I_SD, I_GLUW, I_GLUB, I_BRP, I_BRS,
       I_WOUT, I_NX, I_NMEM, I_WQ, I_WKV, I_WO, I_NFFN, I_RGW, I_RGB, I_REW, I_REB, I_W1, I_W3, I_W2, I_NFIN };

template <class RM>
DI void tr_item(const float* W, int K, int ld, int nblk, bf16_t* WT, const float* kscale, RM rm, LAS float* scr, int item, int lane) {
    const int kb = item / nblk, nb = item % nblk, k0 = 64 * kb, n0 = 32 * nb;
#pragma unroll 8
    for (int i = 0; i < 32; ++i) { const int kk = 2 * i + (lane >> 5); const float s = kscale ? kscale[k0 + kk] : 1.f; scr[kk * 33 + (lane & 31)] = W[(size_t)(k0 + kk) * ld + n0 + (lane & 31)] * s; }
    LDS_WAIT(); asm volatile("" ::: "memory");
    const int c = lane & 7;
#pragma unroll
    for (int j = 0; j < 4; ++j) { const int n = (lane >> 3) + 8 * j; const LAS float* s = scr + (8 * c) * 33 + n;
        u32x4 o; o.x = pk2(s[0 * 33], s[1 * 33]); o.y = pk2(s[2 * 33], s[3 * 33]); o.z = pk2(s[4 * 33], s[5 * 33]); o.w = pk2(s[6 * 33], s[7 * 33]);
        *(u32x4*)(WT + (size_t)rm(n0 + n) * K + k0 + 8 * c) = o; }
    LDS_WAIT(); asm volatile("" ::: "memory");
}
struct RmId { int off; DI int operator()(int n) const { return off + n; } };
struct RmIl { int off; DI int operator()(int n) const { return 8 * (n >> 2) + (n & 3) + off; } };
DI void rms_row_to_bf16(const float* xrow, bf16_t* orow, int lane) {
    const f32x4* xr = (const f32x4*)xrow + lane;
    f32x4 v[4]; float s = 0.f;
#pragma unroll
    for (int j = 0; j < 4; ++j) { v[j] = xr[64 * j]; s += (v[j].x * v[j].x + v[j].y * v[j].y) + (v[j].z * v[j].z + v[j].w * v[j].w); }
    const float r = 1.f / sqrtf(wave_sum(s) * (1.f / 1024.f) + EPS);
    u32x2* o8 = (u32x2*)orow + lane;
#pragma unroll
    for (int j = 0; j < 4; ++j) { u32x2 w; w.x = pk2(v[j].x * r, v[j].y * r); w.y = pk2(v[j].z * r, v[j].w * r); o8[64 * j] = w; }
}
DI void p0_prologue(const Args& a, Frame& F) {
    unsigned char* ws = F.ws;
    LAS float* scr = (LAS float*)(F.lds + RING_OFF + F.wave * 16384);
    const int gw = F.vcu * NWAVES + F.wave, NGW = F.G * NWAVES, lane = F.lane;
    constexpr int I0 = 16 * 80;
    constexpr int I1 = I0 + 8 * 16;
    constexpr int I2 = I1 + 8 * 32;
    constexpr int I3 = I2 + 8 * 32;
    constexpr int I4 = I3 + 16 * 32;
    constexpr int I5 = I4 + 16 * 32;
    constexpr int I6 = I5 + 16 * 64;
    constexpr int I7 = I6 + 16 * 32;
    constexpr int I8 = I7 + 16 * 256;
    constexpr int I9 = I8 + 16 * 256;
    constexpr int I10 = I9 + 16 * 256;
    for (int it = gw; it < I10; it += NGW) {
        if (it < I0) tr_item(a.in[I_WIN] + 512, 1024, 3072, 80, (bf16_t*)(ws + WS_W1T), a.in[I_NMIX], RmId{512}, scr, it, lane);
        else if (it < I1) tr_item(a.in[I_GLUW], 512, 512, 16, (bf16_t*)(ws + WS_WGLU), nullptr, RmId{0}, scr, it - I0, lane);
        else if (it < I2) tr_item(a.in[I_BRP], 512, 1024, 32, (bf16_t*)(ws + WS_WBRP), nullptr, RmId{0}, scr, it - I1, lane);
        else if (it < I3) tr_item(a.in[I_BRS], 512, 1024, 32, (bf16_t*)(ws + WS_WBRS), nullptr, RmId{0}, scr, it - I2, lane);
        else if (it < I4) tr_item(a.in[I_WOUT], 1024, 1024, 32, (bf16_t*)(ws + WS_WOUT), nullptr, RmId{0}, scr, it - I3, lane);
        else if (it < I5) tr_item(a.in[I_WQ], 1024, 1024, 32, (bf16_t*)(ws + WS_WQ), a.in[I_NX], RmId{0}, scr, it - I4, lane);
        else if (it < I6) tr_item(a.in[I_WKV], 1024, 2048, 64, (bf16_t*)(ws + WS_WKV), a.in[I_NMEM], RmId{0}, scr, it - I5, lane);
        else if (it < I7) tr_item(a.in[I_WO], 1024, 1024, 32, (bf16_t*)(ws + WS_WO), nullptr, RmId{0}, scr, it - I6, lane);
        else if (it < I8) { const int r = it - I7, e = r >> 8; tr_item(a.in[I_W1] + (size_t)e * 1024 * 512, 1024, 512, 16, (bf16_t*)(ws + WS_W13) + (size_t)e * 1024 * 1024, a.in[I_NFFN], RmIl{0}, scr, r & 255, lane); }
        else if (it < I9) { const int r = it - I8, e = r >> 8; tr_item(a.in[I_W3] + (size_t)e * 1024 * 512, 1024, 512, 16, (bf16_t*)(ws + WS_W13) + (size_t)e * 1024 * 1024, a.in[I_NFFN], RmIl{4}, scr, r & 255, lane); }
        else { const int r = it - I9, e = r >> 8; tr_item(a.in[I_W2] + (size_t)e * 512 * 1024, 512, 1024, 32, (bf16_t*)(ws + WS_W2T) + (size_t)e * 1024 * 512, nullptr, RmId{0}, scr, r & 255, lane); }
    }
    {
        const float* win = a.in[I_WIN]; const float* pw = a.in[I_POOLW]; const float* ps = a.in[I_POOLS]; const float* nm = a.in[I_NMIX];
        bf16_t* w1t = (bf16_t*)(ws + WS_W1T);
        for (int it = F.vcu * 512 + F.tid; it < 512 * 128; it += F.G * 512) {
            const int n = it & 511, kb = it >> 9, g = n >> 7, d = n & 127, k0 = kb * 8;
            float acc[8];
#pragma unroll
            for (int j = 0; j < 8; ++j) acc[j] = 0.f;
            for (int c = 0; c < 128; ++c) {
                const float p = pw[(size_t)(g * 128 + c) * 128 + d];
#pragma unroll
                for (int j = 0; j < 8; ++j) acc[j] += win[(size_t)(k0 + j) * 3072 + g * 128 + c] * p;
            }
            const float sc = ps[n];
            u32x4 o;
            o.x = pk2(acc[0] * sc * nm[k0 + 0], acc[1] * sc * nm[k0 + 1]); o.y = pk2(acc[2] * sc * nm[k0 + 2], acc[3] * sc * nm[k0 + 3]);
            o.z = pk2(acc[4] * sc * nm[k0 + 4], acc[5] * sc * nm[k0 + 5]); o.w = pk2(acc[6] * sc * nm[k0 + 6], acc[7] * sc * nm[k0 + 7]);
            *(u32x4*)(w1t + (size_t)n * 1024 + k0) = o;
        }
    }
    {
        float* rt = (float*)(ws + WS_RT); const float* nf = a.in[I_NFFN];
        for (int it = F.vcu * 512 + F.tid; it < 20 * 1024; it += F.G * 512) {
            const int j = it >> 10, k = it & 1023;
            rt[it] = nf[k] * (j < 4 ? a.in[I_RGW][k * 4 + j] : a.in[I_REW][k * 16 + (j - 4)]);
        }
    }
    for (int m = gw; m < T; m += NGW) rms_row_to_bf16(a.in[I_X] + (size_t)m * D, (bf16_t*)(ws + WS_A) + (size_t)m * D, lane);
    for (int m = gw; m < MROWS; m += NGW) rms_row_to_bf16(a.in[I_MEM] + (size_t)m * D, (bf16_t*)(ws + WS_MEMN) + (size_t)m * D, lane);
}

DI void p2_pool(Frame& F) {
    const bf16_t* zw = (const bf16_t*)(F.ws + WS_ZW); bf16_t* yp = (bf16_t*)(F.ws + WS_YP);
    for (int it = F.vcu * 512 + F.tid; it < T * 64; it += F.G * 512) {
        const int t = it >> 6, ch = (it & 63) * 8, s = t & (SEQ - 1), w = 2 << (ch >> 7), cnt = (s + 1 < w) ? s + 1 : w;
        f32x4 z0, z1; load8bf(zw + (size_t)t * 512 + ch, z0, z1);
        f32x4 s0 = z0, s1 = z1;
        for (int j = 1; j < cnt; ++j) { f32x4 a, b; load8bf(zw + (size_t)(t - j) * 512 + ch, a, b); s0 += a; s1 += b; }
        const float inv = 1.f / (float)cnt;
        store8bf(yp + (size_t)t * 512 + ch, s0 * inv - z0, s1 * inv - z1);
    }
}
DI void p2_ssm_naive(const Args& a, Frame& F) {
    if (F.wave != 0) return;
    const bf16_t* vs = (const bf16_t*)(F.ws + WS_VS); bf16_t* yg = (bf16_t*)(F.ws + WS_YG);
    const int n = F.lane;
    for (int item = F.vcu; item < BATCH * NSG; item += F.G) {
        const int b = item >> 5, g = item & 31;
        const float dt = expf(a.in[I_LOGDT][g]), ar = a.in[I_ARE][g * 64 + n], ai = a.in[I_AIM][g * 64 + n];
        const float mag = expf(ar * dt); float sn, cs; sincosf(ai * dt, &sn, &cs);
        const float lr = mag * cs, li = mag * sn, den = ar * ar + ai * ai, nr = lr - 1.f, ni = li;
        const float fre = (nr * ar + ni * ai) / den, fim = (ni * ar - nr * ai) / den;
        float bbr[16], bbi[16], cr[16], ci[16], dsk[16];
#pragma unroll
        for (int c = 0; c < 16; ++c) {
            const float br = a.in[I_BRE][(size_t)(g * 64 + n) * 16 + c], bi = a.in[I_BIM][(size_t)(g * 64 + n) * 16 + c];
            bbr[c] = fre * br - fim * bi; bbi[c] = fre * bi + fim * br;
            cr[c] = a.in[I_CRE][(size_t)(g * 16 + c) * 64 + n]; ci[c] = a.in[I_CIM][(size_t)(g * 16 + c) * 64 + n];
            dsk[c] = (n == 0) ? a.in[I_SD][g * 16 + c] : 0.f;
        }
        float hr = 0.f, hi = 0.f;
        const int myc = (((n >> 5) & 1) << 3) | (((n >> 4) & 1) << 2) | (((n >> 3) & 1) << 1) | ((n >> 2) & 1);
        for (int s = 0; s < SEQ; ++s) {
            const size_t t = (size_t)b * SEQ + s;
            f32x4 va, vb, vc, vd; load8bf(vs + t * 512 + g * 16, va, vb); load8bf(vs + t * 512 + g * 16 + 8, vc, vd);
            float v[16];
#pragma unroll
            for (int j = 0; j < 4; ++j) { v[j] = va[j]; v[4 + j] = vb[j]; v[8 + j] = vc[j]; v[12 + j] = vd[j]; }
            float ur = 0.f, ui = 0.f;
#pragma unroll
            for (int c = 0; c < 16; ++c) { ur += bbr[c] * v[c]; ui += bbi[c] * v[c]; }
            const float nhr = lr * hr - li * hi + ur, nhi = lr * hi + li * hr + ui; hr = nhr; hi = nhi;
            float p[16];
#pragma unroll
            for (int c = 0; c < 16; ++c) p[c] = cr[c] * hr - ci[c] * hi + dsk[c] * v[c];
#pragma unroll
            for (int i = 0; i < 8; ++i) { const bool up = (n & 32) != 0; const float keep = up ? p[i + 8] : p[i], send = up ? p[i] : p[i + 8]; p[i] = keep + __shfl_xor(send, 32); }
#pragma unroll
            for (int i = 0; i < 4; ++i) { const bool up = (n & 16) != 0; const float keep = up ? p[i + 4] : p[i], send = up ? p[i] : p[i + 4]; p[i] = keep + __shfl_xor(send, 16); }
#pragma unroll
            for (int i = 0; i < 2; ++i) { const bool up = (n & 8) != 0; const float keep = up ? p[i + 2] : p[i], send = up ? p[i] : p[i + 2]; p[i] = keep + __shfl_xor(send, 8); }
            { const bool up = (n & 4) != 0; const float keep = up ? p[1] : p[0], send = up ? p[0] : p[1]; p[0] = keep + __shfl_xor(send, 4); }
            float y = p[0]; y += __shfl_xor(y, 1); y += __shfl_xor(y, 2);
            if ((n & 3) == 0) yg[t * 512 + g * 16 + myc] = (bf16_t)f2bf(gelu_tanh(y));
        }
    }
}

DI void p7_attn_naive(Frame& F) {
    bf16_t* q = (bf16_t*)(F.ws + WS_Q); const bf16_t* kc = (const bf16_t*)(F.ws + WS_KC); const bf16_t* vt = (const bf16_t*)(F.ws + WS_VT);
    const float* ssq8 = (const float*)(F.ws + WS_SSQ8);
    LAS float* qs = (LAS float*)(F.lds + F.wave * 2048); LAS float* ps = qs + 256;
    const int lane = F.lane, gw = F.vcu * NWAVES + F.wave, NGW = F.G * NWAVES;
    for (int it = gw; it < T * XH; it += NGW) {
        const int t = it >> 2, h = it & 3, b = t >> 13;
        const float inv = 1.f / sqrtf(wave_sum(ssq8[(size_t)t * 128 + lane] + ssq8[(size_t)t * 128 + 64 + lane]) * (1.f / 1024.f) + EPS);
        { const u32x2 w = *(const u32x2*)(q + (size_t)t * 1024 + h * 256 + lane * 4);
          qs[lane * 4 + 0] = bf2f(w.x & 0xffffu); qs[lane * 4 + 1] = bf2f(w.x >> 16); qs[lane * 4 + 2] = bf2f(w.y & 0xffffu); qs[lane * 4 + 3] = bf2f(w.y >> 16); }
        LDS_WAIT(); __builtin_amdgcn_wave_barrier();
        float sc[4];
#pragma unroll
        for (int kk = 0; kk < 4; ++kk) {
            const bf16_t* kr = kc + (size_t)(b * 256 + kk * 64 + lane) * 1024 + h * 256; float s = 0.f;
#pragma unroll 1
            for (int d = 0; d < 256; d += 8) { f32x4 k0, k1; load8bf(kr + d, k0, k1); const f32x4 q0 = *(const LAS f32x4*)(qs + d), q1 = *(const LAS f32x4*)(qs + d + 4);
                s += (k0[0] * q0[0] + k0[1] * q0[1]) + (k0[2] * q0[2] + k0[3] * q0[3]) + (k1[0] * q1[0] + k1[1] * q1[1]) + (k1[2] * q1[2] + k1[3] * q1[3]); }
            sc[kk] = s * inv * 0.0625f;
        }
        const float m = wave_max(fmaxf(fmaxf(sc[0], sc[1]), fmaxf(sc[2], sc[3])));
        float l = 0.f;
#pragma unroll
        for (int kk = 0; kk < 4; ++kk) { const float p = __expf(sc[kk] - m); l += p; ps[kk * 64 + lane] = p; }
        l = wave_sum(l);
        LDS_WAIT(); __builtin_amdgcn_wave_barrier();
        float o[4] = {0.f, 0.f, 0.f, 0.f};
#pragma unroll
        for (int j = 0; j < 4; ++j) {
            const bf16_t* vr = vt + ((size_t)((b * 4 + h) * 256 + lane * 4 + j)) * 256;
#pragma unroll 1
            for (int k = 0; k < 256; k += 8) { f32x4 v0, v1; load8bf(vr + k, v0, v1); const f32x4 p0 = *(const LAS f32x4*)(ps + k), p1 = *(const LAS f32x4*)(ps + k + 4);
                o[j] += (v0[0] * p0[0] + v0[1] * p0[1]) + (v0[2] * p0[2] + v0[3] * p0[3]) + (v1[0] * p1[0] + v1[1] * p1[1]) + (v1[2] * p1[2] + v1[3] * p1[3]); }
        }
        const float il = 1.f / l;
        u32x2 w; w.x = pk2(o[0] * il, o[1] * il); w.y = pk2(o[2] * il, o[3] * il);
        *(u32x2*)(q + (size_t)t * 1024 + h * 256 + lane * 4) = w;
        LDS_WAIT(); __builtin_amdgcn_wave_barrier();
    }
}

DI void p9_router(const Args& a, Frame& F) {
    const float* h2 = a.out; const float* rt = (const float*)(F.ws + WS_RT);
    int* ptok = (int*)(F.ws + WS_PTOK); float* pcomb = (float*)(F.ws + WS_PCOMB); float* pscale = (float*)(F.ws + WS_PSCALE);
    LAS int* rec_e = (LAS int*)(F.lds);
    LAS float* rec_w = (LAS float*)(F.lds + 1024);
    LAS float* rec_s = (LAS float*)(F.lds + 2048);
    const int lane = F.lane;
    for (int chunk = F.vcu; chunk < T / 128; chunk += F.G) {
        __syncthreads();
        for (int i = 0; i < 16; ++i) {
            const int lt = F.wave * 16 + i, t = chunk * 128 + lt;
            const f32x4* hr = (const f32x4*)(h2 + (size_t)t * 1024) + lane;
            f32x4 v[4]; float ss = 0.f;
#pragma unroll
            for (int j = 0; j < 4; ++j) { v[j] = hr[64 * j]; ss += (v[j].x * v[j].x + v[j].y * v[j].y) + (v[j].z * v[j].z + v[j].w * v[j].w); }
            const float inv = 1.f / sqrtf(wave_sum(ss) * (1.f / 1024.f) + EPS);
            LAS float* lgs = (LAS float*)(F.lds + 4096 + F.wave * 128);
#pragma unroll 1
            for (int o = 0; o < 20; ++o) {
                const f32x4* rr = (const f32x4*)(rt + o * 1024) + lane; float s = 0.f;
#pragma unroll
                for (int j = 0; j < 4; ++j) { const f32x4 r = rr[64 * j]; s += (v[j].x * r.x + v[j].y * r.y) + (v[j].z * r.z + v[j].w * r.w); }
                s = wave_sum(s) * inv;
                if (lane == 0) lgs[o] = s;
            }
            LDS_WAIT(); __builtin_amdgcn_wave_barrier();
            if (lane == 0) {
                float lg[20];
#pragma unroll
                for (int o = 0; o < 20; ++o) lg[o] = lgs[o];
                float gl[4]; int gi = 0;
#pragma unroll
                for (int j = 0; j < 4; ++j) gl[j] = lg[j] + a.in[I_RGB][j];
                float gm = gl[0];
#pragma unroll
                for (int j = 1; j < 4; ++j) if (gl[j] > gm) { gm = gl[j]; gi = j; }
                float gs = 0.f;
#pragma unroll
                for (int j = 0; j < 4; ++j) gs += __expf(gl[j] - gm);
                const float gate = 1.f / gs;
                float el[4];
#pragma unroll
                for (int j = 0; j < 4; ++j) {
                    float x = 0.f;
#pragma unroll
                    for (int g2 = 0; g2 < 4; ++g2) x = (gi == g2) ? lg[4 + g2 * 4 + j] + a.in[I_REB][g2 * 4 + j] : x;
                    el[j] = x;
                }
                int i1 = 0; float v1 = el[0];
#pragma unroll
                for (int j = 1; j < 4; ++j) if (el[j] > v1) { v1 = el[j]; i1 = j; }
                int i2 = -1; float v2 = -3.0e38f;
#pragma unroll
                for (int j = 0; j < 4; ++j) if (j != i1 && el[j] > v2) { v2 = el[j]; i2 = j; }
                const float ex = __expf(v2 - v1), w1 = 1.f / (1.f + ex), w2 = ex * w1;
                rec_e[lt * 2 + 0] = gi * 4 + i1; rec_e[lt * 2 + 1] = gi * 4 + i2;
                rec_w[lt * 2 + 0] = w1 * gate; rec_w[lt * 2 + 1] = w2 * gate; rec_s[lt] = inv;
            }
        }
        __syncthreads();
        if (F.tid < 16) {
            const int e = F.tid; int n = 0;
            for (int p = 0; p < 256; ++p) n += (rec_e[p] == e) ? 1 : 0;
            int base = 0;
            if (n > 0) base = (int)__hip_atomic_fetch_add((unsigned*)(F.ctl + CW_CNT + 64 * e), (unsigned)n, RLX_AGENT);
            for (int p = 0; p < 256; ++p) if (rec_e[p] == e) {
                const int t = chunk * 128 + (p >> 1);
                ptok[e * T + base] = t | ((p & 1) ? (int)0x80000000 : 0); pcomb[e * T + base] = rec_w[p]; pscale[e * T + base] = rec_s[p >> 1]; ++base;
            }
        }
    }
    __syncthreads();
}
DI void moe_prefix(Frame& F) {
    volatile LAS int* tp = (volatile LAS int*)(F.lds + XTAB_OFF);
    __syncthreads();
    if (F.tid == 0) {
        int acc = 0;
        for (int e = 0; e < 16; ++e) { const int c = (int)__hip_atomic_load((unsigned*)(F.ctl + CW_CNT + 64 * e), RLX_AGENT); tp[e] = acc; tp[32 + e] = c; acc += (c + 255) >> 8; }
        tp[16] = acc;
    }
    __syncthreads();
}
DI void p12_final(const Args& a, Frame& F) {
    const bf16_t* pk0 = (const bf16_t*)(F.ws + WS_PK0); const bf16_t* pk1 = (const bf16_t*)(F.ws + WS_PK1); const float* nf = a.in[I_NFIN];
    const int lane = F.lane, gw = F.vcu * NWAVES + F.wave, NGW = F.G * NWAVES;
    for (int m = gw; m < T; m += NGW) {
        f32x4* hr = (f32x4*)(a.out + (size_t)m * 1024) + lane;
        f32x4 v[4]; float ss = 0.f;
#pragma unroll
        for (int j = 0; j < 4; ++j) {
            v[j] = hr[64 * j];
            const u32x2 p = *((const u32x2*)(pk0 + (size_t)m * 1024) + lane + 64 * j), r = *((const u32x2*)(pk1 + (size_t)m * 1024) + lane + 64 * j);
            v[j].x += bf2f(p.x & 0xffffu) + bf2f(r.x & 0xffffu); v[j].y += bf2f(p.x >> 16) + bf2f(r.x >> 16);
            v[j].z += bf2f(p.y & 0xffffu) + bf2f(r.y & 0xffffu); v[j].w += bf2f(p.y >> 16) + bf2f(r.y >> 16);
            ss += (v[j].x * v[j].x + v[j].y * v[j].y) + (v[j].z * v[j].z + v[j].w * v[j].w);
        }
        const float inv = 1.f / sqrtf(wave_sum(ss) * (1.f / 1024.f) + EPS);
#pragma unroll
        for (int j = 0; j < 4; ++j) { const f32x4 g = *((const f32x4*)nf + lane + 64 * j); hr[64 * j] = v[j] * inv * g; }
    }
}

constexpr int N_STEPS = 14;
#ifndef SKIPMASK
#define SKIPMASK 0
#endif
DI bool seam_after(int s) { return s != 1 && s != N_STEPS - 1; }
DI void grid_bar(CArgs* ap) {
    const Args a = phase_args(ap);
    extern __shared__ __attribute__((aligned(16))) unsigned char lds[];
    XcdBarrier b; b.bar = (unsigned*)(a.ws + WS_CTL) + CW_BAR; b.x = xb_xcc_id(); b.st = (volatile LAS unsigned*)((LAS unsigned char*)lds + MISC_OFF) + 8;
    xcd_barrier(b);
}
DI void gemm_step(int s, const Args& a, Frame& F, pg8::Gemm& g, pg8::USched& S, UEpi& E) {
    unsigned char* ws = a.ws;
    const volatile LAS int* tp = (const volatile LAS int*)(F.lds + XTAB_OFF);
    size_t oA = WS_A, oB = WS_W1T, oA2 = 0, oB2 = 0, bstride = 0; int K = 1024, M = T, N = 1024, mode = 0, id = E_PROJ;
    if (s == 1)       { N = INW; }
    else if (s == 2)  { oA = WS_MEMN; oB = WS_WKV; M = MROWS; N = 2048; id = E_KV; }
    else if (s == 4)  { oA = WS_YG; oB = WS_WGLU; K = 512; N = 512; id = E_GLU; }
    else if (s == 5)  { oA = WS_YP; oB = WS_WBRP; oA2 = WS_YS2; oB2 = WS_WBRS; K = 512; mode = 1; id = E_BR; }
    else if (s == 6)  { oA = WS_MG; oB = WS_WOUT; id = E_WOUT; }
    else if (s == 7)  { oB = WS_WQ; id = E_Q; }
    else if (s == 9)  { oA = WS_Q; oB = WS_WO; id = E_WO; }
    else if (s == 11) { oB = WS_W13; bstride = (size_t)1024 * 1024; mode = 2; id = E_UP; }
    else              { oA = WS_HID; oB = WS_W2T; K = 512; bstride = (size_t)1024 * 512; mode = 3; id = E_DOWN; }
    g.A = (const bf16_t*)(ws + oA); g.Bt = (const bf16_t*)(ws + oB); g.K = K; g.A2 = (const bf16_t*)(ws + oA2); g.Bt2 = (const bf16_t*)(ws + oB2); g.bstride = bstride;
    S.mode = mode; S.tp = tp; S.ptok = (const int*)(ws + WS_PTOK); S.nN = 4;
    S.so.init(M, N, F.G, F.bid);
    E.id = id; E.tp = tp; E.ws = ws; E.x = a.in[I_X]; E.out = a.out; E.glub = a.in[I_GLUB];
}
DI bool is_gemm_step(int s) { return s == 1 || s == 2 || s == 4 || s == 5 || s == 6 || s == 7 || s == 9 || s == 11 || s == 12; }

__global__ void __launch_bounds__(NWAVES * 64, 2) mk_fwd(Args args) {
    extern __shared__ __attribute__((aligned(16))) unsigned char lds[];
    CArgs* ap = (CArgs*)__builtin_amdgcn_kernarg_segment_ptr();
    const int lo = args.ph_lo, hi = args.ph_hi;
    {
        LAS unsigned char* l = (LAS unsigned char*)lds;
        for (int u = threadIdx.x; u < (LDS_BYTES - LDSCTL_OFF) / 4; u += NWAVES * 64) ((LAS unsigned*)(l + LDSCTL_OFF))[u] = 0u;
        __syncthreads();
        if (!MK_PER_PHASE) (void)xcd_barrier_post((unsigned*)(args.ws + WS_CTL) + CW_BAR, (volatile LAS unsigned*)(l + MISC_OFF) + 8);
    }
    for (int s = lo; s < hi; ++s) {
        if (!((SKIPMASK >> s) & 1)) {
            const Args a = phase_args(ap); Frame F = make_frame(a);
            if (is_gemm_step(s)) {
                if (s >= 11) moe_prefix(F);
                pg8::Gemm g; pg8::USched S; UEpi E;
                gemm_step(s, a, F, g, S, E);
                pg8::ngemm_phase(F.lds + RING_OFF, g, S, E, F.tid);
            } else if (s == 0) p0_prologue(a, F);
            else if (s == 3) { p2_pool(F); p2_ssm_naive(a, F); }
            else if (s == 8) p7_attn_naive(F);
            else if (s == 10) p9_router(a, F);
            else p12_final(a, F);
        }
        if (!MK_PER_PHASE && s + 1 < hi && seam_after(s)) grid_bar(ap);
    }
}

extern "C" void kernel_launch(void* const* d_in, const int* in_sizes, int n_in, void* d_out, int out_size, void* d_ws, size_t ws_size, hipStream_t stream) {
    static int grid = 0;
    if (grid == 0) {
        if (n_in != 33 || in_sizes[0] != T * D || out_size != T * D || ws_size < WS_END) {
            fprintf(stderr, "kernel_launch: shape/workspace mismatch (n_in %d, in0 %d, out %d, ws %zu, need %zu); nothing launched\n", n_in, n_in > 0 ? in_sizes[0] : -1, out_size, ws_size, (size_t)WS_END); grid = -1; return; }
        int dev = 0, cus = 0, per_cu = 0;
        if (hipGetDevice(&dev) != hipSuccess || hipDeviceGetAttribute(&cus, hipDeviceAttributeMultiprocessorCount, dev) != hipSuccess) { fprintf(stderr, "kernel_launch: device query failed\n"); grid = -1; return; }
        if (hipFuncSetAttribute((const void*)mk_fwd, hipFuncAttributeMaxDynamicSharedMemorySize, LDS_BYTES) != hipSuccess) { fprintf(stderr, "kernel_launch: hipFuncSetAttribute failed\n"); grid = -1; return; }
        if (hipOccupancyMaxActiveBlocksPerMultiprocessor(&per_cu, (const void*)mk_fwd, NWAVES * 64, LDS_BYTES) != hipSuccess || per_cu < 1) {
            fprintf(stderr, "kernel_launch: occupancy query reports %d workgroups per CU; nothing launched\n", per_cu); (void)hipGetLastError(); grid = -1; return; }
        grid = cus;
    }
    if (grid < 0) return;
    if (hipMemsetAsync((char*)d_ws + WS_CTL, 0, CTL_ZERO_BYTES, stream) != hipSuccess) { fprintf(stderr, "kernel_launch: memset failed\n"); return; }
    Args a{};
    for (int i = 0; i < 33; ++i) a.in[i] = (const float*)d_in[i];
    a.out = (float*)d_out; a.ws = (unsigned char*)d_ws;
    const int cuts[] = {0, 1, 3, 4, 5, 6, 7, 8, 9, 10, 11, 12, 13, 14};
    const int nl = MK_PER_PHASE ? 13 : 1;
    for (int li = 0; li < nl; ++li) {
        a.ph_lo = MK_PER_PHASE ? cuts[li] : 0; a.ph_hi = MK_PER_PHASE ? cuts[li + 1] : N_STEPS; a.li = li;
        hipLaunchKernelGGL(mk_fwd, dim3(grid), dim3(NWAVES * 64), LDS_BYTES, stream, a);
        const hipError_t le = hipPeekAtLastError();
        if (le != hipSuccess) { fprintf(stderr, "kernel_launch: launch %d failed: %s\n", li, hipGetErrorName(le)); break; }
    }
}
```

```cpp
#include <hip/hip_runtime.h>
#include <cstdio>
#include <cstdint>

#define GAS __attribute__((address_space(1)))
#define LAS __attribute__((address_space(3)))
typedef unsigned short bf16_t;
typedef float f32x4 __attribute__((ext_vector_type(4)));
typedef float f32x2 __attribute__((ext_vector_type(2)));
typedef unsigned u32x4 __attribute__((ext_vector_type(4)));
typedef unsigned u32x2 __attribute__((ext_vector_type(2)));
typedef short bf16x8 __attribute__((ext_vector_type(8)));
typedef GAS unsigned gu32;
#define RLX_AGENT __ATOMIC_RELAXED, __HIP_MEMORY_SCOPE_AGENT
#define LDS_WAIT() asm volatile("s_waitcnt lgkmcnt(0)" ::: "memory")
#define VM_WAIT() asm volatile("s_waitcnt vmcnt(0)" ::: "memory")
#define DI __device__ __forceinline__

#ifndef MK_PER_PHASE
#define MK_PER_PHASE 0
#endif

constexpr int BATCH = 4, SEQ = 8192, D = 1024, T = BATCH * SEQ;
constexpr int PW = 512, SW = 512, NSG = 32, GD = 16, NS = 64, INW = 3072;
constexpr int MEM = 256, XH = 4, XHD = 256, MROWS = BATCH * MEM;
constexpr int NE = 16, DE = 512;
constexpr float EPS = 1e-6f;
constexpr int NWAVES = 8;

constexpr size_t MiB = 1u << 20;
constexpr size_t WS_CTL = 0, CTL_ZERO_BYTES = 1 * MiB;
constexpr size_t WS_W1T = 1 * MiB;
constexpr size_t WS_WGLU = 7 * MiB;
constexpr size_t WS_WBRP = WS_WGLU + MiB / 2;
constexpr size_t WS_WBRS = WS_WBRP + MiB;
constexpr size_t WS_WOUT = WS_WBRS + MiB;
constexpr size_t WS_WQ = WS_WOUT + 2 * MiB;
constexpr size_t WS_WKV = WS_WQ + 2 * MiB;
constexpr size_t WS_WO = WS_WKV + 4 * MiB;
constexpr size_t WS_W13 = 20 * MiB;
constexpr size_t WS_W2T = 52 * MiB;
constexpr size_t WS_MEMN = 68 * MiB;
constexpr size_t WS_KC = 70 * MiB;
constexpr size_t WS_VT = 72 * MiB;
constexpr size_t WS_SSMT = 74 * MiB;
constexpr size_t WS_RT = 84 * MiB;
constexpr size_t WS_SSQ8 = 85 * MiB;
constexpr size_t WS_PTOK = 101 * MiB;
constexpr size_t WS_PCOMB = 103 * MiB;
constexpr size_t WS_PSCALE = 105 * MiB;
constexpr size_t WS_SLOC = 107 * MiB;
constexpr size_t WS_SSCAN = 109 * MiB;
constexpr size_t WS_A = 112 * MiB;
constexpr size_t WS_ZW = 176 * MiB;
constexpr size_t WS_VS = 208 * MiB;
constexpr size_t WS_MG = 176 * MiB;
constexpr size_t WS_Q = 176 * MiB;
constexpr size_t WS_G = 240 * MiB;
constexpr size_t WS_PK0 = 240 * MiB, WS_PK1 = 304 * MiB;
constexpr size_t WS_YP = 368 * MiB, WS_YG = 400 * MiB, WS_YS2 = 432 * MiB;
constexpr size_t WS_HID = 368 * MiB;
constexpr size_t WS_END = 464 * MiB;
constexpr int CW_TMO = 0, CW_CODE = 1;
constexpr int CW_BAR = 4096;
constexpr int CW_CNT = 16384;

constexpr int RING_OFF = 0, RING_BYTES = 131072;
constexpr int LDSCTL_OFF = RING_BYTES, MISC_OFF = LDSCTL_OFF + 320;
constexpr int XTAB_OFF = LDSCTL_OFF + 512;
constexpr int LDS_BYTES = 147456;

DI float bf2f(unsigned b) { return __uint_as_float(b << 16); }
DI unsigned f2bf(float f) { unsigned u = __float_as_uint(f); return (u + 0x7fffu + ((u >> 16) & 1u)) >> 16; }
DI unsigned pk2(float lo, float hi) { return f2bf(lo) | (f2bf(hi) << 16); }
DI float sigm(float x) { return 1.f / (1.f + __expf(-x)); }
DI float gelu_tanh(float x) { return x * sigm(1.5957691216057308f * (x + 0.044715f * x * x * x)); }
DI float wave_sum(float v) {
#pragma unroll
    for (int o = 1; o < 64; o <<= 1) v += __shfl_xor(v, o);
    return v;
}
DI float wave_max(float v) {
#pragma unroll
    for (int o = 1; o < 64; o <<= 1) v = fmaxf(v, __shfl_xor(v, o));
    return v;
}
DI void store8bf(bf16_t* p, const f32x4& a, const f32x4& b) {
    u32x4 w; w.x = pk2(a[0], a[1]); w.y = pk2(a[2], a[3]); w.z = pk2(b[0], b[1]); w.w = pk2(b[2], b[3]);
    *(u32x4*)p = w;
}
DI void load8bf(const bf16_t* p, f32x4& a, f32x4& b) {
    const u32x4 w = *(const u32x4*)p;
    a[0] = bf2f(w.x & 0xffffu); a[1] = bf2f(w.x >> 16); a[2] = bf2f(w.y & 0xffffu); a[3] = bf2f(w.y >> 16);
    b[0] = bf2f(w.z & 0xffffu); b[1] = bf2f(w.z >> 16); b[2] = bf2f(w.w & 0xffffu); b[3] = bf2f(w.w >> 16);
}

#define XB_TMO      128
#define XB_XCNT(j)  (256  + 64 * (j))
#define XB_XSUB(j)  (1280 + 64 * (j))
#define XB_XGEN(j)  (2304 + 64 * (j))
#define XB_TOP      3328
#define XB_TOPGEN   3392
#define XCD_BAR_WORDS 3456
#define XB_SPIN_CAP (1u << 18)
DI unsigned xb_ld(unsigned* p)              { return __hip_atomic_load(p, __ATOMIC_RELAXED, __HIP_MEMORY_SCOPE_AGENT); }
DI unsigned xb_add(unsigned* p, unsigned v) { return __hip_atomic_fetch_add(p, v, __ATOMIC_RELAXED, __HIP_MEMORY_SCOPE_AGENT); }
DI unsigned xb_xcc_id() { return (unsigned)__builtin_amdgcn_s_getreg((3 << 11) | 20) & 0xFu; }
#define XB_SPIN(cond, bar) do { unsigned _sp = 0; while (cond) { __builtin_amdgcn_s_sleep(1); \
    if ((++_sp & 255u) == 0u) { if (xb_ld(&(bar)[XB_TMO])) break; if (_sp > XB_SPIN_CAP) { atomicAdd(&(bar)[XB_TMO], 1u); break; } } } } while (0)
struct XcdBarrier { unsigned* bar; unsigned x; volatile LAS unsigned* st; };
DI XcdBarrier xcd_barrier_post(unsigned* bar, volatile LAS unsigned* st) {
    XcdBarrier b; b.bar = bar; b.x = xb_xcc_id(); b.st = st;
    if (threadIdx.x == 0) (void)xb_add(&bar[XB_XCNT(b.x)], 1u);
    return b;
}
DI void xcd_barrier_complete(unsigned* bar, unsigned x, unsigned& nloc, unsigned& nx) {
    const unsigned G = gridDim.x * gridDim.y * gridDim.z;
    unsigned sum, cnt, mine, sp = 0u;
    for (;;) {
        sum = 0u; cnt = 0u; mine = 0u;
#pragma unroll
        for (unsigned j = 0; j < 16; ++j) { const unsigned c = xb_ld(&bar[XB_XCNT(j)]); sum += c; cnt += (c > 0u) ? 1u : 0u; mine = (j == x) ? c : mine; }
        if (sum == G) break;
        __builtin_amdgcn_s_sleep(1);
        if ((++sp & 255u) == 0u) { if (xb_ld(&bar[XB_TMO])) break; if (sp > XB_SPIN_CAP) { atomicAdd(&bar[XB_TMO], 1u); break; } }
    }
    nloc = mine > 0u ? mine : 1u; nx = cnt > 0u ? cnt : 1u;
}
DI void xcd_barrier(const XcdBarrier& b) {
    asm volatile("s_waitcnt vmcnt(0)" ::: "memory");
    __syncthreads();
    if (threadIdx.x == 0) {
        unsigned* bar = b.bar;
        __builtin_amdgcn_s_waitcnt(0);
        unsigned nloc = b.st[0], nx = b.st[1];
        if (nloc == 0u) { xcd_barrier_complete(bar, b.x, nloc, nx); b.st[0] = nloc; b.st[1] = nx; }
        const unsigned old = xb_add(&bar[XB_XSUB(b.x)], 1u);
        const unsigned gen = old / nloc;
        if (old + 1u == (gen + 1u) * nloc) {
            __builtin_amdgcn_fence(__ATOMIC_RELEASE, "agent");
            asm volatile("s_waitcnt vmcnt(0)" ::: "memory");
            const unsigned og = xb_add(&bar[XB_TOP], 1u);
            const unsigned tg = og / nx;
            if (og + 1u == (tg + 1u) * nx) xb_add(&bar[XB_TOPGEN], 1u);
            else XB_SPIN(xb_ld(&bar[XB_TOPGEN]) == tg, bar);
            __builtin_amdgcn_fence(__ATOMIC_ACQUIRE, "agent");
            xb_add(&bar[XB_XGEN(b.x)], 1u);
            asm volatile("s_waitcnt vmcnt(0)" ::: "memory");
        } else {
            XB_SPIN(xb_ld(&bar[XB_XGEN(b.x)]) == gen, bar);
            __builtin_amdgcn_fence(__ATOMIC_ACQUIRE, "agent");
            asm volatile("s_waitcnt vmcnt(0)" ::: "memory");
        }
    }
    __syncthreads();
}

namespace pg8 {
constexpr int BM = 256, BK = 64, HALF = 128, NXCD = 8, WGM = 8;
struct Unit { int pm, pn, e; };
struct Gemm { const bf16_t* A; const bf16_t* Bt; int K; const bf16_t* A2; const bf16_t* Bt2; size_t bstride; };

struct StaticOrder {
    int nM, nN, nwg, G, c;
    DI void init(int M, int N, int G_, int c_) { nM = M / BM; nN = N / BM; nwg = nM * nN; G = G_; c = c_; }
    DI bool tile(int L, Unit& u) const {
        if (L >= nwg) return false;
        int wgid = L; { const int q = nwg / NXCD, r = nwg % NXCD, xcd = wgid % NXCD, off = wgid / NXCD; wgid = (xcd < r ? xcd * (q + 1) : r * (q + 1) + (xcd - r) * q) + off; }
        const int nig = WGM * nN, gid = wgid / nig, fm = gid * WGM, gsz = (nM - fm) < WGM ? (nM - fm) : WGM;
        u.pm = fm + ((wgid % nig) % gsz); u.pn = (wgid % nig) / gsz; u.e = 0; return true;
    }
    DI bool next(int i, Unit& u) const { return tile(i * G + c, u); }
    DI const bf16_t* a_base(const Gemm& g, const Unit&) const { return g.A; }
    DI const bf16_t* a_row(const Gemm& g, const Unit& u, int r) const { return g.A + (size_t)(u.pm * BM + r) * g.K; }
    DI const bf16_t* b_row(const Gemm& g, const Unit& u, int n) const { return g.Bt + (size_t)(u.pn * BM + n) * g.K; }
};
struct USched {
    int mode; StaticOrder so; const volatile LAS int* tp; const int* ptok; int nN;
    DI bool next(int i, Unit& u) const {
        if (mode == 0) return so.tile(i * so.G + so.c, u);
        if (mode == 1) { if (!so.tile((i >> 1) * so.G + so.c, u)) return false; u.e = i & 1; return true; }
        const int L = i * so.G + so.c, total = tp[16] * nN; if (L >= total) return false;
        const int mt = L / nN; int e = 0;
#pragma unroll
        for (int j = 1; j < 16; ++j) e += (mt >= tp[j]) ? 1 : 0;
        u.pm = __builtin_amdgcn_readfirstlane(mt); u.pn = __builtin_amdgcn_readfirstlane(L % nN); u.e = __builtin_amdgcn_readfirstlane(e); return true;
    }
    DI const bf16_t* a_base(const Gemm& g, const Unit& u) const { return (mode == 1 && u.e) ? g.A2 : g.A; }
    DI const bf16_t* a_row(const Gemm& g, const Unit& u, int r) const {
        if (mode == 2) {
            const int slot = (u.pm - tp[u.e]) * BM + r; const int cnt = tp[32 + u.e];
            const int tok = slot < cnt ? (ptok[u.e * T + slot] & 0x7fffffff) : 0;
            return g.A + (size_t)tok * g.K;
        }
        return a_base(g, u) + (size_t)(u.pm * BM + r) * g.K;
    }
    DI const bf16_t* b_row(const Gemm& g, const Unit& u, int n) const {
        const bf16_t* b = (mode == 1 && u.e) ? g.Bt2 : g.Bt;
        if (mode >= 2) b += (size_t)u.e * g.bstride;
        return b + (size_t)(u.pn * BM + n) * g.K;
    }
};


template <class Epi, class Sched>
DI void ngemm_phase(LAS unsigned char* lds, const Gemm g, const Sched& S, const Epi& E, const int tid) {
    LAS float* As = (LAS float*)lds;
    LAS float* Bs = As + 16 * 132;
    const int lr = tid >> 2, kq = tid & 3, tx = tid & 15, ty = tid >> 4;
    Unit u;
    for (int i = 0; S.next(i, u); ++i) {
        for (int sub = 0; sub < 4; ++sub) {
            const int sm = (sub >> 1) * 128, sn = (sub & 1) * 128;
            float acc[4][8];
#pragma unroll
            for (int r = 0; r < 4; ++r)
#pragma unroll
                for (int c = 0; c < 8; ++c) acc[r][c] = 0.f;
            const bf16_t* arow = S.a_row(g, u, sm + lr) + kq * 4;
            const bf16_t* brow = S.b_row(g, u, sn + lr) + kq * 4;
            for (int k0 = 0; k0 < g.K; k0 += 16) {
                __syncthreads();
                const u32x2 av = *(const u32x2*)(arow + k0), bv = *(const u32x2*)(brow + k0);
                As[(kq * 4 + 0) * 132 + lr] = bf2f(av.x & 0xffffu); As[(kq * 4 + 1) * 132 + lr] = bf2f(av.x >> 16);
                As[(kq * 4 + 2) * 132 + lr] = bf2f(av.y & 0xffffu); As[(kq * 4 + 3) * 132 + lr] = bf2f(av.y >> 16);
                Bs[(kq * 4 + 0) * 132 + lr] = bf2f(bv.x & 0xffffu); Bs[(kq * 4 + 1) * 132 + lr] = bf2f(bv.x >> 16);
                Bs[(kq * 4 + 2) * 132 + lr] = bf2f(bv.y & 0xffffu); Bs[(kq * 4 + 3) * 132 + lr] = bf2f(bv.y >> 16);
                __syncthreads();
#pragma unroll
                for (int k = 0; k < 16; ++k) {
                    const f32x4 a4 = *(const LAS f32x4*)(As + k * 132 + ty * 4);
                    const f32x4 b0 = *(const LAS f32x4*)(Bs + k * 132 + tx * 8), b1 = *(const LAS f32x4*)(Bs + k * 132 + tx * 8 + 4);
#pragma unroll
                    for (int r = 0; r < 4; ++r) {
#pragma unroll
                        for (int c = 0; c < 4; ++c) { acc[r][c] += a4[r] * b0[c]; acc[r][4 + c] += a4[r] * b1[c]; }
                    }
                }
            }
#pragma unroll
            for (int r = 0; r < 4; ++r) {
                f32x4 v0 = {acc[r][0], acc[r][1], acc[r][2], acc[r][3]}, v1 = {acc[r][4], acc[r][5], acc[r][6], acc[r][7]};
                E(u, u.pm * BM + sm + ty * 4 + r, u.pn * BM + sn + tx * 8, v0, v1);
            }
        }
    }
    __syncthreads();
}
}

struct FProj {
    bf16_t* zw; bf16_t* vs; bf16_t* g;
    DI void operator()(const pg8::Unit&, int row, int col, f32x4& v0, f32x4& v1) const {
        if (col < 512) store8bf(zw + (size_t)row * 512 + col, v0, v1);
        else if (col < 1024) store8bf(vs + (size_t)row * 512 + (col - 512), v0, v1);
        else {
            f32x4 a, b;
#pragma unroll
            for (int j = 0; j < 4; ++j) { a[j] = sigm(v0[j]); b[j] = sigm(v1[j]); }
            store8bf(g + (size_t)row * 2048 + (col - 1024), a, b);
        }
    }
};
struct FKV {
    bf16_t* kc; bf16_t* vt;
    DI void operator()(const pg8::Unit&, int row, int col, f32x4& v0, f32x4& v1) const {
        if (col < 1024) store8bf(kc + (size_t)row * 1024 + col, v0, v1);
        else {
            const int c = col - 1024, h = c >> 8, d = c & 255, b = row >> 8, key = row & 255;
            bf16_t* p = vt + ((size_t)((b * 4 + h) * 256 + d)) * 256 + key;
#pragma unroll
            for (int j = 0; j < 4; ++j) { p[(size_t)j * 256] = (bf16_t)f2bf(v0[j]); p[(size_t)(4 + j) * 256] = (bf16_t)f2bf(v1[j]); }
        }
    }
};
struct FGlu {
    const bf16_t* yg; const float* bias; bf16_t* ys2;
    DI void operator()(const pg8::Unit&, int row, int col, f32x4& v0, f32x4& v1) const {
        f32x4 y0, y1; load8bf(yg + (size_t)row * 512 + col, y0, y1);
        const f32x4 b0 = *(const f32x4*)(bias + col), b1 = *(const f32x4*)(bias + col + 4);
        f32x4 a, b;
#pragma unroll
        for (int j = 0; j < 4; ++j) { a[j] = y0[j] * sigm(v0[j] + b0[j]); b[j] = y1[j] * sigm(v1[j] + b1[j]); }
        store8bf(ys2 + (size_t)row * 512 + col, a, b);
    }
};
struct FBrNaive {
    const bf16_t* g; float* tmp; bf16_t* mg;
    DI void operator()(const pg8::Unit& u, int row, int col, f32x4& v0, f32x4& v1) const {
        f32x4 g0, g1; load8bf(g + (size_t)row * 2048 + (u.e ? 1024 : 0) + col, g0, g1);
        float* tp = tmp + (size_t)row * 1024 + col;
        if (u.e == 0) { *(f32x4*)tp = g0 * v0; *(f32x4*)(tp + 4) = g1 * v1; }
        else { const f32x4 t0 = *(const f32x4*)tp, t1 = *(const f32x4*)(tp + 4); store8bf(mg + (size_t)row * 1024 + col, t0 + g0 * v0, t1 + g1 * v1); }
    }
};
struct FWout {
    const float* x; float* out; bf16_t* hb; float* ssq8;
    DI void operator()(const pg8::Unit&, int row, int col, f32x4& v0, f32x4& v1) const {
        const size_t o = (size_t)row * 1024 + col;
        const f32x4 h0 = *(const f32x4*)(x + o) + v0, h1 = *(const f32x4*)(x + o + 4) + v1;
        *(f32x4*)(out + o) = h0; *(f32x4*)(out + o + 4) = h1;
        store8bf(hb + o, h0, h1);
        ssq8[(size_t)row * 128 + (col >> 3)] = (h0[0] * h0[0] + h0[1] * h0[1]) + (h0[2] * h0[2] + h0[3] * h0[3]) + (h1[0] * h1[0] + h1[1] * h1[1]) + (h1[2] * h1[2] + h1[3] * h1[3]);
    }
};
struct FStoreBf {
    bf16_t* o;
    DI void operator()(const pg8::Unit&, int row, int col, f32x4& v0, f32x4& v1) const { store8bf(o + (size_t)row * 1024 + col, v0, v1); }
};
struct FWo {
    float* out; bf16_t* hb;
    DI void operator()(const pg8::Unit&, int row, int col, f32x4& v0, f32x4& v1) const {
        const size_t o = (size_t)row * 1024 + col;
        const f32x4 h0 = *(const f32x4*)(out + o) + v0, h1 = *(const f32x4*)(out + o + 4) + v1;
        *(f32x4*)(out + o) = h0; *(f32x4*)(out + o + 4) = h1;
        store8bf(hb + o, h0, h1);
    }
};
struct FUp {
    const volatile LAS int* tp; const float* pscale; bf16_t* hid;
    DI void operator()(const pg8::Unit& u, int row, int col, f32x4& v0, f32x4& v1) const {
        const int slot = row - tp[u.e] * 256;
        if (slot < tp[32 + u.e]) {
            const float s = pscale[u.e * T + slot];
            u32x2 w; float h[4];
#pragma unroll
            for (int j = 0; j < 4; ++j) { const float a = v0[j] * s, b = v1[j] * s; h[j] = a * sigm(a) * b; }
            w.x = pk2(h[0], h[1]); w.y = pk2(h[2], h[3]);
            *(u32x2*)(hid + (size_t)row * 512 + (col >> 1)) = w;
        }
    }
};
struct FDown {
    const volatile LAS int* tp; const int* ptok; const float* pcomb; bf16_t* pk0; bf16_t* pk1;
    DI void operator()(const pg8::Unit& u, int row, int col, f32x4& v0, f32x4& v1) const {
        const int slot = row - tp[u.e] * 256;
        if (slot < tp[32 + u.e]) {
            const int t = ptok[u.e * T + slot]; const float c = pcomb[u.e * T + slot];
            bf16_t* dst = ((t < 0) ? pk1 : pk0) + (size_t)(t & 0x7fffffff) * 1024 + col;
            store8bf(dst, v0 * c, v1 * c);
        }
    }
};

enum { E_PROJ = 0, E_KV, E_GLU, E_BR, E_WOUT, E_Q, E_WO, E_UP, E_DOWN };
struct UEpi {
    int id; const volatile LAS int* tp; unsigned char* ws; const float* x; float* out; const float* glub;
    DI void operator()(const pg8::Unit& u, int row, int col, f32x4& v0, f32x4& v1) const {
        switch (id) {
        case E_PROJ: FProj{(bf16_t*)(ws + WS_ZW), (bf16_t*)(ws + WS_VS), (bf16_t*)(ws + WS_G)}(u, row, col, v0, v1); break;
        case E_KV:   FKV{(bf16_t*)(ws + WS_KC), (bf16_t*)(ws + WS_VT)}(u, row, col, v0, v1); break;
        case E_GLU:  FGlu{(const bf16_t*)(ws + WS_YG), glub, (bf16_t*)(ws + WS_YS2)}(u, row, col, v0, v1); break;
        case E_BR:   FBrNaive{(const bf16_t*)(ws + WS_G), out, (bf16_t*)(ws + WS_MG)}(u, row, col, v0, v1); break;
        case E_WOUT: FWout{x, out, (bf16_t*)(ws + WS_A), (float*)(ws + WS_SSQ8)}(u, row, col, v0, v1); break;
        case E_Q:    FStoreBf{(bf16_t*)(ws + WS_Q)}(u, row, col, v0, v1); break;
        case E_WO:   FWo{out, (bf16_t*)(ws + WS_A)}(u, row, col, v0, v1); break;
        case E_UP:   FUp{tp, (const float*)(ws + WS_PSCALE), (bf16_t*)(ws + WS_HID)}(u, row, col, v0, v1); break;
        default:     FDown{tp, (const int*)(ws + WS_PTOK), (const float*)(ws + WS_PCOMB), (bf16_t*)(ws + WS_PK0), (bf16_t*)(ws + WS_PK1)}(u, row, col, v0, v1); break;
        }
    }
};

struct Args { const float* in[33]; float* out; unsigned char* ws; int ph_lo, ph_hi, li, pad; };
struct Frame {
    LAS unsigned char* lds; volatile LAS unsigned* MISC; gu32* ctl;
    int tid, lane, wave, vcu, G, bid; unsigned char* ws;
};
typedef __attribute__((address_space(4))) const Args CArgs;
#if defined(__HIP_DEVICE_COMPILE__)
DI Args phase_args(CArgs* p) { asm volatile("" : "+s"(p)); return *p; }
#else
DI Args phase_args(CArgs* p) { return Args{}; }
#endif
DI Frame make_frame(const Args& a) {
    Frame F;
    extern __shared__ __attribute__((aligned(16))) unsigned char lds[];
    F.lds = (LAS unsigned char*)lds;
    F.MISC = (volatile LAS unsigned*)(F.lds + MISC_OFF);
    { int t = threadIdx.x; asm volatile("" : "+v"(t)); F.tid = t; }
    F.lane = F.tid & 63; F.wave = __builtin_amdgcn_readfirstlane(F.tid >> 6);
    int bx = blockIdx.x, gx = gridDim.x; asm volatile("" : "+s"(bx), "+s"(gx));
    F.G = gx; F.bid = bx; F.vcu = (F.G % 8 == 0) ? (bx % 8) * (F.G / 8) + bx / 8 : bx;
    F.ws = a.ws; F.ctl = (gu32*)(a.ws + WS_CTL);
    return F;
}
enum { I_X = 0, I_MEM, I_NMIX, I_WIN, I_POOLW, I_POOLS, I_ARE, I_AIM, I_LOGDT, I_BRE, I_BIM, I_CRE, I_CIM, I_SD, I_GLUW, I_GLUB, I_BRP, I_BRS,
       I_WOUT, I_NX, I_NMEM, I_WQ, I_WKV, I_WO, I_NFFN, I_RGW, I_RGB, I_REW, I_REB, I_W1, I_W3, I_W2, I_NFIN };

template <class RM>
DI void tr_item(const float* W, int K, int ld, int nblk, bf16_t* WT, const float* kscale, RM rm, LAS float* scr, int item, int lane) {
    const int kb = item / nblk, nb = item % nblk, k0 = 64 * kb, n0 = 32 * nb;
#pragma unroll 8
    for (int i = 0; i < 32; ++i) { const int kk = 2 * i + (lane >> 5); const float s = kscale ? kscale[k0 + kk] : 1.f; scr[kk * 33 + (lane & 31)] = W[(size_t)(k0 + kk) * ld + n0 + (lane & 31)] * s; }
    LDS_WAIT(); asm volatile("" ::: "memory");
    const int c = lane & 7;
#pragma unroll
    for (int j = 0; j < 4; ++j) { const int n = (lane >> 3) + 8 * j; const LAS float* s = scr + (8 * c) * 33 + n;
        u32x4 o; o.x = pk2(s[0 * 33], s[1 * 33]); o.y = pk2(s[2 * 33], s[3 * 33]); o.z = pk2(s[4 * 33], s[5 * 33]); o.w = pk2(s[6 * 33], s[7 * 33]);
        *(u32x4*)(WT + (size_t)rm(n0 + n) * K + k0 + 8 * c) = o; }
    LDS_WAIT(); asm volatile("" ::: "memory");
}
struct RmId { int off; DI int operator()(int n) const { return off + n; } };
struct RmIl { int off; DI int operator()(int n) const { return 8 * (n >> 2) + (n & 3) + off; } };
DI void rms_row_to_bf16(const float* xrow, bf16_t* orow, int lane) {
    const f32x4* xr = (const f32x4*)xrow + lane;
    f32x4 v[4]; float s = 0.f;
#pragma unroll
    for (int j = 0; j < 4; ++j) { v[j] = xr[64 * j]; s += (v[j].x * v[j].x + v[j].y * v[j].y) + (v[j].z * v[j].z + v[j].w * v[j].w); }
    const float r = 1.f / sqrtf(wave_sum(s) * (1.f / 1024.f) + EPS);
    u32x2* o8 = (u32x2*)orow + lane;
#pragma unroll
    for (int j = 0; j < 4; ++j) { u32x2 w; w.x = pk2(v[j].x * r, v[j].y * r); w.y = pk2(v[j].z * r, v[j].w * r); o8[64 * j] = w; }
}
DI void p0_prologue(const Args& a, Frame& F) {
    unsigned char* ws = F.ws;
    LAS float* scr = (LAS float*)(F.lds + RING_OFF + F.wave * 16384);
    const int gw = F.vcu * NWAVES + F.wave, NGW = F.G * NWAVES, lane = F.lane;
    constexpr int I0 = 16 * 80;
    constexpr int I1 = I0 + 8 * 16;
    constexpr int I2 = I1 + 8 * 32;
    constexpr int I3 = I2 + 8 * 32;
    constexpr int I4 = I3 + 16 * 32;
    constexpr int I5 = I4 + 16 * 32;
    constexpr int I6 = I5 + 16 * 64;
    constexpr int I7 = I6 + 16 * 32;
    constexpr int I8 = I7 + 16 * 256;
    constexpr int I9 = I8 + 16 * 256;
    constexpr int I10 = I9 + 16 * 256;
    for (int it = gw; it < I10; it += NGW) {
        if (it < I0) tr_item(a.in[I_WIN] + 512, 1024, 3072, 80, (bf16_t*)(ws + WS_W1T), a.in[I_NMIX], RmId{512}, scr, it, lane);
        else if (it < I1) tr_item(a.in[I_GLUW], 512, 512, 16, (bf16_t*)(ws + WS_WGLU), nullptr, RmId{0}, scr, it - I0, lane);
        else if (it < I2) tr_item(a.in[I_BRP], 512, 1024, 32, (bf16_t*)(ws + WS_WBRP), nullptr, RmId{0}, scr, it - I1, lane);
        else if (it < I3) tr_item(a.in[I_BRS], 512, 1024, 32, (bf16_t*)(ws + WS_WBRS), nullptr, RmId{0}, scr, it - I2, lane);
        else if (it < I4) tr_item(a.in[I_WOUT], 1024, 1024, 32, (bf16_t*)(ws + WS_WOUT), nullptr, RmId{0}, scr, it - I3, lane);
        else if (it < I5) tr_item(a.in[I_WQ], 1024, 1024, 32, (bf16_t*)(ws + WS_WQ), a.in[I_NX], RmId{0}, scr, it - I4, lane);
        else if (it < I6) tr_item(a.in[I_WKV], 1024, 2048, 64, (bf16_t*)(ws + WS_WKV), a.in[I_NMEM], RmId{0}, scr, it - I5, lane);
        else if (it < I7) tr_item(a.in[I_WO], 1024, 1024, 32, (bf16_t*)(ws + WS_WO), nullptr, RmId{0}, scr, it - I6, lane);
        else if (it < I8) { const int r = it - I7, e = r >> 8; tr_item(a.in[I_W1] + (size_t)e * 1024 * 512, 1024, 512, 16, (bf16_t*)(ws + WS_W13) + (size_t)e * 1024 * 1024, a.in[I_NFFN], RmIl{0}, scr, r & 255, lane); }
        else if (it < I9) { const int r = it - I8, e = r >> 8; tr_item(a.in[I_W3] + (size_t)e * 1024 * 512, 1024, 512, 16, (bf16_t*)(ws + WS_W13) + (size_t)e * 1024 * 1024, a.in[I_NFFN], RmIl{4}, scr, r & 255, lane); }
        else { const int r = it - I9, e = r >> 8; tr_item(a.in[I_W2] + (size_t)e * 512 * 1024, 512, 1024, 32, (bf16_t*)(ws + WS_W2T) + (size_t)e * 1024 * 512, nullptr, RmId{0}, scr, r & 255, lane); }
    }
    {
        const float* win = a.in[I_WIN]; const float* pw = a.in[I_POOLW]; const float* ps = a.in[I_POOLS]; const float* nm = a.in[I_NMIX];
        bf16_t* w1t = (bf16_t*)(ws + WS_W1T);
        for (int it = F.vcu * 512 + F.tid; it < 512 * 128; it += F.G * 512) {
            const int n = it & 511, kb = it >> 9, g = n >> 7, d = n & 127, k0 = kb * 8;
            float acc[8];
#pragma unroll
            for (int j = 0; j < 8; ++j) acc[j] = 0.f;
            for (int c = 0; c < 128; ++c) {
                const float p = pw[(size_t)(g * 128 + c) * 128 + d];
#pragma unroll
                for (int j = 0; j < 8; ++j) acc[j] += win[(size_t)(k0 + j) * 3072 + g * 128 + c] * p;
            }
            const float sc = ps[n];
            u32x4 o;
            o.x = pk2(acc[0] * sc * nm[k0 + 0], acc[1] * sc * nm[k0 + 1]); o.y = pk2(acc[2] * sc * nm[k0 + 2], acc[3] * sc * nm[k0 + 3]);
            o.z = pk2(acc[4] * sc * nm[k0 + 4], acc[5] * sc * nm[k0 + 5]); o.w = pk2(acc[6] * sc * nm[k0 + 6], acc[7] * sc * nm[k0 + 7]);
            *(u32x4*)(w1t + (size_t)n * 1024 + k0) = o;
        }
    }
    {
        float* rt = (float*)(ws + WS_RT); const float* nf = a.in[I_NFFN];
        for (int it = F.vcu * 512 + F.tid; it < 20 * 1024; it += F.G * 512) {
            const int j = it >> 10, k = it & 1023;
            rt[it] = nf[k] * (j < 4 ? a.in[I_RGW][k * 4 + j] : a.in[I_REW][k * 16 + (j - 4)]);
        }
    }
    for (int m = gw; m < T; m += NGW) rms_row_to_bf16(a.in[I_X] + (size_t)m * D, (bf16_t*)(ws + WS_A) + (size_t)m * D, lane);
    for (int m = gw; m < MROWS; m += NGW) rms_row_to_bf16(a.in[I_MEM] + (size_t)m * D, (bf16_t*)(ws + WS_MEMN) + (size_t)m * D, lane);
}

DI void p2_pool(Frame& F) {
    const bf16_t* zw = (const bf16_t*)(F.ws + WS_ZW); bf16_t* yp = (bf16_t*)(F.ws + WS_YP);
    for (int it = F.vcu * 512 + F.tid; it < T * 64; it += F.G * 512) {
        const int t = it >> 6, ch = (it & 63) * 8, s = t & (SEQ - 1), w = 2 << (ch >> 7), cnt = (s + 1 < w) ? s + 1 : w;
        f32x4 z0, z1; load8bf(zw + (size_t)t * 512 + ch, z0, z1);
        f32x4 s0 = z0, s1 = z1;
        for (int j = 1; j < cnt; ++j) { f32x4 a, b; load8bf(zw + (size_t)(t - j) * 512 + ch, a, b); s0 += a; s1 += b; }
        const float inv = 1.f / (float)cnt;
        store8bf(yp + (size_t)t * 512 + ch, s0 * inv - z0, s1 * inv - z1);
    }
}
DI void p2_ssm_naive(const Args& a, Frame& F) {
    if (F.wave != 0) return;
    const bf16_t* vs = (const bf16_t*)(F.ws + WS_VS); bf16_t* yg = (bf16_t*)(F.ws + WS_YG);
    const int n = F.lane;
    for (int item = F.vcu; item < BATCH * NSG; item += F.G) {
        const int b = item >> 5, g = item & 31;
        const float dt = expf(a.in[I_LOGDT][g]), ar = a.in[I_ARE][g * 64 + n], ai = a.in[I_AIM][g * 64 + n];
        const float mag = expf(ar * dt); float sn, cs; sincosf(ai * dt, &sn, &cs);
        const float lr = mag * cs, li = mag * sn, den = ar * ar + ai * ai, nr = lr - 1.f, ni = li;
        const float fre = (nr * ar + ni * ai) / den, fim = (ni * ar - nr * ai) / den;
        float bbr[16], bbi[16], cr[16], ci[16], dsk[16];
#pragma unroll
        for (int c = 0; c < 16; ++c) {
            const float br = a.in[I_BRE][(size_t)(g * 64 + n) * 16 + c], bi = a.in[I_BIM][(size_t)(g * 64 + n) * 16 + c];
            bbr[c] = fre * br - fim * bi; bbi[c] = fre * bi + fim * br;
            cr[c] = a.in[I_CRE][(size_t)(g * 16 + c) * 64 + n]; ci[c] = a.in[I_CIM][(size_t)(g * 16 + c) * 64 + n];
            dsk[c] = (n == 0) ? a.in[I_SD][g * 16 + c] : 0.f;
        }
        float hr = 0.f, hi = 0.f;
        const int myc = (((n >> 5) & 1) << 3) | (((n >> 4) & 1) << 2) | (((n >> 3) & 1) << 1) | ((n >> 2) & 1);
        for (int s = 0; s < SEQ; ++s) {
            const size_t t = (size_t)b * SEQ + s;
            f32x4 va, vb, vc, vd; load8bf(vs + t * 512 + g * 16, va, vb); load8bf(vs + t * 512 + g * 16 + 8, vc, vd);
            float v[16];
#pragma unroll
            for (int j = 0; j < 4; ++j) { v[j] = va[j]; v[4 + j] = vb[j]; v[8 + j] = vc[j]; v[12 + j] = vd[j]; }
            float ur = 0.f, ui = 0.f;
#pragma unroll
            for (int c = 0; c < 16; ++c) { ur += bbr[c] * v[c]; ui += bbi[c] * v[c]; }
            const float nhr = lr * hr - li * hi + ur, nhi = lr * hi + li * hr + ui; hr = nhr; hi = nhi;
            float p[16];
#pragma unroll
            for (int c = 0; c < 16; ++c) p[c] = cr[c] * hr - ci[c] * hi + dsk[c] * v[c];
#pragma unroll
            for (int i = 0; i < 8; ++i) { const bool up = (n & 32) != 0; const float keep = up ? p[i + 8] : p[i], send = up ? p[i] : p[i + 8]; p[i] = keep + __shfl_xor(send, 32); }
#pragma unroll
            for (int i = 0; i < 4; ++i) { const bool up = (n & 16) != 0; const float keep = up ? p[i + 4] : p[i], send = up ? p[i] : p[i + 4]; p[i] = keep + __shfl_xor(send, 16); }
#pragma unroll
            for (int i = 0; i < 2; ++i) { const bool up = (n & 8) != 0; const float keep = up ? p[i + 2] : p[i], send = up ? p[i] : p[i + 2]; p[i] = keep + __shfl_xor(send, 8); }
            { const bool up = (n & 4) != 0; const float keep = up ? p[1] : p[0], send = up ? p[0] : p[1]; p[0] = keep + __shfl_xor(send, 4); }
            float y = p[0]; y += __shfl_xor(y, 1); y += __shfl_xor(y, 2);
            if ((n & 3) == 0) yg[t * 512 + g * 16 + myc] = (bf16_t)f2bf(gelu_tanh(y));
        }
    }
}

DI void p7_attn_naive(Frame& F) {
    bf16_t* q = (bf16_t*)(F.ws + WS_Q); const bf16_t* kc = (const bf16_t*)(F.ws + WS_KC); const bf16_t* vt = (const bf16_t*)(F.ws + WS_VT);
    const float* ssq8 = (const float*)(F.ws + WS_SSQ8);
    LAS float* qs = (LAS float*)(F.lds + F.wave * 2048); LAS float* ps = qs + 256;
    const int lane = F.lane, gw = F.vcu * NWAVES + F.wave, NGW = F.G * NWAVES;
    for (int it = gw; it < T * XH; it += NGW) {
        const int t = it >> 2, h = it & 3, b = t >> 13;
        const float inv = 1.f / sqrtf(wave_sum(ssq8[(size_t)t * 128 + lane] + ssq8[(size_t)t * 128 + 64 + lane]) * (1.f / 1024.f) + EPS);
        { const u32x2 w = *(const u32x2*)(q + (size_t)t * 1024 + h * 256 + lane * 4);
          qs[lane * 4 + 0] = bf2f(w.x & 0xffffu); qs[lane * 4 + 1] = bf2f(w.x >> 16); qs[lane * 4 + 2] = bf2f(w.y & 0xffffu); qs[lane * 4 + 3] = bf2f(w.y >> 16); }
        LDS_WAIT(); __builtin_amdgcn_wave_barrier();
        float sc[4];
#pragma unroll
        for (int kk = 0; kk < 4; ++kk) {
            const bf16_t* kr = kc + (size_t)(b * 256 + kk * 64 + lane) * 1024 + h * 256; float s = 0.f;
#pragma unroll 1
            for (int d = 0; d < 256; d += 8) { f32x4 k0, k1; load8bf(kr + d, k0, k1); const f32x4 q0 = *(const LAS f32x4*)(qs + d), q1 = *(const LAS f32x4*)(qs + d + 4);
                s += (k0[0] * q0[0] + k0[1] * q0[1]) + (k0[2] * q0[2] + k0[3] * q0[3]) + (k1[0] * q1[0] + k1[1] * q1[1]) + (k1[2] * q1[2] + k1[3] * q1[3]); }
            sc[kk] = s * inv * 0.0625f;
        }
        const float m = wave_max(fmaxf(fmaxf(sc[0], sc[1]), fmaxf(sc[2], sc[3])));
        float l = 0.f;
#pragma unroll
        for (int kk = 0; kk < 4; ++kk) { const float p = __expf(sc[kk] - m); l += p; ps[kk * 64 + lane] = p; }
        l = wave_sum(l);
        LDS_WAIT(); __builtin_amdgcn_wave_barrier();
        float o[4] = {0.f, 0.f, 0.f, 0.f};
#pragma unroll
        for (int j = 0; j < 4; ++j) {
            const bf16_t* vr = vt + ((size_t)((b * 4 + h) * 256 + lane * 4 + j)) * 256;
#pragma unroll 1
            for (int k = 0; k < 256; k += 8) { f32x4 v0, v1; load8bf(vr + k, v0, v1); const f32x4 p0 = *(const LAS f32x4*)(ps + k), p1 = *(const LAS f32x4*)(ps + k + 4);
                o[j] += (v0[0] * p0[0] + v0[1] * p0[1]) + (v0[2] * p0[2] + v0[3] * p0[3]) + (v1[0] * p1[0] + v1[1] * p1[1]) + (v1[2] * p1[2] + v1[3] * p1[3]); }
        }
        const float il = 1.f / l;
        u32x2 w; w.x = pk2(o[0] * il, o[1] * il); w.y = pk2(o[2] * il, o[3] * il);
        *(u32x2*)(q + (size_t)t * 1024 + h * 256 + lane * 4) = w;
        LDS_WAIT(); __builtin_amdgcn_wave_barrier();
    }
}

DI void p9_router(const Args& a, Frame& F) {
    const float* h2 = a.out; const float* rt = (const float*)(F.ws + WS_RT);
    int* ptok = (int*)(F.ws + WS_PTOK); float* pcomb = (float*)(F.ws + WS_PCOMB); float* pscale = (float*)(F.ws + WS_PSCALE);
    LAS int* rec_e = (LAS int*)(F.lds);
    LAS float* rec_w = (LAS float*)(F.lds + 1024);
    LAS float* rec_s = (LAS float*)(F.lds + 2048);
    const int lane = F.lane;
    for (int chunk = F.vcu; chunk < T / 128; chunk += F.G) {
        __syncthreads();
        for (int i = 0; i < 16; ++i) {
            const int lt = F.wave * 16 + i, t = chunk * 128 + lt;
            const f32x4* hr = (const f32x4*)(h2 + (size_t)t * 1024) + lane;
            f32x4 v[4]; float ss = 0.f;
#pragma unroll
            for (int j = 0; j < 4; ++j) { v[j] = hr[64 * j]; ss += (v[j].x * v[j].x + v[j].y * v[j].y) + (v[j].z * v[j].z + v[j].w * v[j].w); }
            const float inv = 1.f / sqrtf(wave_sum(ss) * (1.f / 1024.f) + EPS);
            LAS float* lgs = (LAS float*)(F.lds + 4096 + F.wave * 128);
#pragma unroll 1
            for (int o = 0; o < 20; ++o) {
                const f32x4* rr = (const f32x4*)(rt + o * 1024) + lane; float s = 0.f;
#pragma unroll
                for (int j = 0; j < 4; ++j) { const f32x4 r = rr[64 * j]; s += (v[j].x * r.x + v[j].y * r.y) + (v[j].z * r.z + v[j].w * r.w); }
                s = wave_sum(s) * inv;
                if (lane == 0) lgs[o] = s;
            }
            LDS_WAIT(); __builtin_amdgcn_wave_barrier();
            if (lane == 0) {
                float lg[20];
#pragma unroll
                for (int o = 0; o < 20; ++o) lg[o] = lgs[o];
                float gl[4]; int gi = 0;
#pragma unroll
                for (int j = 0; j < 4; ++j) gl[j] = lg[j] + a.in[I_RGB][j];
                float gm = gl[0];
#pragma unroll
                for (int j = 1; j < 4; ++j) if (gl[j] > gm) { gm = gl[j]; gi = j; }
                float gs = 0.f;
#pragma unroll
                for (int j = 0; j < 4; ++j) gs += __expf(gl[j] - gm);
                const float gate = 1.f / gs;
                float el[4];
#pragma unroll
                for (int j = 0; j < 4; ++j) {
                    float x = 0.f;
#pragma unroll
                    for (int g2 = 0; g2 < 4; ++g2) x = (gi == g2) ? lg[4 + g2 * 4 + j] + a.in[I_REB][g2 * 4 + j] : x;
                    el[j] = x;
                }
                int i1 = 0; float v1 = el[0];
#pragma unroll
                for (int j = 1; j < 4; ++j) if (el[j] > v1) { v1 = el[j]; i1 = j; }
                int i2 = -1; float v2 = -3.0e38f;
#pragma unroll
                for (int j = 0; j < 4; ++j) if (j != i1 && el[j] > v2) { v2 = el[j]; i2 = j; }
                const float ex = __expf(v2 - v1), w1 = 1.f / (1.f + ex), w2 = ex * w1;
                rec_e[lt * 2 + 0] = gi * 4 + i1; rec_e[lt * 2 + 1] = gi * 4 + i2;
                rec_w[lt * 2 + 0] = w1 * gate; rec_w[lt * 2 + 1] = w2 * gate; rec_s[lt] = inv;
            }
        }
        __syncthreads();
        if (F.tid < 16) {
            const int e = F.tid; int n = 0;
            for (int p = 0; p < 256; ++p) n += (rec_e[p] == e) ? 1 : 0;
            int base = 0;
            if (n > 0) base = (int)__hip_atomic_fetch_add((unsigned*)(F.ctl + CW_CNT + 64 * e), (unsigned)n, RLX_AGENT);
            for (int p = 0; p < 256; ++p) if (rec_e[p] == e) {
                const int t = chunk * 128 + (p >> 1);
                ptok[e * T + base] = t | ((p & 1) ? (int)0x80000000 : 0); pcomb[e * T + base] = rec_w[p]; pscale[e * T + base] = rec_s[p >> 1]; ++base;
            }
        }
    }
    __syncthreads();
}
DI void moe_prefix(Frame& F) {
    volatile LAS int* tp = (volatile LAS int*)(F.lds + XTAB_OFF);
    __syncthreads();
    if (F.tid == 0) {
        int acc = 0;
        for (int e = 0; e < 16; ++e) { const int c = (int)__hip_atomic_load((unsigned*)(F.ctl + CW_CNT + 64 * e), RLX_AGENT); tp[e] = acc; tp[32 + e] = c; acc += (c + 255) >> 8; }
        tp[16] = acc;
    }
    __syncthreads();
}
DI void p12_final(const Args& a, Frame& F) {
    const bf16_t* pk0 = (const bf16_t*)(F.ws + WS_PK0); const bf16_t* pk1 = (const bf16_t*)(F.ws + WS_PK1); const float* nf = a.in[I_NFIN];
    const int lane = F.lane, gw = F.vcu * NWAVES + F.wave, NGW = F.G * NWAVES;
    for (int m = gw; m < T; m += NGW) {
        f32x4* hr = (f32x4*)(a.out + (size_t)m * 1024) + lane;
        f32x4 v[4]; float ss = 0.f;
#pragma unroll
        for (int j = 0; j < 4; ++j) {
            v[j] = hr[64 * j];
            const u32x2 p = *((const u32x2*)(pk0 + (size_t)m * 1024) + lane + 64 * j), r = *((const u32x2*)(pk1 + (size_t)m * 1024) + lane + 64 * j);
            v[j].x += bf2f(p.x & 0xffffu) + bf2f(r.x & 0xffffu); v[j].y += bf2f(p.x >> 16) + bf2f(r.x >> 16);
            v[j].z += bf2f(p.y & 0xffffu) + bf2f(r.y & 0xffffu); v[j].w += bf2f(p.y >> 16) + bf2f(r.y >> 16);
            ss += (v[j].x * v[j].x + v[j].y * v[j].y) + (v[j].z * v[j].z + v[j].w * v[j].w);
        }
        const float inv = 1.f / sqrtf(wave_sum(ss) * (1.f / 1024.f) + EPS);
#pragma unroll
        for (int j = 0; j < 4; ++j) { const f32x4 g = *((const f32x4*)nf + lane + 64 * j); hr[64 * j] = v[j] * inv * g; }
    }
}

constexpr int N_STEPS = 14;
#ifndef SKIPMASK
#define SKIPMASK 0
#endif
DI bool seam_after(int s) { return s != 1 && s != N_STEPS - 1; }
DI void grid_bar(CArgs* ap) {
    const Args a = phase_args(ap);
    extern __shared__ __attribute__((aligned(16))) unsigned char lds[];
    XcdBarrier b; b.bar = (unsigned*)(a.ws + WS_CTL) + CW_BAR; b.x = xb_xcc_id(); b.st = (volatile LAS unsigned*)((LAS unsigned char*)lds + MISC_OFF) + 8;
    xcd_barrier(b);
}
DI void gemm_step(int s, const Args& a, Frame& F, pg8::Gemm& g, pg8::USched& S, UEpi& E) {
    unsigned char* ws = a.ws;
    const volatile LAS int* tp = (const volatile LAS int*)(F.lds + XTAB_OFF);
    size_t oA = WS_A, oB = WS_W1T, oA2 = 0, oB2 = 0, bstride = 0; int K = 1024, M = T, N = 1024, mode = 0, id = E_PROJ;
    if (s == 1)       { N = INW; }
    else if (s == 2)  { oA = WS_MEMN; oB = WS_WKV; M = MROWS; N = 2048; id = E_KV; }
    else if (s == 4)  { oA = WS_YG; oB = WS_WGLU; K = 512; N = 512; id = E_GLU; }
    else if (s == 5)  { oA = WS_YP; oB = WS_WBRP; oA2 = WS_YS2; oB2 = WS_WBRS; K = 512; mode = 1; id = E_BR; }
    else if (s == 6)  { oA = WS_MG; oB = WS_WOUT; id = E_WOUT; }
    else if (s == 7)  { oB = WS_WQ; id = E_Q; }
    else if (s == 9)  { oA = WS_Q; oB = WS_WO; id = E_WO; }
    else if (s == 11) { oB = WS_W13; bstride = (size_t)1024 * 1024; mode = 2; id = E_UP; }
    else              { oA = WS_HID; oB = WS_W2T; K = 512; bstride = (size_t)1024 * 512; mode = 3; id = E_DOWN; }
    g.A = (const bf16_t*)(ws + oA); g.Bt = (const bf16_t*)(ws + oB); g.K = K; g.A2 = (const bf16_t*)(ws + oA2); g.Bt2 = (const bf16_t*)(ws + oB2); g.bstride = bstride;
    S.mode = mode; S.tp = tp; S.ptok = (const int*)(ws + WS_PTOK); S.nN = 4;
    S.so.init(M, N, F.G, F.bid);
    E.id = id; E.tp = tp; E.ws = ws; E.x = a.in[I_X]; E.out = a.out; E.glub = a.in[I_GLUB];
}
DI bool is_gemm_step(int s) { return s == 1 || s == 2 || s == 4 || s == 5 || s == 6 || s == 7 || s == 9 || s == 11 || s == 12; }

__global__ void __launch_bounds__(NWAVES * 64, 2) mk_fwd(Args args) {
    extern __shared__ __attribute__((aligned(16))) unsigned char lds[];
    CArgs* ap = (CArgs*)__builtin_amdgcn_kernarg_segment_ptr();
    const int lo = args.ph_lo, hi = args.ph_hi;
    {
        LAS unsigned char* l = (LAS unsigned char*)lds;
        for (int u = threadIdx.x; u < (LDS_BYTES - LDSCTL_OFF) / 4; u += NWAVES * 64) ((LAS unsigned*)(l + LDSCTL_OFF))[u] = 0u;
        __syncthreads();
        if (!MK_PER_PHASE) (void)xcd_barrier_post((unsigned*)(args.ws + WS_CTL) + CW_BAR, (volatile LAS unsigned*)(l + MISC_OFF) + 8);
    }
    for (int s = lo; s < hi; ++s) {
        if (!((SKIPMASK >> s) & 1)) {
            const Args a = phase_args(ap); Frame F = make_frame(a);
            if (is_gemm_step(s)) {
                if (s >= 11) moe_prefix(F);
                pg8::Gemm g; pg8::USched S; UEpi E;
                gemm_step(s, a, F, g, S, E);
                pg8::ngemm_phase(F.lds + RING_OFF, g, S, E, F.tid);
            } else if (s == 0) p0_prologue(a, F);
            else if (s == 3) { p2_pool(F); p2_ssm_naive(a, F); }
            else if (s == 8) p7_attn_naive(F);
            else if (s == 10) p9_router(a, F);
            else p12_final(a, F);
        }
        if (!MK_PER_PHASE && s + 1 < hi && seam_after(s)) grid_bar(ap);
    }
}

extern "C" void kernel_launch(void* const* d_in, const int* in_sizes, int n_in, void* d_out, int out_size, void* d_ws, size_t ws_size, hipStream_t stream) {
    static int grid = 0;
    if (grid == 0) {
        if (n_in != 33 || in_sizes[0] != T * D || out_size != T * D || ws_size < WS_END) {
            fprintf(stderr, "kernel_launch: shape/workspace mismatch (n_in %d, in0 %d, out %d, ws %zu, need %zu); nothing launched\n", n_in, n_in > 0 ? in_sizes[0] : -1, out_size, ws_size, (size_t)WS_END); grid = -1; return; }
        int dev = 0, cus = 0, per_cu = 0;
        if (hipGetDevice(&dev) != hipSuccess || hipDeviceGetAttribute(&cus, hipDeviceAttributeMultiprocessorCount, dev) != hipSuccess) { fprintf(stderr, "kernel_launch: device query failed\n"); grid = -1; return; }
        if (hipFuncSetAttribute((const void*)mk_fwd, hipFuncAttributeMaxDynamicSharedMemorySize, LDS_BYTES) != hipSuccess) { fprintf(stderr, "kernel_launch: hipFuncSetAttribute failed\n"); grid = -1; return; }
        if (hipOccupancyMaxActiveBlocksPerMultiprocessor(&per_cu, (const void*)mk_fwd, NWAVES * 64, LDS_BYTES) != hipSuccess || per_cu < 1) {
            fprintf(stderr, "kernel_launch: occupancy query reports %d workgroups per CU; nothing launched\n", per_cu); (void)hipGetLastError(); grid = -1; return; }
        grid = cus;
    }
    if (grid < 0) return;
    if (hipMemsetAsync((char*)d_ws + WS_CTL, 0, CTL_ZERO_BYTES, stream) != hipSuccess) { fprintf(stderr, "kernel_launch: memset failed\n"); return; }
    Args a{};
    for (int i = 0; i < 33; ++i) a.in[i] = (const float*)d_in[i];
    a.out = (float*)d_out; a.ws = (unsigned char*)d_ws;
    const int cuts[] = {0, 1, 3, 4, 5, 6, 7, 8, 9, 10, 11, 12, 13, 14};
    const int nl = MK_PER_PHASE ? 13 : 1;
    for (int li = 0; li < nl; ++li) {
        a.ph_lo = MK_PER_PHASE ? cuts[li] : 0; a.ph_hi = MK_PER_PHASE ? cuts[li + 1] : N_STEPS; a.li = li;
        hipLaunchKernelGGL(mk_fwd, dim3(grid), dim3(NWAVES * 64), LDS_BYTES, stream, a);
        const hipError_t le = hipPeekAtLastError();
        if (le != hipSuccess) { fprintf(stderr, "kernel_launch: launch %d failed: %s\n", li, hipGetErrorName(le)); break; }
    }
}
```

```cpp
#include <hip/hip_runtime.h>
#include <cstdio>
#include <cstdint>

#define GAS __attribute__((address_space(1)))
#define LAS __attribute__((address_space(3)))
typedef unsigned short bf16_t;
typedef float f32x4 __attribute__((ext_vector_type(4)));
typedef float f32x2 __attribute__((ext_vector_type(2)));
typedef unsigned u32x4 __attribute__((ext_vector_type(4)));
typedef unsigned u32x2 __attribute__((ext_vector_type(2)));
typedef short bf16x8 __attribute__((ext_vector_type(8)));
typedef GAS unsigned gu32;
#define RLX_AGENT __ATOMIC_RELAXED, __HIP_MEMORY_SCOPE_AGENT
#define LDS_WAIT() asm volatile("s_waitcnt lgkmcnt(0)" ::: "memory")
#define VM_WAIT() asm volatile("s_waitcnt vmcnt(0)" ::: "memory")
#define DI __device__ __forceinline__

#ifndef MK_PER_PHASE
#define MK_PER_PHASE 0
#endif

constexpr int BATCH = 4, SEQ = 8192, D = 1024, T = BATCH * SEQ;
constexpr int PW = 512, SW = 512, NSG = 32, GD = 16, NS = 64, INW = 3072;
constexpr int MEM = 256, XH = 4, XHD = 256, MROWS = BATCH * MEM;
constexpr int NE = 16, DE = 512;
constexpr float EPS = 1e-6f;
constexpr int NWAVES = 8;

constexpr size_t MiB = 1u << 20;
constexpr size_t WS_CTL = 0, CTL_ZERO_BYTES = 1 * MiB;
constexpr size_t WS_W1T = 1 * MiB;
constexpr size_t WS_WGLU = 7 * MiB;
constexpr size_t WS_WBRP = WS_WGLU + MiB / 2;
constexpr size_t WS_WBRS = WS_WBRP + MiB;
constexpr size_t WS_WOUT = WS_WBRS + MiB;
constexpr size_t WS_WQ = WS_WOUT + 2 * MiB;
constexpr size_t WS_WKV = WS_WQ + 2 * MiB;
constexpr size_t WS_WO = WS_WKV + 4 * MiB;
constexpr size_t WS_W13 = 20 * MiB;
constexpr size_t WS_W2T = 52 * MiB;
constexpr size_t WS_MEMN = 68 * MiB;
constexpr size_t WS_KC = 70 * MiB;
constexpr size_t WS_VT = 72 * MiB;
constexpr size_t WS_SSMT = 74 * MiB;
constexpr size_t WS_RT = 84 * MiB;
constexpr size_t WS_SSQ8 = 85 * MiB;
constexpr size_t WS_PTOK = 101 * MiB;
constexpr size_t WS_PCOMB = 103 * MiB;
constexpr size_t WS_PSCALE = 105 * MiB;
constexpr size_t WS_SLOC = 107 * MiB;
constexpr size_t WS_SSCAN = 109 * MiB;
constexpr size_t WS_A = 112 * MiB;
constexpr size_t WS_ZW = 176 * MiB;
constexpr size_t WS_VS = 208 * MiB;
constexpr size_t WS_MG = 176 * MiB;
constexpr size_t WS_Q = 176 * MiB;
constexpr size_t WS_G = 240 * MiB;
constexpr size_t WS_PK0 = 240 * MiB, WS_PK1 = 304 * MiB;
constexpr size_t WS_YP = 368 * MiB, WS_YG = 400 * MiB, WS_YS2 = 432 * MiB;
constexpr size_t WS_HID = 368 * MiB;
constexpr size_t WS_END = 464 * MiB;
constexpr int CW_TMO = 0, CW_CODE = 1;
constexpr int CW_BAR = 4096;
constexpr int CW_CNT = 16384;

constexpr int RING_OFF = 0, RING_BYTES = 131072;
constexpr int LDSCTL_OFF = RING_BYTES, MISC_OFF = LDSCTL_OFF + 320;
constexpr int XTAB_OFF = LDSCTL_OFF + 512;
constexpr int LDS_BYTES = 147456;

DI float bf2f(unsigned b) { return __uint_as_float(b << 16); }
DI unsigned f2bf(float f) { unsigned u = __float_as_uint(f); return (u + 0x7fffu + ((u >> 16) & 1u)) >> 16; }
DI unsigned pk2(float lo, float hi) { return f2bf(lo) | (f2bf(hi) << 16); }
DI float sigm(float x) { return 1.f / (1.f + __expf(-x)); }
DI float gelu_tanh(float x) { return x * sigm(1.5957691216057308f * (x + 0.044715f * x * x * x)); }
DI float wave_sum(float v) {
#pragma unroll
    for (int o = 1; o < 64; o <<= 1) v += __shfl_xor(v, o);
    return v;
}
DI float wave_max(float v) {
#pragma unroll
    for (int o = 1; o < 64; o <<= 1) v = fmaxf(v, __shfl_xor(v, o));
    return v;
}
DI void store8bf(bf16_t* p, const f32x4& a, const f32x4& b) {
    u32x4 w; w.x = pk2(a[0], a[1]); w.y = pk2(a[2], a[3]); w.z = pk2(b[0], b[1]); w.w = pk2(b[2], b[3]);
    *(u32x4*)p = w;
}
DI void load8bf(const bf16_t* p, f32x4& a, f32x4& b) {
    const u32x4 w = *(const u32x4*)p;
    a[0] = bf2f(w.x & 0xffffu); a[1] = bf2f(w.x >> 16); a[2] = bf2f(w.y & 0xffffu); a[3] = bf2f(w.y >> 16);
    b[0] = bf2f(w.z & 0xffffu); b[1] = bf2f(w.z >> 16); b[2] = bf2f(w.w & 0xffffu); b[3] = bf2f(w.w >> 16);
}

#define XB_TMO      128
#define XB_XCNT(j)  (256  + 64 * (j))
#define XB_XSUB(j)  (1280 + 64 * (j))
#define XB_XGEN(j)  (2304 + 64 * (j))
#define XB_TOP      3328
#define XB_TOPGEN   3392
#define XCD_BAR_WORDS 3456
#define XB_SPIN_CAP (1u << 18)
DI unsigned xb_ld(unsigned* p)              { return __hip_atomic_load(p, __ATOMIC_RELAXED, __HIP_MEMORY_SCOPE_AGENT); }
DI unsigned xb_add(unsigned* p, unsigned v) { return __hip_atomic_fetch_add(p, v, __ATOMIC_RELAXED, __HIP_MEMORY_SCOPE_AGENT); }
DI unsigned xb_xcc_id() { return (unsigned)__builtin_amdgcn_s_getreg((3 << 11) | 20) & 0xFu; }
#define XB_SPIN(cond, bar) do { unsigned _sp = 0; while (cond) { __builtin_amdgcn_s_sleep(1); \
    if ((++_sp & 255u) == 0u) { if (xb_ld(&(bar)[XB_TMO])) break; if (_sp > XB_SPIN_CAP) { atomicAdd(&(bar)[XB_TMO], 1u); break; } } } } while (0)
struct XcdBarrier { unsigned* bar; unsigned x; volatile LAS unsigned* st; };
DI XcdBarrier xcd_barrier_post(unsigned* bar, volatile LAS unsigned* st) {
    XcdBarrier b; b.bar = bar; b.x = xb_xcc_id(); b.st = st;
    if (threadIdx.x == 0) (void)xb_add(&bar[XB_XCNT(b.x)], 1u);
    return b;
}
DI void xcd_barrier_complete(unsigned* bar, unsigned x, unsigned& nloc, unsigned& nx) {
    const unsigned G = gridDim.x * gridDim.y * gridDim.z;
    unsigned sum, cnt, mine, sp = 0u;
    for (;;) {
        sum = 0u; cnt = 0u; mine = 0u;
#pragma unroll
        for (unsigned j = 0; j < 16; ++j) { const unsigned c = xb_ld(&bar[XB_XCNT(j)]); sum += c; cnt += (c > 0u) ? 1u : 0u; mine = (j == x) ? c : mine; }
        if (sum == G) break;
        __builtin_amdgcn_s_sleep(1);
        if ((++sp & 255u) == 0u) { if (xb_ld(&bar[XB_TMO])) break; if (sp > XB_SPIN_CAP) { atomicAdd(&bar[XB_TMO], 1u); break; } }
    }
    nloc = mine > 0u ? mine : 1u; nx = cnt > 0u ? cnt : 1u;
}
DI void xcd_barrier(const XcdBarrier& b) {
    asm volatile("s_waitcnt vmcnt(0)" ::: "memory");
    __syncthreads();
    if (threadIdx.x == 0) {
        unsigned* bar = b.bar;
        __builtin_amdgcn_s_waitcnt(0);
        unsigned nloc = b.st[0], nx = b.st[1];
        if (nloc == 0u) { xcd_barrier_complete(bar, b.x, nloc, nx); b.st[0] = nloc; b.st[1] = nx; }
        const unsigned old = xb_add(&bar[XB_XSUB(b.x)], 1u);
        const unsigned gen = old / nloc;
        if (old + 1u == (gen + 1u) * nloc) {
            __builtin_amdgcn_fence(__ATOMIC_RELEASE, "agent");
            asm volatile("s_waitcnt vmcnt(0)" ::: "memory");
            const unsigned og = xb_add(&bar[XB_TOP], 1u);
            const unsigned tg = og / nx;
            if (og + 1u == (tg + 1u) * nx) xb_add(&bar[XB_TOPGEN], 1u);
            else XB_SPIN(xb_ld(&bar[XB_TOPGEN]) == tg, bar);
            __builtin_amdgcn_fence(__ATOMIC_ACQUIRE, "agent");
            xb_add(&bar[XB_XGEN(b.x)], 1u);
            asm volatile("s_waitcnt vmcnt(0)" ::: "memory");
        } else {
            XB_SPIN(xb_ld(&bar[XB_XGEN(b.x)]) == gen, bar);
            __builtin_amdgcn_fence(__ATOMIC_ACQUIRE, "agent");
            asm volatile("s_waitcnt vmcnt(0)" ::: "memory");
        }
    }
    __syncthreads();
}

namespace pg8 {
constexpr int BM = 256, BK = 64, HALF = 128, NXCD = 8, WGM = 8;
struct Unit { int pm, pn, e; };
struct Gemm { const bf16_t* A; const bf16_t* Bt; int K; const bf16_t* A2; const bf16_t* Bt2; size_t bstride; };

struct StaticOrder {
    int nM, nN, nwg, G, c;
    DI void init(int M, int N, int G_, int c_) { nM = M / BM; nN = N / BM; nwg = nM * nN; G = G_; c = c_; }
    DI bool tile(int L, Unit& u) const {
        if (L >= nwg) return false;
        int wgid = L; { const int q = nwg / NXCD, r = nwg % NXCD, xcd = wgid % NXCD, off = wgid / NXCD; wgid = (xcd < r ? xcd * (q + 1) : r * (q + 1) + (xcd - r) * q) + off; }
        const int nig = WGM * nN, gid = wgid / nig, fm = gid * WGM, gsz = (nM - fm) < WGM ? (nM - fm) : WGM;
        u.pm = fm + ((wgid % nig) % gsz); u.pn = (wgid % nig) / gsz; u.e = 0; return true;
    }
    DI bool next(int i, Unit& u) const { return tile(i * G + c, u); }
    DI const bf16_t* a_base(const Gemm& g, const Unit&) const { return g.A; }
    DI const bf16_t* a_row(const Gemm& g, const Unit& u, int r) const { return g.A + (size_t)(u.pm * BM + r) * g.K; }
    DI const bf16_t* b_row(const Gemm& g, const Unit& u, int n) const { return g.Bt + (size_t)(u.pn * BM + n) * g.K; }
};
struct USched {
    int mode; StaticOrder so; const volatile LAS int* tp; const int* ptok; int nN;
    DI bool next(int i, Unit& u) const {
        if (mode == 0) return so.tile(i * so.G + so.c, u);
        if (mode == 1) { if (!so.tile((i >> 1) * so.G + so.c, u)) return false; u.e = i & 1; return true; }
        const int L = i * so.G + so.c, total = tp[16] * nN; if (L >= total) return false;
        const int mt = L / nN; int e = 0;
#pragma unroll
        for (int j = 1; j < 16; ++j) e += (mt >= tp[j]) ? 1 : 0;
        u.pm = __builtin_amdgcn_readfirstlane(mt); u.pn = __builtin_amdgcn_readfirstlane(L % nN); u.e = __builtin_amdgcn_readfirstlane(e); return true;
    }
    DI const bf16_t* a_base(const Gemm& g, const Unit& u) const { return (mode == 1 && u.e) ? g.A2 : g.A; }
    DI const bf16_t* a_row(const Gemm& g, const Unit& u, int r) const {
        if (mode == 2) {
            const int slot = (u.pm - tp[u.e]) * BM + r; const int cnt = tp[32 + u.e];
            const int tok = slot < cnt ? (ptok[u.e * T + slot] & 0x7fffffff) : 0;
            return g.A + (size_t)tok * g.K;
        }
        return a_base(g, u) + (size_t)(u.pm * BM + r) * g.K;
    }
    DI const bf16_t* b_row(const Gemm& g, const Unit& u, int n) const {
        const bf16_t* b = (mode == 1 && u.e) ? g.Bt2 : g.Bt;
        if (mode >= 2) b += (size_t)u.e * g.bstride;
        return b + (size_t)(u.pn * BM + n) * g.K;
    }
};


template <class Epi, class Sched>
DI void ngemm_phase(LAS unsigned char* lds, const Gemm g, const Sched& S, const Epi& E, const int tid) {
    LAS float* As = (LAS float*)lds;
    LAS float* Bs = As + 16 * 132;
    const int lr = tid >> 2, kq = tid & 3, tx = tid & 15, ty = tid >> 4;
    Unit u;
    for (int i = 0; S.next(i, u); ++i) {
        for (int sub = 0; sub < 4; ++sub) {
            const int sm = (sub >> 1) * 128, sn = (sub & 1) * 128;
            float acc[4][8];
#pragma unroll
            for (int r = 0; r < 4; ++r)
#pragma unroll
                for (int c = 0; c < 8; ++c) acc[r][c] = 0.f;
            const bf16_t* arow = S.a_row(g, u, sm + lr) + kq * 4;
            const bf16_t* brow = S.b_row(g, u, sn + lr) + kq * 4;
            for (int k0 = 0; k0 < g.K; k0 += 16) {
                __syncthreads();
                const u32x2 av = *(const u32x2*)(arow + k0), bv = *(const u32x2*)(brow + k0);
                As[(kq * 4 + 0) * 132 + lr] = bf2f(av.x & 0xffffu); As[(kq * 4 + 1) * 132 + lr] = bf2f(av.x >> 16);
                As[(kq * 4 + 2) * 132 + lr] = bf2f(av.y & 0xffffu); As[(kq * 4 + 3) * 132 + lr] = bf2f(av.y >> 16);
                Bs[(kq * 4 + 0) * 132 + lr] = bf2f(bv.x & 0xffffu); Bs[(kq * 4 + 1) * 132 + lr] = bf2f(bv.x >> 16);
                Bs[(kq * 4 + 2) * 132 + lr] = bf2f(bv.y & 0xffffu); Bs[(kq * 4 + 3) * 132 + lr] = bf2f(bv.y >> 16);
                __syncthreads();
#pragma unroll
                for (int k = 0; k < 16; ++k) {
                    const f32x4 a4 = *(const LAS f32x4*)(As + k * 132 + ty * 4);
                    const f32x4 b0 = *(const LAS f32x4*)(Bs + k * 132 + tx * 8), b1 = *(const LAS f32x4*)(Bs + k * 132 + tx * 8 + 4);
#pragma unroll
                    for (int r = 0; r < 4; ++r) {
#pragma unroll
                        for (int c = 0; c < 4; ++c) { acc[r][c] += a4[r] * b0[c]; acc[r][4 + c] += a4[r] * b1[c]; }
                    }
                }
            }
#pragma unroll
            for (int r = 0; r < 4; ++r) {
                f32x4 v0 = {acc[r][0], acc[r][1], acc[r][2], acc[r][3]}, v1 = {acc[r][4], acc[r][5], acc[r][6], acc[r][7]};
                E(u, u.pm * BM + sm + ty * 4 + r, u.pn * BM + sn + tx * 8, v0, v1);
            }
        }
    }
    __syncthreads();
}

template <class F> DI void epi_drive(const F& f, const Unit& u, f32x4 (&acc)[2][2][4][2], int wr, int wc, int fr, int fq) {
#pragma unroll
    for (int ai = 0; ai < 2; ++ai)
#pragma unroll
        for (int m = 0; m < 4; ++m) { const int row = u.pm * 256 + ai * 128 + wr * 64 + m * 16 + fr;
#pragma unroll
            for (int bj = 0; bj < 2; ++bj) f(u, row, u.pn * 256 + bj * 128 + wc * 32 + 8 * fq, acc[ai][bj][m][0], acc[ai][bj][m][1]);
            asm volatile("" ::: "memory"); }
}
DI int lds_byte(int r, int c) { const int st = (r >> 4) * 2 + (c >> 5), rr = r & 15, cc = c & 31, ob = rr * 64 + cc * 2; return st * 1024 + (ob ^ (((ob >> 9) & 1) << 5)); }
DI void stage_rc(int b, int& R, int& C) { const int st = b / 1024, sb = b % 1024, swz = sb ^ (((sb >> 9) & 1) << 5); R = (st >> 1) * 16 + swz / 64; C = (st & 1) * 32 + (swz % 64) / 2; }
DI int perm32(int rho) { const int n = rho >> 4, i = rho & 15; return 8 * (i >> 2) + 4 * n + (i & 3); }
constexpr int HTB = HALF * BK * 2;
template <bool GATHER, class F, class Sched>
DI void gemm_phase(LAS unsigned char* lds, const Gemm g, const Sched& S, const F& E, const int tid) {
    const int wid = __builtin_amdgcn_readfirstlane(tid >> 6), lane = tid & 63, wr = wid >> 2, wc = wid & 3, fr = lane & 15, fq = lane >> 4;
    const int K = g.K, nt = K / BK;
    int Rr[2], Cc[2]; unsigned voffB[2];
#pragma unroll
    for (int i = 0; i < 2; ++i) { int R, C; stage_rc(tid * 16 + i * 8192, R, C); Rr[i] = R; Cc[i] = C; const int Rb = (R & ~31) + perm32(R & 31); voffB[i] = (unsigned)(Rb * K + C) * 2u; }
    const size_t kstep = (size_t)(BK * 2);
    const size_t hstep = (size_t)HALF * K * 2;
    const unsigned ldsw = (unsigned)wid * 1024u;
    const int aoff = lds_byte(wr * 64 + fr, fq * 8), boff = lds_byte(wc * 32 + fr, fq * 8);
#define PG8_SA(b, h) (((b) * 2 + (h)) * HTB)
#define PG8_SB(b, h) ((4 + (b) * 2 + (h)) * HTB)
#define PG8_STAGE2(bufoff, gbase, v0_, v1_) do { \
        __builtin_amdgcn_global_load_lds((const unsigned*)((const char*)(gbase) + (v0_)), (LAS unsigned*)(lds + (bufoff) + ldsw), 16, 0, 0); \
        __builtin_amdgcn_global_load_lds((const unsigned*)((const char*)(gbase) + (v1_)), (LAS unsigned*)(lds + (bufoff) + ldsw + 8192), 16, 0, 0); } while (0)
#define PG8_STAGEB(bufoff, gbase) PG8_STAGE2(bufoff, gbase, voffB[0], voffB[1])
#define PG8_LDA(dst, b, h) do { _Pragma("unroll") for (int m = 0; m < 4; ++m) _Pragma("unroll") for (int k = 0; k < 2; ++k) dst[m][k] = *(const LAS bf16x8*)(lds + PG8_SA(b, h) + aoff + m * 2048 + k * 1024); } while (0)
#define PG8_LDB(dst, b, h) do { _Pragma("unroll") for (int n = 0; n < 2; ++n) _Pragma("unroll") for (int k = 0; k < 2; ++k) dst[n][k] = *(const LAS bf16x8*)(lds + PG8_SB(b, h) + boff + n * 2048 + k * 1024); } while (0)
#define PG8_MMA(ai, bj, At, Bt) do { __builtin_amdgcn_s_setprio(1); _Pragma("unroll") for (int m = 0; m < 4; ++m) _Pragma("unroll") for (int n = 0; n < 2; ++n) _Pragma("unroll") for (int k = 0; k < 2; ++k) \
        acc[ai][bj][m][n] = __builtin_amdgcn_mfma_f32_16x16x32_bf16(Bt[n][k], At[m][k], acc[ai][bj][m][n], 0, 0, 0); __builtin_amdgcn_s_setprio(0); } while (0)
#define PG8_WAIT_V(n) asm volatile("s_waitcnt vmcnt(" #n ")" ::: "memory")
#define PG8_WAIT_L(n) asm volatile("s_waitcnt lgkmcnt(" #n ")" ::: "memory")
#define PG8_BAR __builtin_amdgcn_s_barrier()
#define PG8_SCHED __builtin_amdgcn_sched_barrier(0)
    Unit cur, nxt; int ui = 0;
    if (!S.next(0, cur)) return;
    f32x4 acc[2][2][4][2];
#pragma unroll
    for (int a = 0; a < 2; ++a)
#pragma unroll
        for (int b = 0; b < 2; ++b)
#pragma unroll
            for (int m = 0; m < 4; ++m)
#pragma unroll
                for (int n = 0; n < 2; ++n) acc[a][b][m][n] = (f32x4){0.f, 0.f, 0.f, 0.f};
    bf16x8 At[4][2], B0[2][2], B1[2][2];
    const char* cA = GATHER ? (const char*)S.a_base(g, cur) : (const char*)S.a_row(g, cur, 0); const char* cB = (const char*)S.b_row(g, cur, 0);
    unsigned vc00, vc01, vc10, vc11;
    if constexpr (GATHER) {
        vc00 = (unsigned)((const char*)S.a_row(g, cur, Rr[0]) - cA) + (unsigned)Cc[0] * 2u; vc01 = (unsigned)((const char*)S.a_row(g, cur, Rr[1]) - cA) + (unsigned)Cc[1] * 2u;
        vc10 = (unsigned)((const char*)S.a_row(g, cur, HALF + Rr[0]) - cA) + (unsigned)Cc[0] * 2u; vc11 = (unsigned)((const char*)S.a_row(g, cur, HALF + Rr[1]) - cA) + (unsigned)Cc[1] * 2u;
    } else {
        vc00 = (unsigned)(Rr[0] * K + Cc[0]) * 2u; vc01 = (unsigned)(Rr[1] * K + Cc[1]) * 2u; vc10 = vc00 + (unsigned)hstep; vc11 = vc01 + (unsigned)hstep;
    }
    PG8_STAGEB(PG8_SB(0, 0), cB); PG8_STAGEB(PG8_SB(0, 1), cB + hstep); PG8_STAGE2(PG8_SA(0, 0), cA, vc00, vc01); PG8_STAGE2(PG8_SA(0, 1), cA, vc10, vc11);
    if (wr == 1) PG8_BAR;
    PG8_WAIT_V(2); PG8_BAR;
    PG8_STAGEB(PG8_SB(1, 0), cB + kstep); PG8_STAGE2(PG8_SA(1, 0), cA + kstep, vc00, vc01); PG8_STAGEB(PG8_SB(1, 1), cB + hstep + kstep);
    PG8_WAIT_V(6); PG8_BAR;
    for (;;) {
        const bool has_next = S.next(ui + 1, nxt);
        const char* nA = cA; const char* nB = cB; unsigned vn00 = vc00, vn01 = vc01, vn10 = vc10, vn11 = vc11;
        if (has_next) {
            nB = (const char*)S.b_row(g, nxt, 0);
            if constexpr (GATHER) {
                nA = (const char*)S.a_base(g, nxt);
                vn00 = (unsigned)((const char*)S.a_row(g, nxt, Rr[0]) - nA) + (unsigned)Cc[0] * 2u; vn01 = (unsigned)((const char*)S.a_row(g, nxt, Rr[1]) - nA) + (unsigned)Cc[1] * 2u;
                vn10 = (unsigned)((const char*)S.a_row(g, nxt, HALF + Rr[0]) - nA) + (unsigned)Cc[0] * 2u; vn11 = (unsigned)((const char*)S.a_row(g, nxt, HALF + Rr[1]) - nA) + (unsigned)Cc[1] * 2u;
            } else nA = (const char*)S.a_row(g, nxt, 0);
        }
        for (int t = 0; t < nt; t += 2) {
            const bool last = (t == nt - 2);
            const char* a1 = cA + (size_t)(t + 1) * kstep;
            const char* a2 = last ? nA : cA + (size_t)(t + 2) * kstep; const char* b2 = last ? nB : cB + (size_t)(t + 2) * kstep;
            const char* a3 = a2 + kstep; const char* b3 = b2 + kstep;
            const unsigned w00 = (GATHER && last) ? vn00 : vc00, w01 = (GATHER && last) ? vn01 : vc01, w10 = (GATHER && last) ? vn10 : vc10, w11 = (GATHER && last) ? vn11 : vc11;
            PG8_LDB(B0, 0, 0); PG8_LDB(B1, 0, 1); PG8_SCHED; PG8_LDA(At, 0, 0); PG8_STAGE2(PG8_SA(1, 1), a1, vc10, vc11);
            PG8_WAIT_V(8); PG8_WAIT_L(0); PG8_BAR; PG8_MMA(0, 0, At, B0); PG8_MMA(0, 1, At, B1); PG8_BAR; PG8_SCHED;
            PG8_LDA(At, 0, 1); PG8_STAGEB(PG8_SB(0, 0), b2); PG8_STAGEB(PG8_SB(0, 1), b2 + hstep); PG8_STAGE2(PG8_SA(0, 0), a2, w00, w01);
            PG8_WAIT_V(8); PG8_WAIT_L(0); PG8_BAR; PG8_MMA(1, 0, At, B0); PG8_MMA(1, 1, At, B1); PG8_BAR; PG8_SCHED;
            PG8_LDB(B0, 1, 0); PG8_LDB(B1, 1, 1); PG8_SCHED; PG8_LDA(At, 1, 0); PG8_STAGE2(PG8_SA(0, 1), a2, w10, w11);
            PG8_WAIT_V(8); PG8_WAIT_L(0); PG8_BAR; PG8_MMA(0, 0, At, B0); PG8_MMA(0, 1, At, B1); PG8_BAR; PG8_SCHED;
            PG8_LDA(At, 1, 1); PG8_STAGEB(PG8_SB(1, 0), b3); PG8_STAGEB(PG8_SB(1, 1), b3 + hstep); PG8_STAGE2(PG8_SA(1, 0), a3, w00, w01);
            PG8_WAIT_V(8); PG8_WAIT_L(0); PG8_BAR; PG8_MMA(1, 0, At, B0); PG8_MMA(1, 1, At, B1); PG8_BAR; PG8_SCHED;
        }
        if (wr == 0) PG8_BAR;
        epi_drive(E, cur, acc, wr, wc, fr, fq);
        const bool keep = E.keep(cur);
        if (!has_next) break;
        if (!keep) {
#pragma unroll
            for (int a = 0; a < 2; ++a)
#pragma unroll
                for (int b = 0; b < 2; ++b)
#pragma unroll
                    for (int m = 0; m < 4; ++m)
#pragma unroll
                        for (int n = 0; n < 2; ++n) acc[a][b][m][n] = (f32x4){0.f, 0.f, 0.f, 0.f};
        }
        cur = nxt; cA = nA; cB = nB; vc00 = vn00; vc01 = vn01; vc10 = vn10; vc11 = vn11; ++ui;
        if (wr == 1) PG8_BAR;
    }
    PG8_WAIT_V(0);
    PG8_BAR;
#undef PG8_SA
#undef PG8_SB
#undef PG8_STAGE2
#undef PG8_STAGEB
#undef PG8_LDA
#undef PG8_LDB
#undef PG8_MMA
#undef PG8_WAIT_V
#undef PG8_WAIT_L
#undef PG8_BAR
#undef PG8_SCHED
}
}

struct FProj {
    DI bool keep(const pg8::Unit&) const { return false; }
    bf16_t* zw; bf16_t* vs; bf16_t* g;
    DI void operator()(const pg8::Unit&, int row, int col, f32x4& v0, f32x4& v1) const {
        if (col < 512) store8bf(zw + (size_t)row * 512 + col, v0, v1);
        else if (col < 1024) store8bf(vs + (size_t)row * 512 + (col - 512), v0, v1);
        else {
            f32x4 a, b;
#pragma unroll
            for (int j = 0; j < 4; ++j) { a[j] = sigm(v0[j]); b[j] = sigm(v1[j]); }
            store8bf(g + (size_t)row * 2048 + (col - 1024), a, b);
        }
    }
};
struct FKV {
    DI bool keep(const pg8::Unit&) const { return false; }
    bf16_t* kc; bf16_t* vt;
    DI void operator()(const pg8::Unit&, int row, int col, f32x4& v0, f32x4& v1) const {
        if (col < 1024) store8bf(kc + (size_t)row * 1024 + col, v0, v1);
        else {
            const int c = col - 1024, h = c >> 8, d = c & 255, b = row >> 8, key = row & 255;
            bf16_t* p = vt + ((size_t)((b * 4 + h) * 256 + d)) * 256 + key;
#pragma unroll
            for (int j = 0; j < 4; ++j) { p[(size_t)j * 256] = (bf16_t)f2bf(v0[j]); p[(size_t)(4 + j) * 256] = (bf16_t)f2bf(v1[j]); }
        }
    }
};
struct FGlu {
    DI bool keep(const pg8::Unit&) const { return false; }
    const bf16_t* yg; const float* bias; bf16_t* ys2;
    DI void operator()(const pg8::Unit&, int row, int col, f32x4& v0, f32x4& v1) const {
        f32x4 y0, y1; load8bf(yg + (size_t)row * 512 + col, y0, y1);
        const f32x4 b0 = *(const f32x4*)(bias + col), b1 = *(const f32x4*)(bias + col + 4);
        f32x4 a, b;
#pragma unroll
        for (int j = 0; j < 4; ++j) { a[j] = y0[j] * sigm(v0[j] + b0[j]); b[j] = y1[j] * sigm(v1[j] + b1[j]); }
        store8bf(ys2 + (size_t)row * 512 + col, a, b);
    }
};
struct FBrNaive {
    DI bool keep(const pg8::Unit&) const { return false; }
    const bf16_t* g; float* tmp; bf16_t* mg;
    DI void operator()(const pg8::Unit& u, int row, int col, f32x4& v0, f32x4& v1) const {
        f32x4 g0, g1; load8bf(g + (size_t)row * 2048 + (u.e ? 1024 : 0) + col, g0, g1);
        float* tp = tmp + (size_t)row * 1024 + col;
        if (u.e == 0) { *(f32x4*)tp = g0 * v0; *(f32x4*)(tp + 4) = g1 * v1; }
        else { const f32x4 t0 = *(const f32x4*)tp, t1 = *(const f32x4*)(tp + 4); store8bf(mg + (size_t)row * 1024 + col, t0 + g0 * v0, t1 + g1 * v1); }
    }
};
struct FBr {
    DI bool keep(const pg8::Unit& u) const { return u.e == 0; }
    const bf16_t* g; bf16_t* mg;
    DI void operator()(const pg8::Unit& u, int row, int col, f32x4& v0, f32x4& v1) const {
        f32x4 a0, a1, b0, b1; load8bf(g + (size_t)row * 2048 + col, a0, a1); load8bf(g + (size_t)row * 2048 + 1024 + col, b0, b1);
        if (u.e == 0) {
#pragma unroll
            for (int j = 0; j < 4; ++j) { v0[j] *= a0[j] / fmaxf(b0[j], 1e-30f); v1[j] *= a1[j] / fmaxf(b1[j], 1e-30f); }
        } else store8bf(mg + (size_t)row * 1024 + col, v0 * (f32x4){fmaxf(b0[0], 1e-30f), fmaxf(b0[1], 1e-30f), fmaxf(b0[2], 1e-30f), fmaxf(b0[3], 1e-30f)},
                                                       v1 * (f32x4){fmaxf(b1[0], 1e-30f), fmaxf(b1[1], 1e-30f), fmaxf(b1[2], 1e-30f), fmaxf(b1[3], 1e-30f)});
    }
};
struct FWout {
    DI bool keep(const pg8::Unit&) const { return false; }
    const float* x; float* out; bf16_t* hb; float* ssq8;
    DI void operator()(const pg8::Unit&, int row, int col, f32x4& v0, f32x4& v1) const {
        const size_t o = (size_t)row * 1024 + col;
        const f32x4 h0 = *(const f32x4*)(x + o) + v0, h1 = *(const f32x4*)(x + o + 4) + v1;
        *(f32x4*)(out + o) = h0; *(f32x4*)(out + o + 4) = h1;
        store8bf(hb + o, h0, h1);
        ssq8[(size_t)row * 128 + (col >> 3)] = (h0[0] * h0[0] + h0[1] * h0[1]) + (h0[2] * h0[2] + h0[3] * h0[3]) + (h1[0] * h1[0] + h1[1] * h1[1]) + (h1[2] * h1[2] + h1[3] * h1[3]);
    }
};
struct FStoreBf {
    DI bool keep(const pg8::Unit&) const { return false; }
    bf16_t* o;
    DI void operator()(const pg8::Unit&, int row, int col, f32x4& v0, f32x4& v1) const { store8bf(o + (size_t)row * 1024 + col, v0, v1); }
};
struct FWo {
    DI bool keep(const pg8::Unit&) const { return false; }
    float* out; bf16_t* hb;
    DI void operator()(const pg8::Unit&, int row, int col, f32x4& v0, f32x4& v1) const {
        const size_t o = (size_t)row * 1024 + col;
        const f32x4 h0 = *(const f32x4*)(out + o) + v0, h1 = *(const f32x4*)(out + o + 4) + v1;
        *(f32x4*)(out + o) = h0; *(f32x4*)(out + o + 4) = h1;
        store8bf(hb + o, h0, h1);
    }
};
struct FUp {
    DI bool keep(const pg8::Unit&) const { return false; }
    const volatile LAS int* tp; const float* pscale; bf16_t* hid;
    DI void operator()(const pg8::Unit& u, int row, int col, f32x4& v0, f32x4& v1) const {
        const int slot = row - tp[u.e] * 256;
        if (slot < tp[32 + u.e]) {
            const float s = pscale[u.e * T + slot];
            u32x2 w; float h[4];
#pragma unroll
            for (int j = 0; j < 4; ++j) { const float a = v0[j] * s, b = v1[j] * s; h[j] = a * sigm(a) * b; }
            w.x = pk2(h[0], h[1]); w.y = pk2(h[2], h[3]);
            *(u32x2*)(hid + (size_t)row * 512 + (col >> 1)) = w;
        }
    }
};
struct FDown {
    DI bool keep(const pg8::Unit&) const { return false; }
    const volatile LAS int* tp; const int* ptok; const float* pcomb; bf16_t* pk0; bf16_t* pk1;
    DI void operator()(const pg8::Unit& u, int row, int col, f32x4& v0, f32x4& v1) const {
        const int slot = row - tp[u.e] * 256;
        if (slot < tp[32 + u.e]) {
            const int t = ptok[u.e * T + slot]; const float c = pcomb[u.e * T + slot];
            bf16_t* dst = ((t < 0) ? pk1 : pk0) + (size_t)(t & 0x7fffffff) * 1024 + col;
            store8bf(dst, v0 * c, v1 * c);
        }
    }
};

enum { E_PROJ = 0, E_KV, E_GLU, E_BR, E_WOUT, E_Q, E_WO, E_UP, E_DOWN, E_BRN };
struct UEpi {
    int id; const volatile LAS int* tp; unsigned char* ws; const float* x; float* out; const float* glub;
    DI void operator()(const pg8::Unit& u, int row, int col, f32x4& v0, f32x4& v1) const {
        switch (id) {
        case E_PROJ: FProj{(bf16_t*)(ws + WS_ZW), (bf16_t*)(ws + WS_VS), (bf16_t*)(ws + WS_G)}(u, row, col, v0, v1); break;
        case E_KV:   FKV{(bf16_t*)(ws + WS_KC), (bf16_t*)(ws + WS_VT)}(u, row, col, v0, v1); break;
        case E_GLU:  FGlu{(const bf16_t*)(ws + WS_YG), glub, (bf16_t*)(ws + WS_YS2)}(u, row, col, v0, v1); break;
        case E_BR:   FBr{(const bf16_t*)(ws + WS_G), (bf16_t*)(ws + WS_MG)}(u, row, col, v0, v1); break;
        case E_BRN:  FBrNaive{(const bf16_t*)(ws + WS_G), out, (bf16_t*)(ws + WS_MG)}(u, row, col, v0, v1); break;
        case E_WOUT: FWout{x, out, (bf16_t*)(ws + WS_A), (float*)(ws + WS_SSQ8)}(u, row, col, v0, v1); break;
        case E_Q:    FStoreBf{(bf16_t*)(ws + WS_Q)}(u, row, col, v0, v1); break;
        case E_WO:   FWo{out, (bf16_t*)(ws + WS_A)}(u, row, col, v0, v1); break;
        case E_UP:   FUp{tp, (const float*)(ws + WS_PSCALE), (bf16_t*)(ws + WS_HID)}(u, row, col, v0, v1); break;
        case E_DOWN: default: FDown{tp, (const int*)(ws + WS_PTOK), (const float*)(ws + WS_PCOMB), (bf16_t*)(ws + WS_PK0), (bf16_t*)(ws + WS_PK1)}(u, row, col, v0, v1); break;
        }
    }
    DI bool keep(const pg8::Unit& u) const { return id == E_BR && u.e == 0; }
    DI UEpi fresh() const { UEpi e = *this; asm volatile("" : "+s"(e.ws), "+s"(e.x), "+s"(e.out), "+s"(e.glub), "+s"(e.id)); return e; }
};

struct Args { const float* in[33]; float* out; unsigned char* ws; int ph_lo, ph_hi, li, pad; };
struct Frame {
    LAS unsigned char* lds; volatile LAS unsigned* MISC; gu32* ctl;
    int tid, lane, wave, vcu, G, bid; unsigned char* ws;
};
typedef __attribute__((address_space(4))) const Args CArgs;
#if defined(__HIP_DEVICE_COMPILE__)
DI Args phase_args(CArgs* p) { asm volatile("" : "+s"(p)); return *p; }
#else
DI Args phase_args(CArgs* p) { return Args{}; }
#endif
DI Frame make_frame(const Args& a) {
    Frame F;
    extern __shared__ __attribute__((aligned(16))) unsigned char lds[];
    F.lds = (LAS unsigned char*)lds;
    F.MISC = (volatile LAS unsigned*)(F.lds + MISC_OFF);
    { int t = threadIdx.x; asm volatile("" : "+v"(t)); F.tid = t; }
    F.lane = F.tid & 63; F.wave = __builtin_amdgcn_readfirstlane(F.tid >> 6);
    int bx = blockIdx.x, gx = gridDim.x; asm volatile("" : "+s"(bx), "+s"(gx));
    F.G = gx; F.bid = bx; F.vcu = (F.G % 8 == 0) ? (bx % 8) * (F.G / 8) + bx / 8 : bx;
    F.ws = a.ws; F.ctl = (gu32*)(a.ws + WS_CTL);
    return F;
}
enum { I_X = 0, I_MEM, I_NMIX, I_WIN, I_POOLW, I_POOLS, I_ARE, I_AIM, I_LOGDT, I_BRE, I_BIM, I_CRE, I_CIM, I_SD, I_GLUW, I_GLUB, I_BRP, I_BRS,
       I_WOUT, I_NX, I_NMEM, I_WQ, I_WKV, I_WO, I_NFFN, I_RGW, I_RGB, I_REW, I_REB, I_W1, I_W3, I_W2, I_NFIN };

template <class RM>
DI void tr_item(const float* W, int K, int ld, int nblk, bf16_t* WT, const float* kscale, RM rm, LAS float* scr, int item, int lane) {
    const int kb = item / nblk, nb = item % nblk, k0 = 64 * kb, n0 = 32 * nb;
#pragma unroll 8
    for (int i = 0; i < 32; ++i) { const int kk = 2 * i + (lane >> 5); const float s = kscale ? kscale[k0 + kk] : 1.f; scr[kk * 33 + (lane & 31)] = W[(size_t)(k0 + kk) * ld + n0 + (lane & 31)] * s; }
    LDS_WAIT(); asm volatile("" ::: "memory");
    const int c = lane & 7;
#pragma unroll
    for (int j = 0; j < 4; ++j) { const int n = (lane >> 3) + 8 * j; const LAS float* s = scr + (8 * c) * 33 + n;
        u32x4 o; o.x = pk2(s[0 * 33], s[1 * 33]); o.y = pk2(s[2 * 33], s[3 * 33]); o.z = pk2(s[4 * 33], s[5 * 33]); o.w = pk2(s[6 * 33], s[7 * 33]);
        *(u32x4*)(WT + (size_t)rm(n0 + n) * K + k0 + 8 * c) = o; }
    LDS_WAIT(); asm volatile("" ::: "memory");
}
struct RmId { int off; DI int operator()(int n) const { return off + n; } };
struct RmIl { int off; DI int operator()(int n) const { return 8 * (n >> 2) + (n & 3) + off; } };
DI void rms_row_to_bf16(const float* xrow, bf16_t* orow, int lane) {
    const f32x4* xr = (const f32x4*)xrow + lane;
    f32x4 v[4]; float s = 0.f;
#pragma unroll
    for (int j = 0; j < 4; ++j) { v[j] = xr[64 * j]; s += (v[j].x * v[j].x + v[j].y * v[j].y) + (v[j].z * v[j].z + v[j].w * v[j].w); }
    const float r = 1.f / sqrtf(wave_sum(s) * (1.f / 1024.f) + EPS);
    u32x2* o8 = (u32x2*)orow + lane;
#pragma unroll
    for (int j = 0; j < 4; ++j) { u32x2 w; w.x = pk2(v[j].x * r, v[j].y * r); w.y = pk2(v[j].z * r, v[j].w * r); o8[64 * j] = w; }
}
DI void p0_prologue(const Args& a, Frame& F) {
    unsigned char* ws = F.ws;
    LAS float* scr = (LAS float*)(F.lds + RING_OFF + F.wave * 16384);
    const int gw = F.vcu * NWAVES + F.wave, NGW = F.G * NWAVES, lane = F.lane;
    constexpr int I0 = 16 * 80;
    constexpr int I1 = I0 + 8 * 16;
    constexpr int I2 = I1 + 8 * 32;
    constexpr int I3 = I2 + 8 * 32;
    constexpr int I4 = I3 + 16 * 32;
    constexpr int I5 = I4 + 16 * 32;
    constexpr int I6 = I5 + 16 * 64;
    constexpr int I7 = I6 + 16 * 32;
    constexpr int I8 = I7 + 16 * 256;
    constexpr int I9 = I8 + 16 * 256;
    constexpr int I10 = I9 + 16 * 256;
    for (int it = gw; it < I10; it += NGW) {
        if (it < I0) tr_item(a.in[I_WIN] + 512, 1024, 3072, 80, (bf16_t*)(ws + WS_W1T), a.in[I_NMIX], RmId{512}, scr, it, lane);
        else if (it < I1) tr_item(a.in[I_GLUW], 512, 512, 16, (bf16_t*)(ws + WS_WGLU), nullptr, RmId{0}, scr, it - I0, lane);
        else if (it < I2) tr_item(a.in[I_BRP], 512, 1024, 32, (bf16_t*)(ws + WS_WBRP), nullptr, RmId{0}, scr, it - I1, lane);
        else if (it < I3) tr_item(a.in[I_BRS], 512, 1024, 32, (bf16_t*)(ws + WS_WBRS), nullptr, RmId{0}, scr, it - I2, lane);
        else if (it < I4) tr_item(a.in[I_WOUT], 1024, 1024, 32, (bf16_t*)(ws + WS_WOUT), nullptr, RmId{0}, scr, it - I3, lane);
        else if (it < I5) tr_item(a.in[I_WQ], 1024, 1024, 32, (bf16_t*)(ws + WS_WQ), a.in[I_NX], RmId{0}, scr, it - I4, lane);
        else if (it < I6) tr_item(a.in[I_WKV], 1024, 2048, 64, (bf16_t*)(ws + WS_WKV), a.in[I_NMEM], RmId{0}, scr, it - I5, lane);
        else if (it < I7) tr_item(a.in[I_WO], 1024, 1024, 32, (bf16_t*)(ws + WS_WO), nullptr, RmId{0}, scr, it - I6, lane);
        else if (it < I8) { const int r = it - I7, e = r >> 8; tr_item(a.in[I_W1] + (size_t)e * 1024 * 512, 1024, 512, 16, (bf16_t*)(ws + WS_W13) + (size_t)e * 1024 * 1024, a.in[I_NFFN], RmIl{0}, scr, r & 255, lane); }
        else if (it < I9) { const int r = it - I8, e = r >> 8; tr_item(a.in[I_W3] + (size_t)e * 1024 * 512, 1024, 512, 16, (bf16_t*)(ws + WS_W13) + (size_t)e * 1024 * 1024, a.in[I_NFFN], RmIl{4}, scr, r & 255, lane); }
        else { const int r = it - I9, e = r >> 8; tr_item(a.in[I_W2] + (size_t)e * 512 * 1024, 512, 1024, 32, (bf16_t*)(ws + WS_W2T) + (size_t)e * 1024 * 512, nullptr, RmId{0}, scr, r & 255, lane); }
    }
    {
        const float* win = a.in[I_WIN]; const float* pw = a.in[I_POOLW]; const float* ps = a.in[I_POOLS]; const float* nm = a.in[I_NMIX];
        bf16_t* w1t = (bf16_t*)(ws + WS_W1T);
        for (int it = F.vcu * 512 + F.tid; it < 512 * 128; it += F.G * 512) {
            const int n = it & 511, kb = it >> 9, g = n >> 7, d = n & 127, k0 = kb * 8;
            float acc[8];
#pragma unroll
            for (int j = 0; j < 8; ++j) acc[j] = 0.f;
            for (int c = 0; c < 128; ++c) {
                const float p = pw[(size_t)(g * 128 + c) * 128 + d];
#pragma unroll
                for (int j = 0; j < 8; ++j) acc[j] += win[(size_t)(k0 + j) * 3072 + g * 128 + c] * p;
            }
            const float sc = ps[n];
            u32x4 o;
            o.x = pk2(acc[0] * sc * nm[k0 + 0], acc[1] * sc * nm[k0 + 1]); o.y = pk2(acc[2] * sc * nm[k0 + 2], acc[3] * sc * nm[k0 + 3]);
            o.z = pk2(acc[4] * sc * nm[k0 + 4], acc[5] * sc * nm[k0 + 5]); o.w = pk2(acc[6] * sc * nm[k0 + 6], acc[7] * sc * nm[k0 + 7]);
            *(u32x4*)(w1t + (size_t)n * 1024 + k0) = o;
        }
    }
    {
        float* rt = (float*)(ws + WS_RT); const float* nf = a.in[I_NFFN];
        for (int it = F.vcu * 512 + F.tid; it < 20 * 1024; it += F.G * 512) {
            const int j = it >> 10, k = it & 1023;
            rt[it] = nf[k] * (j < 4 ? a.in[I_RGW][k * 4 + j] : a.in[I_REW][k * 16 + (j - 4)]);
        }
    }
    for (int m = gw; m < T; m += NGW) rms_row_to_bf16(a.in[I_X] + (size_t)m * D, (bf16_t*)(ws + WS_A) + (size_t)m * D, lane);
    for (int m = gw; m < MROWS; m += NGW) rms_row_to_bf16(a.in[I_MEM] + (size_t)m * D, (bf16_t*)(ws + WS_MEMN) + (size_t)m * D, lane);
}

DI void p2_pool(Frame& F) {
    const bf16_t* zw = (const bf16_t*)(F.ws + WS_ZW); bf16_t* yp = (bf16_t*)(F.ws + WS_YP);
    for (int it = F.vcu * 512 + F.tid; it < T * 64; it += F.G * 512) {
        const int t = it >> 6, ch = (it & 63) * 8, s = t & (SEQ - 1), w = 2 << (ch >> 7), cnt = (s + 1 < w) ? s + 1 : w;
        f32x4 z0, z1; load8bf(zw + (size_t)t * 512 + ch, z0, z1);
        f32x4 s0 = z0, s1 = z1;
        for (int j = 1; j < cnt; ++j) { f32x4 a, b; load8bf(zw + (size_t)(t - j) * 512 + ch, a, b); s0 += a; s1 += b; }
        const float inv = 1.f / (float)cnt;
        store8bf(yp + (size_t)t * 512 + ch, s0 * inv - z0, s1 * inv - z1);
    }
}
DI void p2_ssm_naive(const Args& a, Frame& F) {
    if (F.wave != 0) return;
    const bf16_t* vs = (const bf16_t*)(F.ws + WS_VS); bf16_t* yg = (bf16_t*)(F.ws + WS_YG);
    const int n = F.lane;
    for (int item = F.vcu; item < BATCH * NSG; item += F.G) {
        const int b = item >> 5, g = item & 31;
        const float dt = expf(a.in[I_LOGDT][g]), ar = a.in[I_ARE][g * 64 + n], ai = a.in[I_AIM][g * 64 + n];
        const float mag = expf(ar * dt); float sn, cs; sincosf(ai * dt, &sn, &cs);
        const float lr = mag * cs, li = mag * sn, den = ar * ar + ai * ai, nr = lr - 1.f, ni = li;
        const float fre = (nr * ar + ni * ai) / den, fim = (ni * ar - nr * ai) / den;
        float bbr[16], bbi[16], cr[16], ci[16], dsk[16];
#pragma unroll
        for (int c = 0; c < 16; ++c) {
            const float br = a.in[I_BRE][(size_t)(g * 64 + n) * 16 + c], bi = a.in[I_BIM][(size_t)(g * 64 + n) * 16 + c];
            bbr[c] = fre * br - fim * bi; bbi[c] = fre * bi + fim * br;
            cr[c] = a.in[I_CRE][(size_t)(g * 16 + c) * 64 + n]; ci[c] = a.in[I_CIM][(size_t)(g * 16 + c) * 64 + n];
            dsk[c] = (n == 0) ? a.in[I_SD][g * 16 + c] : 0.f;
        }
        float hr = 0.f, hi = 0.f;
        const int myc = (((n >> 5) & 1) << 3) | (((n >> 4) & 1) << 2) | (((n >> 3) & 1) << 1) | ((n >> 2) & 1);
        for (int s = 0; s < SEQ; ++s) {
            const size_t t = (size_t)b * SEQ + s;
            f32x4 va, vb, vc, vd; load8bf(vs + t * 512 + g * 16, va, vb); load8bf(vs + t * 512 + g * 16 + 8, vc, vd);
            float v[16];
#pragma unroll
            for (int j = 0; j < 4; ++j) { v[j] = va[j]; v[4 + j] = vb[j]; v[8 + j] = vc[j]; v[12 + j] = vd[j]; }
            float ur = 0.f, ui = 0.f;
#pragma unroll
            for (int c = 0; c < 16; ++c) { ur += bbr[c] * v[c]; ui += bbi[c] * v[c]; }
            const float nhr = lr * hr - li * hi + ur, nhi = lr * hi + li * hr + ui; hr = nhr; hi = nhi;
            float p[16];
#pragma unroll
            for (int c = 0; c < 16; ++c) p[c] = cr[c] * hr - ci[c] * hi + dsk[c] * v[c];
#pragma unroll
            for (int i = 0; i < 8; ++i) { const bool up = (n & 32) != 0; const float keep = up ? p[i + 8] : p[i], send = up ? p[i] : p[i + 8]; p[i] = keep + __shfl_xor(send, 32); }
#pragma unroll
            for (int i = 0; i < 4; ++i) { const bool up = (n & 16) != 0; const float keep = up ? p[i + 4] : p[i], send = up ? p[i] : p[i + 4]; p[i] = keep + __shfl_xor(send, 16); }
#pragma unroll
            for (int i = 0; i < 2; ++i) { const bool up = (n & 8) != 0; const float keep = up ? p[i + 2] : p[i], send = up ? p[i] : p[i + 2]; p[i] = keep + __shfl_xor(send, 8); }
            { const bool up = (n & 4) != 0; const float keep = up ? p[1] : p[0], send = up ? p[0] : p[1]; p[0] = keep + __shfl_xor(send, 4); }
            float y = p[0]; y += __shfl_xor(y, 1); y += __shfl_xor(y, 2);
            if ((n & 3) == 0) yg[t * 512 + g * 16 + myc] = (bf16_t)f2bf(gelu_tanh(y));
        }
    }
}

DI void p7_attn_naive(Frame& F) {
    bf16_t* q = (bf16_t*)(F.ws + WS_Q); const bf16_t* kc = (const bf16_t*)(F.ws + WS_KC); const bf16_t* vt = (const bf16_t*)(F.ws + WS_VT);
    const float* ssq8 = (const float*)(F.ws + WS_SSQ8);
    LAS float* qs = (LAS float*)(F.lds + F.wave * 2048); LAS float* ps = qs + 256;
    const int lane = F.lane, gw = F.vcu * NWAVES + F.wave, NGW = F.G * NWAVES;
    for (int it = gw; it < T * XH; it += NGW) {
        const int t = it >> 2, h = it & 3, b = t >> 13;
        const float inv = 1.f / sqrtf(wave_sum(ssq8[(size_t)t * 128 + lane] + ssq8[(size_t)t * 128 + 64 + lane]) * (1.f / 1024.f) + EPS);
        { const u32x2 w = *(const u32x2*)(q + (size_t)t * 1024 + h * 256 + lane * 4);
          qs[lane * 4 + 0] = bf2f(w.x & 0xffffu); qs[lane * 4 + 1] = bf2f(w.x >> 16); qs[lane * 4 + 2] = bf2f(w.y & 0xffffu); qs[lane * 4 + 3] = bf2f(w.y >> 16); }
        LDS_WAIT(); __builtin_amdgcn_wave_barrier();
        float sc[4];
#pragma unroll
        for (int kk = 0; kk < 4; ++kk) {
            const bf16_t* kr = kc + (size_t)(b * 256 + kk * 64 + lane) * 1024 + h * 256; float s = 0.f;
#pragma unroll 1
            for (int d = 0; d < 256; d += 8) { f32x4 k0, k1; load8bf(kr + d, k0, k1); const f32x4 q0 = *(const LAS f32x4*)(qs + d), q1 = *(const LAS f32x4*)(qs + d + 4);
                s += (k0[0] * q0[0] + k0[1] * q0[1]) + (k0[2] * q0[2] + k0[3] * q0[3]) + (k1[0] * q1[0] + k1[1] * q1[1]) + (k1[2] * q1[2] + k1[3] * q1[3]); }
            sc[kk] = s * inv * 0.0625f;
        }
        const float m = wave_max(fmaxf(fmaxf(sc[0], sc[1]), fmaxf(sc[2], sc[3])));
        float l = 0.f;
#pragma unroll
        for (int kk = 0; kk < 4; ++kk) { const float p = __expf(sc[kk] - m); l += p; ps[kk * 64 + lane] = p; }
        l = wave_sum(l);
        LDS_WAIT(); __builtin_amdgcn_wave_barrier();
        float o[4] = {0.f, 0.f, 0.f, 0.f};
#pragma unroll
        for (int j = 0; j < 4; ++j) {
            const bf16_t* vr = vt + ((size_t)((b * 4 + h) * 256 + lane * 4 + j)) * 256;
#pragma unroll 1
            for (int k = 0; k < 256; k += 8) { f32x4 v0, v1; load8bf(vr + k, v0, v1); const f32x4 p0 = *(const LAS f32x4*)(ps + k), p1 = *(const LAS f32x4*)(ps + k + 4);
                o[j] += (v0[0] * p0[0] + v0[1] * p0[1]) + (v0[2] * p0[2] + v0[3] * p0[3]) + (v1[0] * p1[0] + v1[1] * p1[1]) + (v1[2] * p1[2] + v1[3] * p1[3]); }
        }
        const float il = 1.f / l;
        u32x2 w; w.x = pk2(o[0] * il, o[1] * il); w.y = pk2(o[2] * il, o[3] * il);
        *(u32x2*)(q + (size_t)t * 1024 + h * 256 + lane * 4) = w;
        LDS_WAIT(); __builtin_amdgcn_wave_barrier();
    }
}

DI void p9_router(const Args& a, Frame& F) {
    const float* h2 = a.out; const float* rt = (const float*)(F.ws + WS_RT);
    int* ptok = (int*)(F.ws + WS_PTOK); float* pcomb = (float*)(F.ws + WS_PCOMB); float* pscale = (float*)(F.ws + WS_PSCALE);
    LAS int* rec_e = (LAS int*)(F.lds);
    LAS float* rec_w = (LAS float*)(F.lds + 1024);
    LAS float* rec_s = (LAS float*)(F.lds + 2048);
    const int lane = F.lane;
    for (int chunk = F.vcu; chunk < T / 128; chunk += F.G) {
        __syncthreads();
        for (int i = 0; i < 16; ++i) {
            const int lt = F.wave * 16 + i, t = chunk * 128 + lt;
            const f32x4* hr = (const f32x4*)(h2 + (size_t)t * 1024) + lane;
            f32x4 v[4]; float ss = 0.f;
#pragma unroll
            for (int j = 0; j < 4; ++j) { v[j] = hr[64 * j]; ss += (v[j].x * v[j].x + v[j].y * v[j].y) + (v[j].z * v[j].z + v[j].w * v[j].w); }
            const float inv = 1.f / sqrtf(wave_sum(ss) * (1.f / 1024.f) + EPS);
            LAS float* lgs = (LAS float*)(F.lds + 4096 + F.wave * 128);
#pragma unroll 1
            for (int o = 0; o < 20; ++o) {
                const f32x4* rr = (const f32x4*)(rt + o * 1024) + lane; float s = 0.f;
#pragma unroll
                for (int j = 0; j < 4; ++j) { const f32x4 r = rr[64 * j]; s += (v[j].x * r.x + v[j].y * r.y) + (v[j].z * r.z + v[j].w * r.w); }
                s = wave_sum(s) * inv;
                if (lane == 0) lgs[o] = s;
            }
            LDS_WAIT(); __builtin_amdgcn_wave_barrier();
            if (lane == 0) {
                float lg[20];
#pragma unroll
                for (int o = 0; o < 20; ++o) lg[o] = lgs[o];
                float gl[4]; int gi = 0;
#pragma unroll
                for (int j = 0; j < 4; ++j) gl[j] = lg[j] + a.in[I_RGB][j];
                float gm = gl[0];
#pragma unroll
                for (int j = 1; j < 4; ++j) if (gl[j] > gm) { gm = gl[j]; gi = j; }
                float gs = 0.f;
#pragma unroll
                for (int j = 0; j < 4; ++j) gs += __expf(gl[j] - gm);
                const float gate = 1.f / gs;
                float el[4];
#pragma unroll
                for (int j = 0; j < 4; ++j) {
                    float x = 0.f;
#pragma unroll
                    for (int g2 = 0; g2 < 4; ++g2) x = (gi == g2) ? lg[4 + g2 * 4 + j] + a.in[I_REB][g2 * 4 + j] : x;
                    el[j] = x;
                }
                int i1 = 0; float v1 = el[0];
#pragma unroll
                for (int j = 1; j < 4; ++j) if (el[j] > v1) { v1 = el[j]; i1 = j; }
                int i2 = -1; float v2 = -3.0e38f;
#pragma unroll
                for (int j = 0; j < 4; ++j) if (j != i1 && el[j] > v2) { v2 = el[j]; i2 = j; }
                const float ex = __expf(v2 - v1), w1 = 1.f / (1.f + ex), w2 = ex * w1;
                rec_e[lt * 2 + 0] = gi * 4 + i1; rec_e[lt * 2 + 1] = gi * 4 + i2;
                rec_w[lt * 2 + 0] = w1 * gate; rec_w[lt * 2 + 1] = w2 * gate; rec_s[lt] = inv;
            }
        }
        __syncthreads();
        if (F.tid < 16) {
            const int e = F.tid; int n = 0;
            for (int p = 0; p < 256; ++p) n += (rec_e[p] == e) ? 1 : 0;
            int base = 0;
            if (n > 0) base = (int)__hip_atomic_fetch_add((unsigned*)(F.ctl + CW_CNT + 64 * e), (unsigned)n, RLX_AGENT);
            for (int p = 0; p < 256; ++p) if (rec_e[p] == e) {
                const int t = chunk * 128 + (p >> 1);
                ptok[e * T + base] = t | ((p & 1) ? (int)0x80000000 : 0); pcomb[e * T + base] = rec_w[p]; pscale[e * T + base] = rec_s[p >> 1]; ++base;
            }
        }
    }
    __syncthreads();
}
DI void moe_prefix(Frame& F) {
    volatile LAS int* tp = (volatile LAS int*)(F.lds + XTAB_OFF);
    __syncthreads();
    if (F.tid == 0) {
        int acc = 0;
        for (int e = 0; e < 16; ++e) { const int c = (int)__hip_atomic_load((unsigned*)(F.ctl + CW_CNT + 64 * e), RLX_AGENT); tp[e] = acc; tp[32 + e] = c; acc += (c + 255) >> 8; }
        tp[16] = acc;
    }
    __syncthreads();
}
DI void p12_final(const Args& a, Frame& F) {
    const bf16_t* pk0 = (const bf16_t*)(F.ws + WS_PK0); const bf16_t* pk1 = (const bf16_t*)(F.ws + WS_PK1); const float* nf = a.in[I_NFIN];
    const int lane = F.lane, gw = F.vcu * NWAVES + F.wave, NGW = F.G * NWAVES;
    for (int m = gw; m < T; m += NGW) {
        f32x4* hr = (f32x4*)(a.out + (size_t)m * 1024) + lane;
        f32x4 v[4]; float ss = 0.f;
#pragma unroll
        for (int j = 0; j < 4; ++j) {
            v[j] = hr[64 * j];
            const u32x2 p = *((const u32x2*)(pk0 + (size_t)m * 1024) + lane + 64 * j), r = *((const u32x2*)(pk1 + (size_t)m * 1024) + lane + 64 * j);
            v[j].x += bf2f(p.x & 0xffffu) + bf2f(r.x & 0xffffu); v[j].y += bf2f(p.x >> 16) + bf2f(r.x >> 16);
            v[j].z += bf2f(p.y & 0xffffu) + bf2f(r.y & 0xffffu); v[j].w += bf2f(p.y >> 16) + bf2f(r.y >> 16);
            ss += (v[j].x * v[j].x + v[j].y * v[j].y) + (v[j].z * v[j].z + v[j].w * v[j].w);
        }
        const float inv = 1.f / sqrtf(wave_sum(ss) * (1.f / 1024.f) + EPS);
#pragma unroll
        for (int j = 0; j < 4; ++j) { const f32x4 g = *((const f32x4*)nf + lane + 64 * j); hr[64 * j] = v[j] * inv * g; }
    }
}

constexpr int N_STEPS = 14;
#ifndef SKIPMASK
#define SKIPMASK 0
#endif
#ifndef MFMA_MASK
#define MFMA_MASK 0x1AF6
#endif
DI bool use_mfma(int s) { return ((MFMA_MASK >> s) & 1) != 0; }
DI bool seam_after(int s) { return s != 1 && s != N_STEPS - 1; }
DI void grid_bar(CArgs* ap) {
    const Args a = phase_args(ap);
    extern __shared__ __attribute__((aligned(16))) unsigned char lds[];
    XcdBarrier b; b.bar = (unsigned*)(a.ws + WS_CTL) + CW_BAR; b.x = xb_xcc_id(); b.st = (volatile LAS unsigned*)((LAS unsigned char*)lds + MISC_OFF) + 8;
    xcd_barrier(b);
}
DI void gemm_step(int s, const Args& a, Frame& F, pg8::Gemm& g, pg8::USched& S, UEpi& E) {
    unsigned char* ws = a.ws;
    const volatile LAS int* tp = (const volatile LAS int*)(F.lds + XTAB_OFF);
    size_t oA = WS_A, oB = WS_W1T, oA2 = 0, oB2 = 0, bstride = 0; int K = 1024, M = T, N = 1024, mode = 0, id = E_PROJ;
    if (s == 1)       { N = INW; }
    else if (s == 2)  { oA = WS_MEMN; oB = WS_WKV; M = MROWS; N = 2048; id = E_KV; }
    else if (s == 4)  { oA = WS_YG; oB = WS_WGLU; K = 512; N = 512; id = E_GLU; }
    else if (s == 5)  { oA = WS_YP; oB = WS_WBRP; oA2 = WS_YS2; oB2 = WS_WBRS; K = 512; mode = 1; id = use_mfma(5) ? E_BR : E_BRN; }
    else if (s == 6)  { oA = WS_MG; oB = WS_WOUT; id = E_WOUT; }
    else if (s == 7)  { oB = WS_WQ; id = E_Q; }
    else if (s == 9)  { oA = WS_Q; oB = WS_WO; id = E_WO; }
    else if (s == 11) { oB = WS_W13; bstride = (size_t)1024 * 1024; mode = 2; id = E_UP; }
    else              { oA = WS_HID; oB = WS_W2T; K = 512; bstride = (size_t)1024 * 512; mode = 3; id = E_DOWN; }
    g.A = (const bf16_t*)(ws + oA); g.Bt = (const bf16_t*)(ws + oB); g.K = K; g.A2 = (const bf16_t*)(ws + oA2); g.Bt2 = (const bf16_t*)(ws + oB2); g.bstride = bstride;
    S.mode = mode; S.tp = tp; S.ptok = (const int*)(ws + WS_PTOK); S.nN = 4;
    S.so.init(M, N, F.G, F.bid);
    E.id = id; E.tp = tp; E.ws = ws; E.x = a.in[I_X]; E.out = a.out; E.glub = a.in[I_GLUB];
}
DI bool is_gemm_step(int s) { return s == 1 || s == 2 || s == 4 || s == 5 || s == 6 || s == 7 || s == 9 || s == 11 || s == 12; }

__global__ void __launch_bounds__(NWAVES * 64, 2) mk_fwd(Args args) {
    extern __shared__ __attribute__((aligned(16))) unsigned char lds[];
    CArgs* ap = (CArgs*)__builtin_amdgcn_kernarg_segment_ptr();
    const int lo = args.ph_lo, hi = args.ph_hi;
    {
        LAS unsigned char* l = (LAS unsigned char*)lds;
        for (int u = threadIdx.x; u < (LDS_BYTES - LDSCTL_OFF) / 4; u += NWAVES * 64) ((LAS unsigned*)(l + LDSCTL_OFF))[u] = 0u;
        __syncthreads();
        if (!MK_PER_PHASE) (void)xcd_barrier_post((unsigned*)(args.ws + WS_CTL) + CW_BAR, (volatile LAS unsigned*)(l + MISC_OFF) + 8);
    }
    for (int s = lo; s < hi; ++s) {
        {
            const Args a = phase_args(ap); Frame F = make_frame(a);
            if (is_gemm_step(s)) {
                if constexpr ((SKIPMASK & 0x1AF6) != 0x1AF6) {
                if (s >= 11) moe_prefix(F);
                pg8::Gemm g; pg8::USched S; UEpi E;
                gemm_step(s, a, F, g, S, E);
                if (use_mfma(s)) {
                    unsigned char* ws = a.ws; const volatile LAS int* tp = E.tp; LAS unsigned char* ring = F.lds + RING_OFF;
                    switch (s) {
                    case 1:  if constexpr (MFMA_MASK & (1 << 1))  pg8::gemm_phase<false>(ring, g, S, FProj{(bf16_t*)(ws + WS_ZW), (bf16_t*)(ws + WS_VS), (bf16_t*)(ws + WS_G)}, F.tid); break;
                    case 2:  if constexpr (MFMA_MASK & (1 << 2))  pg8::gemm_phase<false>(ring, g, S, FKV{(bf16_t*)(ws + WS_KC), (bf16_t*)(ws + WS_VT)}, F.tid); break;
                    case 4:  if constexpr (MFMA_MASK & (1 << 4))  pg8::gemm_phase<false>(ring, g, S, FGlu{(const bf16_t*)(ws + WS_YG), a.in[I_GLUB], (bf16_t*)(ws + WS_YS2)}, F.tid); break;
                    case 5:  if constexpr (MFMA_MASK & (1 << 5))  pg8::gemm_phase<false>(ring, g, S, FBr{(const bf16_t*)(ws + WS_G), (bf16_t*)(ws + WS_MG)}, F.tid); break;
                    case 6:  if constexpr (MFMA_MASK & (1 << 6))  pg8::gemm_phase<false>(ring, g, S, FWout{a.in[I_X], a.out, (bf16_t*)(ws + WS_A), (float*)(ws + WS_SSQ8)}, F.tid); break;
                    case 7:  if constexpr (MFMA_MASK & (1 << 7))  pg8::gemm_phase<false>(ring, g, S, FStoreBf{(bf16_t*)(ws + WS_Q)}, F.tid); break;
                    case 9:  if constexpr (MFMA_MASK & (1 << 9))  pg8::gemm_phase<false>(ring, g, S, FWo{a.out, (bf16_t*)(ws + WS_A)}, F.tid); break;
                    case 11: if constexpr (MFMA_MASK & (1 << 11)) pg8::gemm_phase<true>(ring, g, S, FUp{tp, (const float*)(ws + WS_PSCALE), (bf16_t*)(ws + WS_HID)}, F.tid); break;
                    default: if constexpr (MFMA_MASK & (1 << 12)) pg8::gemm_phase<false>(ring, g, S, FDown{tp, (const int*)(ws + WS_PTOK), (const float*)(ws + WS_PCOMB), (bf16_t*)(ws + WS_PK0), (bf16_t*)(ws + WS_PK1)}, F.tid); break;
                    }
                } else { if constexpr ((MFMA_MASK & 0x1AF6) != 0x1AF6) pg8::ngemm_phase(F.lds + RING_OFF, g, S, E, F.tid); }
                }
            } else if (s == 0) { if constexpr (!(SKIPMASK & 1)) p0_prologue(a, F); }
            else if (s == 3) { if constexpr (!(SKIPMASK & 8)) { p2_pool(F); p2_ssm_naive(a, F); } }
            else if (s == 8) { if constexpr (!(SKIPMASK & 0x100)) p7_attn_naive(F); }
            else if (s == 10) { if constexpr (!(SKIPMASK & 0x400)) p9_router(a, F); }
            else { if constexpr (!(SKIPMASK & 0x2000)) p12_final(a, F); }
        }
        if (!MK_PER_PHASE && s + 1 < hi && seam_after(s)) grid_bar(ap);
    }
}

extern "C" void kernel_launch(void* const* d_in, const int* in_sizes, int n_in, void* d_out, int out_size, void* d_ws, size_t ws_size, hipStream_t stream) {
    static int grid = 0;
    if (grid == 0) {
        if (n_in != 33 || in_sizes[0] != T * D || out_size != T * D || ws_size < WS_END) {
            fprintf(stderr, "kernel_launch: shape/workspace mismatch (n_in %d, in0 %d, out %d, ws %zu, need %zu); nothing launched\n", n_in, n_in > 0 ? in_sizes[0] : -1, out_size, ws_size, (size_t)WS_END); grid = -1; return; }
        int dev = 0, cus = 0, per_cu = 0;
        if (hipGetDevice(&dev) != hipSuccess || hipDeviceGetAttribute(&cus, hipDeviceAttributeMultiprocessorCount, dev) != hipSuccess) { fprintf(stderr, "kernel_launch: device query failed\n"); grid = -1; return; }
        if (hipFuncSetAttribute((const void*)mk_fwd, hipFuncAttributeMaxDynamicSharedMemorySize, LDS_BYTES) != hipSuccess) { fprintf(stderr, "kernel_launch: hipFuncSetAttribute failed\n"); grid = -1; return; }
        if (hipOccupancyMaxActiveBlocksPerMultiprocessor(&per_cu, (const void*)mk_fwd, NWAVES * 64, LDS_BYTES) != hipSuccess || per_cu < 1) {
            fprintf(stderr, "kernel_launch: occupancy query reports %d workgroups per CU; nothing launched\n", per_cu); (void)hipGetLastError(); grid = -1; return; }
        grid = cus;
    }
    if (grid < 0) return;
    if (hipMemsetAsync((char*)d_ws + WS_CTL, 0, CTL_ZERO_BYTES, stream) != hipSuccess) { fprintf(stderr, "kernel_launch: memset failed\n"); return; }
    Args a{};
    for (int i = 0; i < 33; ++i) a.in[i] = (const float*)d_in[i];
    a.out = (float*)d_out; a.ws = (unsigned char*)d_ws;
    const int cuts[] = {0, 1, 3, 4, 5, 6, 7, 8, 9, 10, 11, 12, 13, 14};
    const int nl = MK_PER_PHASE ? 13 : 1;
    for (int li = 0; li < nl; ++li) {
        a.ph_lo = MK_PER_PHASE ? cuts[li] : 0; a.ph_hi = MK_PER_PHASE ? cuts[li + 1] : N_STEPS; a.li = li;
        hipLaunchKernelGGL(mk_fwd, dim3(grid), dim3(NWAVES * 64), LDS_BYTES, stream, a);
        const hipError_t le = hipPeekAtLastError();
        if (le != hipSuccess) { fprintf(stderr, "kernel_launch: launch %d failed: %s\n", li, hipGetErrorName(le)); break; }
    }
}
```

```cpp
#include <hip/hip_runtime.h>
#include <cstdio>
#include <cstdint>

#define GAS __attribute__((address_space(1)))
#define LAS __attribute__((address_space(3)))
typedef unsigned short bf16_t;
typedef float f32x4 __attribute__((ext_vector_type(4)));
typedef float f32x2 __attribute__((ext_vector_type(2)));
typedef unsigned u32x4 __attribute__((ext_vector_type(4)));
typedef unsigned u32x2 __attribute__((ext_vector_type(2)));
typedef short bf16x8 __attribute__((ext_vector_type(8)));
typedef GAS unsigned gu32;
#define RLX_AGENT __ATOMIC_RELAXED, __HIP_MEMORY_SCOPE_AGENT
#define LDS_WAIT() asm volatile("s_waitcnt lgkmcnt(0)" ::: "memory")
#define VM_WAIT() asm volatile("s_waitcnt vmcnt(0)" ::: "memory")
#define DI __device__ __forceinline__

#ifndef MK_PER_PHASE
#define MK_PER_PHASE 0
#endif

constexpr int BATCH = 4, SEQ = 8192, D = 1024, T = BATCH * SEQ;
constexpr int PW = 512, SW = 512, NSG = 32, GD = 16, NS = 64, INW = 3072;
constexpr int MEM = 256, XH = 4, XHD = 256, MROWS = BATCH * MEM;
constexpr int NE = 16, DE = 512;
constexpr float EPS = 1e-6f;
constexpr int NWAVES = 8;

constexpr size_t MiB = 1u << 20;
constexpr size_t WS_CTL = 0, CTL_ZERO_BYTES = 1 * MiB;
constexpr size_t WS_W1T = 1 * MiB;
constexpr size_t WS_WGLU = 7 * MiB;
constexpr size_t WS_WBRP = WS_WGLU + MiB / 2;
constexpr size_t WS_WBRS = WS_WBRP + MiB;
constexpr size_t WS_WOUT = WS_WBRS + MiB;
constexpr size_t WS_WQ = WS_WOUT + 2 * MiB;
constexpr size_t WS_WKV = WS_WQ + 2 * MiB;
constexpr size_t WS_WO = WS_WKV + 4 * MiB;
constexpr size_t WS_W13 = 20 * MiB;
constexpr size_t WS_W2T = 52 * MiB;
constexpr size_t WS_MEMN = 68 * MiB;
constexpr size_t WS_KC = 70 * MiB;
constexpr size_t WS_VT = 72 * MiB;
constexpr size_t WS_SSMT = 74 * MiB;
constexpr size_t WS_WSA = WS_SSMT;
constexpr size_t WS_TDA = WS_SSMT + 2 * MiB;
constexpr size_t WS_WOA = WS_TDA + MiB / 2;
constexpr size_t WS_MU = WS_WOA + 2 * MiB;
constexpr size_t WS_NU = WS_MU + 16384;
constexpr size_t WS_RT = 84 * MiB;
constexpr size_t WS_SSQ8 = 85 * MiB;
constexpr size_t WS_PTOK = 101 * MiB;
constexpr size_t WS_PCOMB = 103 * MiB;
constexpr size_t WS_PSCALE = 105 * MiB;
constexpr size_t WS_SLOC = 107 * MiB;
constexpr size_t WS_SSCAN = 109 * MiB;
constexpr size_t WS_A = 112 * MiB;
constexpr size_t WS_ZW = 176 * MiB;
constexpr size_t WS_VS = 208 * MiB;
constexpr size_t WS_MG = 176 * MiB;
constexpr size_t WS_Q = 176 * MiB;
constexpr size_t WS_G = 240 * MiB;
constexpr size_t WS_PK0 = 240 * MiB, WS_PK1 = 304 * MiB;
constexpr size_t WS_YP = 368 * MiB, WS_YG = 400 * MiB, WS_YS2 = 432 * MiB;
constexpr size_t WS_HID = 368 * MiB;
constexpr size_t WS_END = 464 * MiB;
constexpr int CW_TMO = 0, CW_CODE = 1;
constexpr int CW_BAR = 4096;
constexpr int CW_CNT = 16384;

constexpr int RING_OFF = 0, RING_BYTES = 131072;
constexpr int LDS_BYTES = 163840;
constexpr int LDSCTL_OFF = LDS_BYTES - 2048, MISC_OFF = LDSCTL_OFF + 320;
constexpr int XTAB_OFF = LDSCTL_OFF + 512;
constexpr int SSM_WS = 0, SSM_TD = 65536, SSM_WO = 81920, SSM_SCR = 147456;

DI float bf2f(unsigned b) { return __uint_as_float(b << 16); }
DI unsigned f2bf(float f) { unsigned u = __float_as_uint(f); return (u + 0x7fffu + ((u >> 16) & 1u)) >> 16; }
DI unsigned pk2(float lo, float hi) { return f2bf(lo) | (f2bf(hi) << 16); }
DI float sigm(float x) { return 1.f / (1.f + __expf(-x)); }
DI float gelu_tanh(float x) { return x * sigm(1.5957691216057308f * (x + 0.044715f * x * x * x)); }
DI float wave_sum(float v) {
#pragma unroll
    for (int o = 1; o < 64; o <<= 1) v += __shfl_xor(v, o);
    return v;
}
DI float wave_max(float v) {
#pragma unroll
    for (int o = 1; o < 64; o <<= 1) v = fmaxf(v, __shfl_xor(v, o));
    return v;
}
DI void store8bf(bf16_t* p, const f32x4& a, const f32x4& b) {
    u32x4 w; w.x = pk2(a[0], a[1]); w.y = pk2(a[2], a[3]); w.z = pk2(b[0], b[1]); w.w = pk2(b[2], b[3]);
    *(u32x4*)p = w;
}
DI void load8bf(const bf16_t* p, f32x4& a, f32x4& b) {
    const u32x4 w = *(const u32x4*)p;
    a[0] = bf2f(w.x & 0xffffu); a[1] = bf2f(w.x >> 16); a[2] = bf2f(w.y & 0xffffu); a[3] = bf2f(w.y >> 16);
    b[0] = bf2f(w.z & 0xffffu); b[1] = bf2f(w.z >> 16); b[2] = bf2f(w.w & 0xffffu); b[3] = bf2f(w.w >> 16);
}

#define XB_TMO      128
#define XB_XCNT(j)  (256  + 64 * (j))
#define XB_XSUB(j)  (1280 + 64 * (j))
#define XB_XGEN(j)  (2304 + 64 * (j))
#define XB_TOP      3328
#define XB_TOPGEN   3392
#define XCD_BAR_WORDS 3456
#define XB_SPIN_CAP (1u << 18)
DI unsigned xb_ld(unsigned* p)              { return __hip_atomic_load(p, __ATOMIC_RELAXED, __HIP_MEMORY_SCOPE_AGENT); }
DI unsigned xb_add(unsigned* p, unsigned v) { return __hip_atomic_fetch_add(p, v, __ATOMIC_RELAXED, __HIP_MEMORY_SCOPE_AGENT); }
DI unsigned xb_xcc_id() { return (unsigned)__builtin_amdgcn_s_getreg((3 << 11) | 20) & 0xFu; }
#define XB_SPIN(cond, bar) do { unsigned _sp = 0; while (cond) { __builtin_amdgcn_s_sleep(1); \
    if ((++_sp & 255u) == 0u) { if (xb_ld(&(bar)[XB_TMO])) break; if (_sp > XB_SPIN_CAP) { atomicAdd(&(bar)[XB_TMO], 1u); break; } } } } while (0)
struct XcdBarrier { unsigned* bar; unsigned x; volatile LAS unsigned* st; };
DI XcdBarrier xcd_barrier_post(unsigned* bar, volatile LAS unsigned* st) {
    XcdBarrier b; b.bar = bar; b.x = xb_xcc_id(); b.st = st;
    if (threadIdx.x == 0) (void)xb_add(&bar[XB_XCNT(b.x)], 1u);
    return b;
}
DI void xcd_barrier_complete(unsigned* bar, unsigned x, unsigned& nloc, unsigned& nx) {
    const unsigned G = gridDim.x * gridDim.y * gridDim.z;
    unsigned sum, cnt, mine, sp = 0u;
    for (;;) {
        sum = 0u; cnt = 0u; mine = 0u;
#pragma unroll
        for (unsigned j = 0; j < 16; ++j) { const unsigned c = xb_ld(&bar[XB_XCNT(j)]); sum += c; cnt += (c > 0u) ? 1u : 0u; mine = (j == x) ? c : mine; }
        if (sum == G) break;
        __builtin_amdgcn_s_sleep(1);
        if ((++sp & 255u) == 0u) { if (xb_ld(&bar[XB_TMO])) break; if (sp > XB_SPIN_CAP) { atomicAdd(&bar[XB_TMO], 1u); break; } }
    }
    nloc = mine > 0u ? mine : 1u; nx = cnt > 0u ? cnt : 1u;
}
DI void xcd_barrier(const XcdBarrier& b) {
    asm volatile("s_waitcnt vmcnt(0)" ::: "memory");
    __syncthreads();
    if (threadIdx.x == 0) {
        unsigned* bar = b.bar;
        __builtin_amdgcn_s_waitcnt(0);
        unsigned nloc = b.st[0], nx = b.st[1];
        if (nloc == 0u) { xcd_barrier_complete(bar, b.x, nloc, nx); b.st[0] = nloc; b.st[1] = nx; }
        const unsigned old = xb_add(&bar[XB_XSUB(b.x)], 1u);
        const unsigned gen = old / nloc;
        if (old + 1u == (gen + 1u) * nloc) {
            __builtin_amdgcn_fence(__ATOMIC_RELEASE, "agent");
            asm volatile("s_waitcnt vmcnt(0)" ::: "memory");
            const unsigned og = xb_add(&bar[XB_TOP], 1u);
            const unsigned tg = og / nx;
            if (og + 1u == (tg + 1u) * nx) xb_add(&bar[XB_TOPGEN], 1u);
            else XB_SPIN(xb_ld(&bar[XB_TOPGEN]) == tg, bar);
            __builtin_amdgcn_fence(__ATOMIC_ACQUIRE, "agent");
            xb_add(&bar[XB_XGEN(b.x)], 1u);
            asm volatile("s_waitcnt vmcnt(0)" ::: "memory");
        } else {
            XB_SPIN(xb_ld(&bar[XB_XGEN(b.x)]) == gen, bar);
            __builtin_amdgcn_fence(__ATOMIC_ACQUIRE, "agent");
            asm volatile("s_waitcnt vmcnt(0)" ::: "memory");
        }
    }
    __syncthreads();
}

namespace pg8 {
constexpr int BM = 256, BK = 64, HALF = 128, NXCD = 8, WGM = 8;
struct Unit { int pm, pn, e; };
struct Gemm { const bf16_t* A; const bf16_t* Bt; int K; const bf16_t* A2; const bf16_t* Bt2; size_t bstride; };

struct StaticOrder {
    int nM, nN, nwg, G, c;
    DI void init(int M, int N, int G_, int c_) { nM = M / BM; nN = N / BM; nwg = nM * nN; G = G_; c = c_; }
    DI bool tile(int L, Unit& u) const {
        if (L >= nwg) return false;
        int wgid = L; { const int q = nwg / NXCD, r = nwg % NXCD, xcd = wgid % NXCD, off = wgid / NXCD; wgid = (xcd < r ? xcd * (q + 1) : r * (q + 1) + (xcd - r) * q) + off; }
        const int nig = WGM * nN, gid = wgid / nig, fm = gid * WGM, gsz = (nM - fm) < WGM ? (nM - fm) : WGM;
        u.pm = fm + ((wgid % nig) % gsz); u.pn = (wgid % nig) / gsz; u.e = 0; return true;
    }
    DI bool next(int i, Unit& u) const { return tile(i * G + c, u); }
    DI const bf16_t* a_base(const Gemm& g, const Unit&) const { return g.A; }
    DI const bf16_t* a_row(const Gemm& g, const Unit& u, int r) const { return g.A + (size_t)(u.pm * BM + r) * g.K; }
    DI const bf16_t* b_row(const Gemm& g, const Unit& u, int n) const { return g.Bt + (size_t)(u.pn * BM + n) * g.K; }
};
struct USched {
    int mode; StaticOrder so; const volatile LAS int* tp; const int* ptok; int nN;
    DI bool next(int i, Unit& u) const {
        if (mode == 0) return so.tile(i * so.G + so.c, u);
        if (mode == 1) { if (!so.tile((i >> 1) * so.G + so.c, u)) return false; u.e = i & 1; return true; }
        const int L = i * so.G + so.c, total = tp[16] * nN; if (L >= total) return false;
        const int mt = L / nN; int e = 0;
#pragma unroll
        for (int j = 1; j < 16; ++j) e += (mt >= tp[j]) ? 1 : 0;
        u.pm = __builtin_amdgcn_readfirstlane(mt); u.pn = __builtin_amdgcn_readfirstlane(L % nN); u.e = __builtin_amdgcn_readfirstlane(e); return true;
    }
    DI const bf16_t* a_base(const Gemm& g, const Unit& u) const { return (mode == 1 && u.e) ? g.A2 : g.A; }
    DI const bf16_t* a_row(const Gemm& g, const Unit& u, int r) const {
        if (mode == 2) {
            const int slot = (u.pm - tp[u.e]) * BM + r; const int cnt = tp[32 + u.e];
            const int tok = slot < cnt ? (ptok[u.e * T + slot] & 0x7fffffff) : 0;
            return g.A + (size_t)tok * g.K;
        }
        return a_base(g, u) + (size_t)(u.pm * BM + r) * g.K;
    }
    DI const bf16_t* b_row(const Gemm& g, const Unit& u, int n) const {
        const bf16_t* b = (mode == 1 && u.e) ? g.Bt2 : g.Bt;
        if (mode >= 2) b += (size_t)u.e * g.bstride;
        return b + (size_t)(u.pn * BM + n) * g.K;
    }
};


template <class Epi, class Sched>
DI void ngemm_phase(LAS unsigned char* lds, const Gemm g, const Sched& S, const Epi& E, const int tid) {
    LAS float* As = (LAS float*)lds;
    LAS float* Bs = As + 16 * 132;
    const int lr = tid >> 2, kq = tid & 3, tx = tid & 15, ty = tid >> 4;
    Unit u;
    for (int i = 0; S.next(i, u); ++i) {
        for (int sub = 0; sub < 4; ++sub) {
            const int sm = (sub >> 1) * 128, sn = (sub & 1) * 128;
            float acc[4][8];
#pragma unroll
            for (int r = 0; r < 4; ++r)
#pragma unroll
                for (int c = 0; c < 8; ++c) acc[r][c] = 0.f;
            const bf16_t* arow = S.a_row(g, u, sm + lr) + kq * 4;
            const bf16_t* brow = S.b_row(g, u, sn + lr) + kq * 4;
            for (int k0 = 0; k0 < g.K; k0 += 16) {
                __syncthreads();
                const u32x2 av = *(const u32x2*)(arow + k0), bv = *(const u32x2*)(brow + k0);
                As[(kq * 4 + 0) * 132 + lr] = bf2f(av.x & 0xffffu); As[(kq * 4 + 1) * 132 + lr] = bf2f(av.x >> 16);
                As[(kq * 4 + 2) * 132 + lr] = bf2f(av.y & 0xffffu); As[(kq * 4 + 3) * 132 + lr] = bf2f(av.y >> 16);
                Bs[(kq * 4 + 0) * 132 + lr] = bf2f(bv.x & 0xffffu); Bs[(kq * 4 + 1) * 132 + lr] = bf2f(bv.x >> 16);
                Bs[(kq * 4 + 2) * 132 + lr] = bf2f(bv.y & 0xffffu); Bs[(kq * 4 + 3) * 132 + lr] = bf2f(bv.y >> 16);
                __syncthreads();
#pragma unroll
                for (int k = 0; k < 16; ++k) {
                    const f32x4 a4 = *(const LAS f32x4*)(As + k * 132 + ty * 4);
                    const f32x4 b0 = *(const LAS f32x4*)(Bs + k * 132 + tx * 8), b1 = *(const LAS f32x4*)(Bs + k * 132 + tx * 8 + 4);
#pragma unroll
                    for (int r = 0; r < 4; ++r) {
#pragma unroll
                        for (int c = 0; c < 4; ++c) { acc[r][c] += a4[r] * b0[c]; acc[r][4 + c] += a4[r] * b1[c]; }
                    }
                }
            }
#pragma unroll
            for (int r = 0; r < 4; ++r) {
                f32x4 v0 = {acc[r][0], acc[r][1], acc[r][2], acc[r][3]}, v1 = {acc[r][4], acc[r][5], acc[r][6], acc[r][7]};
                E(u, u.pm * BM + sm + ty * 4 + r, u.pn * BM + sn + tx * 8, v0, v1);
            }
        }
    }
    __syncthreads();
}

template <class F> DI void epi_drive(const F& f, const Unit& u, f32x4 (&acc)[2][2][4][2], int wr, int wc, int fr, int fq) {
#pragma unroll
    for (int ai = 0; ai < 2; ++ai)
#pragma unroll
        for (int m = 0; m < 4; ++m) { const int row = u.pm * 256 + ai * 128 + wr * 64 + m * 16 + fr;
#pragma unroll
            for (int bj = 0; bj < 2; ++bj) f(u, row, u.pn * 256 + bj * 128 + wc * 32 + 8 * fq, acc[ai][bj][m][0], acc[ai][bj][m][1]);
            asm volatile("" ::: "memory"); }
}
DI int lds_byte(int r, int c) { const int st = (r >> 4) * 2 + (c >> 5), rr = r & 15, cc = c & 31, ob = rr * 64 + cc * 2; return st * 1024 + (ob ^ (((ob >> 9) & 1) << 5)); }
DI void stage_rc(int b, int& R, int& C) { const int st = b / 1024, sb = b % 1024, swz = sb ^ (((sb >> 9) & 1) << 5); R = (st >> 1) * 16 + swz / 64; C = (st & 1) * 32 + (swz % 64) / 2; }
DI int perm32(int rho) { const int n = rho >> 4, i = rho & 15; return 8 * (i >> 2) + 4 * n + (i & 3); }
constexpr int HTB = HALF * BK * 2;
template <bool GATHER, class F, class Sched>
DI void gemm_phase(LAS unsigned char* lds, const Gemm g, const Sched& S, const F& E, const int tid) {
    const int wid = __builtin_amdgcn_readfirstlane(tid >> 6), lane = tid & 63, wr = wid >> 2, wc = wid & 3, fr = lane & 15, fq = lane >> 4;
    const int K = g.K, nt = K / BK;
    int Rr[2], Cc[2]; unsigned voffB[2];
#pragma unroll
    for (int i = 0; i < 2; ++i) { int R, C; stage_rc(tid * 16 + i * 8192, R, C); Rr[i] = R; Cc[i] = C; const int Rb = (R & ~31) + perm32(R & 31); voffB[i] = (unsigned)(Rb * K + C) * 2u; }
    const size_t kstep = (size_t)(BK * 2);
    const size_t hstep = (size_t)HALF * K * 2;
    const unsigned ldsw = (unsigned)wid * 1024u;
    const int aoff = lds_byte(wr * 64 + fr, fq * 8), boff = lds_byte(wc * 32 + fr, fq * 8);
#define PG8_SA(b, h) (((b) * 2 + (h)) * HTB)
#define PG8_SB(b, h) ((4 + (b) * 2 + (h)) * HTB)
#define PG8_STAGE2(bufoff, gbase, v0_, v1_) do { \
        __builtin_amdgcn_global_load_lds((const unsigned*)((const char*)(gbase) + (v0_)), (LAS unsigned*)(lds + (bufoff) + ldsw), 16, 0, 0); \
        __builtin_amdgcn_global_load_lds((const unsigned*)((const char*)(gbase) + (v1_)), (LAS unsigned*)(lds + (bufoff) + ldsw + 8192), 16, 0, 0); } while (0)
#define PG8_STAGEB(bufoff, gbase) PG8_STAGE2(bufoff, gbase, voffB[0], voffB[1])
#define PG8_LDA(dst, b, h) do { _Pragma("unroll") for (int m = 0; m < 4; ++m) _Pragma("unroll") for (int k = 0; k < 2; ++k) dst[m][k] = *(const LAS bf16x8*)(lds + PG8_SA(b, h) + aoff + m * 2048 + k * 1024); } while (0)
#define PG8_LDB(dst, b, h) do { _Pragma("unroll") for (int n = 0; n < 2; ++n) _Pragma("unroll") for (int k = 0; k < 2; ++k) dst[n][k] = *(const LAS bf16x8*)(lds + PG8_SB(b, h) + boff + n * 2048 + k * 1024); } while (0)
#define PG8_MMA(ai, bj, At, Bt) do { __builtin_amdgcn_s_setprio(1); _Pragma("unroll") for (int m = 0; m < 4; ++m) _Pragma("unroll") for (int n = 0; n < 2; ++n) _Pragma("unroll") for (int k = 0; k < 2; ++k) \
        acc[ai][bj][m][n] = __builtin_amdgcn_mfma_f32_16x16x32_bf16(Bt[n][k], At[m][k], acc[ai][bj][m][n], 0, 0, 0); __builtin_amdgcn_s_setprio(0); } while (0)
#define PG8_WAIT_V(n) asm volatile("s_waitcnt vmcnt(" #n ")" ::: "memory")
#define PG8_WAIT_L(n) asm volatile("s_waitcnt lgkmcnt(" #n ")" ::: "memory")
#define PG8_BAR __builtin_amdgcn_s_barrier()
#define PG8_SCHED __builtin_amdgcn_sched_barrier(0)
    Unit cur, nxt; int ui = 0;
    if (!S.next(0, cur)) return;
    f32x4 acc[2][2][4][2];
#pragma unroll
    for (int a = 0; a < 2; ++a)
#pragma unroll
        for (int b = 0; b < 2; ++b)
#pragma unroll
            for (int m = 0; m < 4; ++m)
#pragma unroll
                for (int n = 0; n < 2; ++n) acc[a][b][m][n] = (f32x4){0.f, 0.f, 0.f, 0.f};
    bf16x8 At[4][2], B0[2][2], B1[2][2];
    const char* cA = GATHER ? (const char*)S.a_base(g, cur) : (const char*)S.a_row(g, cur, 0); const char* cB = (const char*)S.b_row(g, cur, 0);
    unsigned vc00, vc01, vc10, vc11;
    if constexpr (GATHER) {
        vc00 = (unsigned)((const char*)S.a_row(g, cur, Rr[0]) - cA) + (unsigned)Cc[0] * 2u; vc01 = (unsigned)((const char*)S.a_row(g, cur, Rr[1]) - cA) + (unsigned)Cc[1] * 2u;
        vc10 = (unsigned)((const char*)S.a_row(g, cur, HALF + Rr[0]) - cA) + (unsigned)Cc[0] * 2u; vc11 = (unsigned)((const char*)S.a_row(g, cur, HALF + Rr[1]) - cA) + (unsigned)Cc[1] * 2u;
    } else {
        vc00 = (unsigned)(Rr[0] * K + Cc[0]) * 2u; vc01 = (unsigned)(Rr[1] * K + Cc[1]) * 2u; vc10 = vc00 + (unsigned)hstep; vc11 = vc01 + (unsigned)hstep;
    }
    PG8_STAGEB(PG8_SB(0, 0), cB); PG8_STAGEB(PG8_SB(0, 1), cB + hstep); PG8_STAGE2(PG8_SA(0, 0), cA, vc00, vc01); PG8_STAGE2(PG8_SA(0, 1), cA, vc10, vc11);
    if (wr == 1) PG8_BAR;
    PG8_WAIT_V(2); PG8_BAR;
    PG8_STAGEB(PG8_SB(1, 0), cB + kstep); PG8_STAGE2(PG8_SA(1, 0), cA + kstep, vc00, vc01); PG8_STAGEB(PG8_SB(1, 1), cB + hstep + kstep);
    PG8_WAIT_V(6); PG8_BAR;
    for (;;) {
        const bool has_next = S.next(ui + 1, nxt);
        const char* nA = cA; const char* nB = cB; unsigned vn00 = vc00, vn01 = vc01, vn10 = vc10, vn11 = vc11;
        if (has_next) {
            nB = (const char*)S.b_row(g, nxt, 0);
            if constexpr (GATHER) {
                nA = (const char*)S.a_base(g, nxt);
                vn00 = (unsigned)((const char*)S.a_row(g, nxt, Rr[0]) - nA) + (unsigned)Cc[0] * 2u; vn01 = (unsigned)((const char*)S.a_row(g, nxt, Rr[1]) - nA) + (unsigned)Cc[1] * 2u;
                vn10 = (unsigned)((const char*)S.a_row(g, nxt, HALF + Rr[0]) - nA) + (unsigned)Cc[0] * 2u; vn11 = (unsigned)((const char*)S.a_row(g, nxt, HALF + Rr[1]) - nA) + (unsigned)Cc[1] * 2u;
            } else nA = (const char*)S.a_row(g, nxt, 0);
        }
        for (int t = 0; t < nt; t += 2) {
            const bool last = (t == nt - 2);
            const char* a1 = cA + (size_t)(t + 1) * kstep;
            const char* a2 = last ? nA : cA + (size_t)(t + 2) * kstep; const char* b2 = last ? nB : cB + (size_t)(t + 2) * kstep;
            const char* a3 = a2 + kstep; const char* b3 = b2 + kstep;
            const unsigned w00 = (GATHER && last) ? vn00 : vc00, w01 = (GATHER && last) ? vn01 : vc01, w10 = (GATHER && last) ? vn10 : vc10, w11 = (GATHER && last) ? vn11 : vc11;
            PG8_LDB(B0, 0, 0); PG8_LDB(B1, 0, 1); PG8_SCHED; PG8_LDA(At, 0, 0); PG8_STAGE2(PG8_SA(1, 1), a1, vc10, vc11);
            PG8_WAIT_V(8); PG8_WAIT_L(0); PG8_BAR; PG8_MMA(0, 0, At, B0); PG8_MMA(0, 1, At, B1); PG8_BAR; PG8_SCHED;
            PG8_LDA(At, 0, 1); PG8_STAGEB(PG8_SB(0, 0), b2); PG8_STAGEB(PG8_SB(0, 1), b2 + hstep); PG8_STAGE2(PG8_SA(0, 0), a2, w00, w01);
            PG8_WAIT_V(8); PG8_WAIT_L(0); PG8_BAR; PG8_MMA(1, 0, At, B0); PG8_MMA(1, 1, At, B1); PG8_BAR; PG8_SCHED;
            PG8_LDB(B0, 1, 0); PG8_LDB(B1, 1, 1); PG8_SCHED; PG8_LDA(At, 1, 0); PG8_STAGE2(PG8_SA(0, 1), a2, w10, w11);
            PG8_WAIT_V(8); PG8_WAIT_L(0); PG8_BAR; PG8_MMA(0, 0, At, B0); PG8_MMA(0, 1, At, B1); PG8_BAR; PG8_SCHED;
            PG8_LDA(At, 1, 1); PG8_STAGEB(PG8_SB(1, 0), b3); PG8_STAGEB(PG8_SB(1, 1), b3 + hstep); PG8_STAGE2(PG8_SA(1, 0), a3, w00, w01);
            PG8_WAIT_V(8); PG8_WAIT_L(0); PG8_BAR; PG8_MMA(1, 0, At, B0); PG8_MMA(1, 1, At, B1); PG8_BAR; PG8_SCHED;
        }
        if (wr == 0) PG8_BAR;
        epi_drive(E, cur, acc, wr, wc, fr, fq);
        const bool keep = E.keep(cur);
        if (!has_next) break;
        if (!keep) {
#pragma unroll
            for (int a = 0; a < 2; ++a)
#pragma unroll
                for (int b = 0; b < 2; ++b)
#pragma unroll
                    for (int m = 0; m < 4; ++m)
#pragma unroll
                        for (int n = 0; n < 2; ++n) acc[a][b][m][n] = (f32x4){0.f, 0.f, 0.f, 0.f};
        }
        cur = nxt; cA = nA; cB = nB; vc00 = vn00; vc01 = vn01; vc10 = vn10; vc11 = vn11; ++ui;
        if (wr == 1) PG8_BAR;
    }
    PG8_WAIT_V(0);
    PG8_BAR;
#undef PG8_SA
#undef PG8_SB
#undef PG8_STAGE2
#undef PG8_STAGEB
#undef PG8_LDA
#undef PG8_LDB
#undef PG8_MMA
#undef PG8_WAIT_V
#undef PG8_WAIT_L
#undef PG8_BAR
#undef PG8_SCHED
}
}

struct FProj {
    DI bool keep(const pg8::Unit&) const { return false; }
    bf16_t* zw; bf16_t* vs; bf16_t* g;
    DI void operator()(const pg8::Unit&, int row, int col, f32x4& v0, f32x4& v1) const {
        if (col < 512) store8bf(zw + (size_t)row * 512 + col, v0, v1);
        else if (col < 1024) { const int c0 = col - 512; store8bf(vs + ((size_t)(c0 >> 4) * T + row) * 16 + (c0 & 15), v0, v1); }
        else {
            f32x4 a, b;
#pragma unroll
            for (int j = 0; j < 4; ++j) { a[j] = sigm(v0[j]); b[j] = sigm(v1[j]); }
            store8bf(g + (size_t)row * 2048 + (col - 1024), a, b);
        }
    }
};
struct FKV {
    DI bool keep(const pg8::Unit&) const { return false; }
    bf16_t* kc; bf16_t* vt;
    DI void operator()(const pg8::Unit&, int row, int col, f32x4& v0, f32x4& v1) const {
        if (col < 1024) store8bf(kc + (size_t)row * 1024 + col, v0, v1);
        else {
            const int c = col - 1024, h = c >> 8, d = c & 255, b = row >> 8, key = row & 255;
            bf16_t* p = vt + ((size_t)((b * 4 + h) * 256 + d)) * 256 + key;
#pragma unroll
            for (int j = 0; j < 4; ++j) { p[(size_t)j * 256] = (bf16_t)f2bf(v0[j]); p[(size_t)(4 + j) * 256] = (bf16_t)f2bf(v1[j]); }
        }
    }
};
struct FGlu {
    DI bool keep(const pg8::Unit&) const { return false; }
    const bf16_t* yg; const float* bias; bf16_t* ys2;
    DI void operator()(const pg8::Unit&, int row, int col, f32x4& v0, f32x4& v1) const {
        f32x4 y0, y1; load8bf(yg + (size_t)row * 512 + col, y0, y1);
        const f32x4 b0 = *(const f32x4*)(bias + col), b1 = *(const f32x4*)(bias + col + 4);
        f32x4 a, b;
#pragma unroll
        for (int j = 0; j < 4; ++j) { a[j] = y0[j] * sigm(v0[j] + b0[j]); b[j] = y1[j] * sigm(v1[j] + b1[j]); }
        store8bf(ys2 + (size_t)row * 512 + col, a, b);
    }
};
struct FBrNaive {
    DI bool keep(const pg8::Unit&) const { return false; }
    const bf16_t* g; float* tmp; bf16_t* mg;
    DI void operator()(const pg8::Unit& u, int row, int col, f32x4& v0, f32x4& v1) const {
        f32x4 g0, g1; load8bf(g + (size_t)row * 2048 + (u.e ? 1024 : 0) + col, g0, g1);
        float* tp = tmp + (size_t)row * 1024 + col;
        if (u.e == 0) { *(f32x4*)tp = g0 * v0; *(f32x4*)(tp + 4) = g1 * v1; }
        else { const f32x4 t0 = *(const f32x4*)tp, t1 = *(const f32x4*)(tp + 4); store8bf(mg + (size_t)row * 1024 + col, t0 + g0 * v0, t1 + g1 * v1); }
    }
};
struct FBr {
    DI bool keep(const pg8::Unit& u) const { return u.e == 0; }
    const bf16_t* g; bf16_t* mg;
    DI void operator()(const pg8::Unit& u, int row, int col, f32x4& v0, f32x4& v1) const {
        f32x4 a0, a1, b0, b1; load8bf(g + (size_t)row * 2048 + col, a0, a1); load8bf(g + (size_t)row * 2048 + 1024 + col, b0, b1);
        if (u.e == 0) {
#pragma unroll
            for (int j = 0; j < 4; ++j) { v0[j] *= a0[j] / fmaxf(b0[j], 1e-30f); v1[j] *= a1[j] / fmaxf(b1[j], 1e-30f); }
        } else store8bf(mg + (size_t)row * 1024 + col, v0 * (f32x4){fmaxf(b0[0], 1e-30f), fmaxf(b0[1], 1e-30f), fmaxf(b0[2], 1e-30f), fmaxf(b0[3], 1e-30f)},
                                                       v1 * (f32x4){fmaxf(b1[0], 1e-30f), fmaxf(b1[1], 1e-30f), fmaxf(b1[2], 1e-30f), fmaxf(b1[3], 1e-30f)});
    }
};
struct FWout {
    DI bool keep(const pg8::Unit&) const { return false; }
    const float* x; float* out; bf16_t* hb; float* ssq8;
    DI void operator()(const pg8::Unit&, int row, int col, f32x4& v0, f32x4& v1) const {
        const size_t o = (size_t)row * 1024 + col;
        const f32x4 h0 = *(const f32x4*)(x + o) + v0, h1 = *(const f32x4*)(x + o + 4) + v1;
        *(f32x4*)(out + o) = h0; *(f32x4*)(out + o + 4) = h1;
        store8bf(hb + o, h0, h1);
        ssq8[(size_t)row * 128 + (col >> 3)] = (h0[0] * h0[0] + h0[1] * h0[1]) + (h0[2] * h0[2] + h0[3] * h0[3]) + (h1[0] * h1[0] + h1[1] * h1[1]) + (h1[2] * h1[2] + h1[3] * h1[3]);
    }
};
struct FStoreBf {
    DI bool keep(const pg8::Unit&) const { return false; }
    bf16_t* o;
    DI void operator()(const pg8::Unit&, int row, int col, f32x4& v0, f32x4& v1) const { store8bf(o + (size_t)row * 1024 + col, v0, v1); }
};
struct FWo {
    DI bool keep(const pg8::Unit&) const { return false; }
    float* out; bf16_t* hb;
    DI void operator()(const pg8::Unit&, int row, int col, f32x4& v0, f32x4& v1) const {
        const size_t o = (size_t)row * 1024 + col;
        const f32x4 h0 = *(const f32x4*)(out + o) + v0, h1 = *(const f32x4*)(out + o + 4) + v1;
        *(f32x4*)(out + o) = h0; *(f32x4*)(out + o + 4) = h1;
        store8bf(hb + o, h0, h1);
    }
};
struct FUp {
    DI bool keep(const pg8::Unit&) const { return false; }
    const volatile LAS int* tp; const float* pscale; bf16_t* hid;
    DI void operator()(const pg8::Unit& u, int row, int col, f32x4& v0, f32x4& v1) const {
        const int slot = row - tp[u.e] * 256;
        if (slot < tp[32 + u.e]) {
            const float s = pscale[u.e * T + slot];
            u32x2 w; float h[4];
#pragma unroll
            for (int j = 0; j < 4; ++j) { const float a = v0[j] * s, b = v1[j] * s; h[j] = a * sigm(a) * b; }
            w.x = pk2(h[0], h[1]); w.y = pk2(h[2], h[3]);
            *(u32x2*)(hid + (size_t)row * 512 + (col >> 1)) = w;
        }
    }
};
struct FDown {
    DI bool keep(const pg8::Unit&) const { return false; }
    const volatile LAS int* tp; const int* ptok; const float* pcomb; bf16_t* pk0; bf16_t* pk1;
    DI void operator()(const pg8::Unit& u, int row, int col, f32x4& v0, f32x4& v1) const {
        const int slot = row - tp[u.e] * 256;
        if (slot < tp[32 + u.e]) {
            const int t = ptok[u.e * T + slot]; const float c = pcomb[u.e * T + slot];
            bf16_t* dst = ((t < 0) ? pk1 : pk0) + (size_t)(t & 0x7fffffff) * 1024 + col;
            store8bf(dst, v0 * c, v1 * c);
        }
    }
};

enum { E_PROJ = 0, E_KV, E_GLU, E_BR, E_WOUT, E_Q, E_WO, E_UP, E_DOWN, E_BRN };
struct UEpi {
    int id; const volatile LAS int* tp; unsigned char* ws; const float* x; float* out; const float* glub;
    DI void operator()(const pg8::Unit& u, int row, int col, f32x4& v0, f32x4& v1) const {
        switch (id) {
        case E_PROJ: FProj{(bf16_t*)(ws + WS_ZW), (bf16_t*)(ws + WS_VS), (bf16_t*)(ws + WS_G)}(u, row, col, v0, v1); break;
        case E_KV:   FKV{(bf16_t*)(ws + WS_KC), (bf16_t*)(ws + WS_VT)}(u, row, col, v0, v1); break;
        case E_GLU:  FGlu{(const bf16_t*)(ws + WS_YG), glub, (bf16_t*)(ws + WS_YS2)}(u, row, col, v0, v1); break;
        case E_BR:   FBr{(const bf16_t*)(ws + WS_G), (bf16_t*)(ws + WS_MG)}(u, row, col, v0, v1); break;
        case E_BRN:  FBrNaive{(const bf16_t*)(ws + WS_G), out, (bf16_t*)(ws + WS_MG)}(u, row, col, v0, v1); break;
        case E_WOUT: FWout{x, out, (bf16_t*)(ws + WS_A), (float*)(ws + WS_SSQ8)}(u, row, col, v0, v1); break;
        case E_Q:    FStoreBf{(bf16_t*)(ws + WS_Q)}(u, row, col, v0, v1); break;
        case E_WO:   FWo{out, (bf16_t*)(ws + WS_A)}(u, row, col, v0, v1); break;
        case E_UP:   FUp{tp, (const float*)(ws + WS_PSCALE), (bf16_t*)(ws + WS_HID)}(u, row, col, v0, v1); break;
        case E_DOWN: default: FDown{tp, (const int*)(ws + WS_PTOK), (const float*)(ws + WS_PCOMB), (bf16_t*)(ws + WS_PK0), (bf16_t*)(ws + WS_PK1)}(u, row, col, v0, v1); break;
        }
    }
    DI bool keep(const pg8::Unit& u) const { return id == E_BR && u.e == 0; }
    DI UEpi fresh() const { UEpi e = *this; asm volatile("" : "+s"(e.ws), "+s"(e.x), "+s"(e.out), "+s"(e.glub), "+s"(e.id)); return e; }
};

struct Args { const float* in[33]; float* out; unsigned char* ws; int ph_lo, ph_hi, li, pad; };
struct Frame {
    LAS unsigned char* lds; volatile LAS unsigned* MISC; gu32* ctl;
    int tid, lane, wave, vcu, G, bid; unsigned char* ws;
};
typedef __attribute__((address_space(4))) const Args CArgs;
#if defined(__HIP_DEVICE_COMPILE__)
DI Args phase_args(CArgs* p) { asm volatile("" : "+s"(p)); return *p; }
#else
DI Args phase_args(CArgs* p) { return Args{}; }
#endif
DI Frame make_frame(const Args& a) {
    Frame F;
    extern __shared__ __attribute__((aligned(16))) unsigned char lds[];
    F.lds = (LAS unsigned char*)lds;
    F.MISC = (volatile LAS unsigned*)(F.lds + MISC_OFF);
    { int t = threadIdx.x; asm volatile("" : "+v"(t)); F.tid = t; }
    F.lane = F.tid & 63; F.wave = __builtin_amdgcn_readfirstlane(F.tid >> 6);
    int bx = blockIdx.x, gx = gridDim.x; asm volatile("" : "+s"(bx), "+s"(gx));
    F.G = gx; F.bid = bx; F.vcu = (F.G % 8 == 0) ? (bx % 8) * (F.G / 8) + bx / 8 : bx;
    F.ws = a.ws; F.ctl = (gu32*)(a.ws + WS_CTL);
    return F;
}
enum { I_X = 0, I_MEM, I_NMIX, I_WIN, I_POOLW, I_POOLS, I_ARE, I_AIM, I_LOGDT, I_BRE, I_BIM, I_CRE, I_CIM, I_SD, I_GLUW, I_GLUB, I_BRP, I_BRS,
       I_WOUT, I_NX, I_NMEM, I_WQ, I_WKV, I_WO, I_NFFN, I_RGW, I_RGB, I_REW, I_REB, I_W1, I_W3, I_W2, I_NFIN };

DI void ssm_tables_item(const Args& a, Frame& F, int g, int p) {
    LAS float* lamr = (LAS float*)(F.lds);
    LAS float* lami = lamr + 17 * 64;
    LAS float* Bbr = lami + 17 * 64;
    LAS float* Bbi = Bbr + 1024;
    LAS float* Cr = Bbi + 1024;
    LAS float* Ci = Cr + 1024;
    const int tid = F.tid;
    __syncthreads();
    if (tid < 64) {
        const int n = tid;
        const float dt = expf(a.in[I_LOGDT][g]), ar = a.in[I_ARE][g * 64 + n], ai = a.in[I_AIM][g * 64 + n];
        for (int m = 0; m <= 16; ++m) { const float mag = expf((float)m * ar * dt); float sn, cs; sincosf((float)m * ai * dt, &sn, &cs); lamr[m * 64 + n] = mag * cs; lami[m * 64 + n] = mag * sn; }
        const float lr = lamr[64 + n], li = lami[64 + n], den = ar * ar + ai * ai, nr = lr - 1.f, ni = li;
        const float fre = (nr * ar + ni * ai) / den, fim = (ni * ar - nr * ai) / den;
        for (int c = 0; c < 16; ++c) {
            const float br = a.in[I_BRE][(size_t)(g * 64 + n) * 16 + c], bi = a.in[I_BIM][(size_t)(g * 64 + n) * 16 + c];
            Bbr[n * 16 + c] = fre * br - fim * bi; Bbi[n * 16 + c] = fre * bi + fim * br;
        }
        if (p == 0) {
            float* mu = (float*)(F.ws + WS_MU) + g * 128; float* nu = (float*)(F.ws + WS_NU) + g * 128;
            mu[n] = lamr[16 * 64 + n]; mu[64 + n] = lami[16 * 64 + n];
            const float mag = expf(256.f * ar * dt); float sn, cs; sincosf(256.f * ai * dt, &sn, &cs); nu[n] = mag * cs; nu[64 + n] = mag * sn;
        }
    }
    for (int e = tid; e < 1024; e += 512) { Cr[e] = a.in[I_CRE][(size_t)g * 1024 + e]; Ci[e] = a.in[I_CIM][(size_t)g * 1024 + e]; }
    __syncthreads();
    bf16_t* wsa = (bf16_t*)(F.ws + WS_WSA); bf16_t* tda = (bf16_t*)(F.ws + WS_TDA); bf16_t* woa = (bf16_t*)(F.ws + WS_WOA);
    {
        const int nt = p;
        for (int e = tid; e < 4096; e += 512) {
            const int ks = e >> 9, l = (e >> 3) & 63, jj = e & 7, r = l & 15, q = l >> 4, npr = 16 * nt + r, n = npr & 63, i = 2 * ks + (q >> 1), cp = 8 * (q & 1) + jj, m = 15 - i;
            const float zr = lamr[m * 64 + n] * Bbr[n * 16 + cp] - lami[m * 64 + n] * Bbi[n * 16 + cp], zi = lamr[m * 64 + n] * Bbi[n * 16 + cp] + lami[m * 64 + n] * Bbr[n * 16 + cp];
            wsa[((size_t)(g * 8 + nt) * 8 + ks) * 512 + l * 8 + jj] = (bf16_t)f2bf(npr < 64 ? zr : zi);
        }
    }
    {
        for (int e = tid; e < 4096; e += 512) {
            const int i = 2 * p + (e >> 11), s = (e >> 9) & 3, l = (e >> 3) & 63, jj = e & 7, cc = l & 15, q = l >> 4;
            const int npr = 32 * s + (jj < 4 ? 4 * q + jj : 16 + 4 * q + jj - 4), n = npr & 63, m = i + 1;
            const float zr = Cr[cc * 64 + n] * lamr[m * 64 + n] - Ci[cc * 64 + n] * lami[m * 64 + n], zi = Cr[cc * 64 + n] * lami[m * 64 + n] + Ci[cc * 64 + n] * lamr[m * 64 + n];
            woa[((size_t)(g * 16 + i) * 4 + s) * 512 + l * 8 + jj] = (bf16_t)f2bf(npr < 64 ? zr : -zi);
        }
    }
    {
        for (int e = tid; e < 1024; e += 512) {
            const int d = 2 * p + (e >> 9), l = (e >> 3) & 63, jj = e & 7, cc = l & 15, q = l >> 4, kk = q >> 1, cp = 8 * (q & 1) + jj, m = d - kk;
            float acc = 0.f;
            if (m >= 0) {
                for (int n = 0; n < 64; ++n) {
                    const float tr = lamr[m * 64 + n] * Bbr[n * 16 + cp] - lami[m * 64 + n] * Bbi[n * 16 + cp], ti = lamr[m * 64 + n] * Bbi[n * 16 + cp] + lami[m * 64 + n] * Bbr[n * 16 + cp];
                    acc += Cr[cc * 64 + n] * tr - Ci[cc * 64 + n] * ti;
                }
                if (m == 0 && cc == cp) acc += a.in[I_SD][g * 16 + cc];
            }
            tda[((size_t)g * 16 + d) * 512 + l * 8 + jj] = (bf16_t)f2bf(acc);
        }
    }
}
template <int D_> DI float row_shr(float x) { return __int_as_float(__builtin_amdgcn_update_dpp(0, __float_as_int(x), 0x110 + D_, 0xf, 0xf, true)); }
template <int D_> DI void ssm_scan_step(f32x4 (&zr)[4], f32x4 (&zi)[4], f32x4 (&mr)[4], f32x4 (&mi)[4]) {
#pragma unroll
    for (int nt = 0; nt < 4; ++nt)
#pragma unroll
        for (int r = 0; r < 4; ++r) {
            const float sr = row_shr<D_>(zr[nt][r]), si = row_shr<D_>(zi[nt][r]);
            zr[nt][r] += mr[nt][r] * sr - mi[nt][r] * si; zi[nt][r] += mr[nt][r] * si + mi[nt][r] * sr;
            const float a2 = mr[nt][r] * mr[nt][r] - mi[nt][r] * mi[nt][r], b2 = 2.f * mr[nt][r] * mi[nt][r]; mr[nt][r] = a2; mi[nt][r] = b2;
        }
}
DI bf16x8 pack8(const f32x4& a, const f32x4& b) { u32x4 w; w.x = pk2(a[0], a[1]); w.y = pk2(a[2], a[3]); w.z = pk2(b[0], b[1]); w.w = pk2(b[2], b[3]); return __builtin_bit_cast(bf16x8, w); }
template <bool OUT>
DI void ssm_pass(Frame& F) {
    const bf16_t* vs = (const bf16_t*)(F.ws + WS_VS); bf16_t* yg = (bf16_t*)(F.ws + WS_YG);
    float* E = (float*)(F.ws + WS_SLOC); const float* MU = (const float*)(F.ws + WS_MU); const float* NU = (const float*)(F.ws + WS_NU);
    const int lane = F.lane, j = lane & 15, q = lane >> 4;
    for (int batch = F.vcu; batch < 512; batch += F.G) {
        const int g = batch & 31, tb = batch >> 5, tile = tb * 8 + F.wave;
        __syncthreads();
        {
            const u32x4* s0 = (const u32x4*)(F.ws + WS_WSA + (size_t)g * 65536); LAS u32x4* d0 = (LAS u32x4*)(F.lds + SSM_WS);
            for (int i = F.tid; i < 4096; i += 512) d0[i] = s0[i];
            if (OUT) {
                const u32x4* s1 = (const u32x4*)(F.ws + WS_TDA + (size_t)g * 16384); LAS u32x4* d1 = (LAS u32x4*)(F.lds + SSM_TD);
                for (int i = F.tid; i < 1024; i += 512) d1[i] = s1[i];
                const u32x4* s2 = (const u32x4*)(F.ws + WS_WOA + (size_t)g * 65536); LAS u32x4* d2 = (LAS u32x4*)(F.lds + SSM_WO);
                for (int i = F.tid; i < 4096; i += 512) d2[i] = s2[i];
            }
        }
        bf16x8 Bv[8];
        {
            const bf16_t* vb = vs + ((size_t)g * T + (size_t)tile * 256 + 16 * j + (q >> 1)) * 16 + 8 * (q & 1);
#pragma unroll
            for (int ks = 0; ks < 8; ++ks) Bv[ks] = *(const bf16x8*)(vb + ks * 32);
        }
        f32x4 hpr[4], hpi[4];
        if (OUT) {
            const int tq = tile & 31, t0 = tile - tq;
            const float nr = NU[g * 128 + lane], ni = NU[g * 128 + 64 + lane];
            float hr = 0.f, hi = 0.f;
            for (int tt = 0; tt < tq; ++tt) {
                const float er = E[((size_t)(t0 + tt) * 32 + g) * 128 + lane], ei = E[((size_t)(t0 + tt) * 32 + g) * 128 + 64 + lane];
                const float a2 = nr * hr - ni * hi + er, b2 = nr * hi + ni * hr + ei; hr = a2; hi = b2;
            }
            LAS float* sc = (LAS float*)(F.lds + SSM_SCR + F.wave * 512);
            sc[lane] = hr; sc[64 + lane] = hi;
            LDS_WAIT(); __builtin_amdgcn_wave_barrier();
#pragma unroll
            for (int nt = 0; nt < 4; ++nt) { hpr[nt] = *(const LAS f32x4*)(sc + 16 * nt + 4 * q); hpi[nt] = *(const LAS f32x4*)(sc + 64 + 16 * nt + 4 * q); }
        }
        f32x4 mr[4], mi[4];
#pragma unroll
        for (int nt = 0; nt < 4; ++nt) { mr[nt] = *(const f32x4*)(MU + g * 128 + 16 * nt + 4 * q); mi[nt] = *(const f32x4*)(MU + g * 128 + 64 + 16 * nt + 4 * q); }
        __syncthreads();
        f32x4 zr[4], zi[4];
#pragma unroll
        for (int nt = 0; nt < 4; ++nt) { zr[nt] = (f32x4){0.f, 0.f, 0.f, 0.f}; zi[nt] = (f32x4){0.f, 0.f, 0.f, 0.f}; }
#pragma unroll
        for (int nt = 0; nt < 4; ++nt)
#pragma unroll
            for (int ks = 0; ks < 8; ++ks) {
                const bf16x8 ar = *(const LAS bf16x8*)(F.lds + SSM_WS + ((nt * 8 + ks) * 64 + lane) * 16);
                const bf16x8 ai = *(const LAS bf16x8*)(F.lds + SSM_WS + (((nt + 4) * 8 + ks) * 64 + lane) * 16);
                zr[nt] = __builtin_amdgcn_mfma_f32_16x16x32_bf16(ar, Bv[ks], zr[nt], 0, 0, 0);
                zi[nt] = __builtin_amdgcn_mfma_f32_16x16x32_bf16(ai, Bv[ks], zi[nt], 0, 0, 0);
            }
        if (OUT) {
            if (j == 0) {
#pragma unroll
                for (int nt = 0; nt < 4; ++nt)
#pragma unroll
                    for (int r = 0; r < 4; ++r) { zr[nt][r] += mr[nt][r] * hpr[nt][r] - mi[nt][r] * hpi[nt][r]; zi[nt][r] += mr[nt][r] * hpi[nt][r] + mi[nt][r] * hpr[nt][r]; }
            }
        }
        ssm_scan_step<1>(zr, zi, mr, mi); ssm_scan_step<2>(zr, zi, mr, mi); ssm_scan_step<4>(zr, zi, mr, mi); ssm_scan_step<8>(zr, zi, mr, mi);
        if (!OUT) {
            if (j == 15) {
                float* e = E + ((size_t)tile * 32 + g) * 128;
#pragma unroll
                for (int nt = 0; nt < 4; ++nt) { *(f32x4*)(e + 16 * nt + 4 * q) = zr[nt]; *(f32x4*)(e + 64 + 16 * nt + 4 * q) = zi[nt]; }
            }
        } else {
            f32x4 h8[8];
#pragma unroll
            for (int nt = 0; nt < 4; ++nt)
#pragma unroll
                for (int r = 0; r < 4; ++r) { const float sr = row_shr<1>(zr[nt][r]), si = row_shr<1>(zi[nt][r]); h8[nt][r] = (j == 0) ? hpr[nt][r] : sr; h8[4 + nt][r] = (j == 0) ? hpi[nt][r] : si; }
            bf16x8 Hb[4];
#pragma unroll
            for (int s = 0; s < 4; ++s) Hb[s] = pack8(h8[2 * s], h8[2 * s + 1]);
            bf16_t* yo = yg + ((size_t)tile * 256 + 16 * j) * 512 + 16 * g + 4 * q;
#pragma unroll
            for (int i = 0; i < 16; ++i) {
                f32x4 c = (f32x4){0.f, 0.f, 0.f, 0.f};
#pragma unroll
                for (int ks = 0; ks <= i / 2; ++ks) c = __builtin_amdgcn_mfma_f32_16x16x32_bf16(*(const LAS bf16x8*)(F.lds + SSM_TD + ((i - 2 * ks) * 64 + lane) * 16), Bv[ks], c, 0, 0, 0);
#pragma unroll
                for (int s = 0; s < 4; ++s) c = __builtin_amdgcn_mfma_f32_16x16x32_bf16(*(const LAS bf16x8*)(F.lds + SSM_WO + ((i * 4 + s) * 64 + lane) * 16), Hb[s], c, 0, 0, 0);
                u32x2 w; w.x = pk2(gelu_tanh(c[0]), gelu_tanh(c[1])); w.y = pk2(gelu_tanh(c[2]), gelu_tanh(c[3]));
                *(u32x2*)(yo + (size_t)i * 512) = w;
            }
        }
    }
    __syncthreads();
}

template <class RM>
DI void tr_item(const float* W, int K, int ld, int nblk, bf16_t* WT, const float* kscale, RM rm, LAS float* scr, int item, int lane) {
    const int kb = item / nblk, nb = item % nblk, k0 = 64 * kb, n0 = 32 * nb;
#pragma unroll 8
    for (int i = 0; i < 32; ++i) { const int kk = 2 * i + (lane >> 5); const float s = kscale ? kscale[k0 + kk] : 1.f; scr[kk * 33 + (lane & 31)] = W[(size_t)(k0 + kk) * ld + n0 + (lane & 31)] * s; }
    LDS_WAIT(); asm volatile("" ::: "memory");
    const int c = lane & 7;
#pragma unroll
    for (int j = 0; j < 4; ++j) { const int n = (lane >> 3) + 8 * j; const LAS float* s = scr + (8 * c) * 33 + n;
        u32x4 o; o.x = pk2(s[0 * 33], s[1 * 33]); o.y = pk2(s[2 * 33], s[3 * 33]); o.z = pk2(s[4 * 33], s[5 * 33]); o.w = pk2(s[6 * 33], s[7 * 33]);
        *(u32x4*)(WT + (size_t)rm(n0 + n) * K + k0 + 8 * c) = o; }
    LDS_WAIT(); asm volatile("" ::: "memory");
}
struct RmId { int off; DI int operator()(int n) const { return off + n; } };
struct RmIl { int off; DI int operator()(int n) const { return 8 * (n >> 2) + (n & 3) + off; } };
DI void rms_row_to_bf16(const float* xrow, bf16_t* orow, int lane) {
    const f32x4* xr = (const f32x4*)xrow + lane;
    f32x4 v[4]; float s = 0.f;
#pragma unroll
    for (int j = 0; j < 4; ++j) { v[j] = xr[64 * j]; s += (v[j].x * v[j].x + v[j].y * v[j].y) + (v[j].z * v[j].z + v[j].w * v[j].w); }
    const float r = 1.f / sqrtf(wave_sum(s) * (1.f / 1024.f) + EPS);
    u32x2* o8 = (u32x2*)orow + lane;
#pragma unroll
    for (int j = 0; j < 4; ++j) { u32x2 w; w.x = pk2(v[j].x * r, v[j].y * r); w.y = pk2(v[j].z * r, v[j].w * r); o8[64 * j] = w; }
}
DI void p0_prologue(const Args& a, Frame& F) {
    unsigned char* ws = F.ws;
    LAS float* scr = (LAS float*)(F.lds + RING_OFF + F.wave * 16384);
    const int gw = F.vcu * NWAVES + F.wave, NGW = F.G * NWAVES, lane = F.lane;
    constexpr int I0 = 16 * 80;
    constexpr int I1 = I0 + 8 * 16;
    constexpr int I2 = I1 + 8 * 32;
    constexpr int I3 = I2 + 8 * 32;
    constexpr int I4 = I3 + 16 * 32;
    constexpr int I5 = I4 + 16 * 32;
    constexpr int I6 = I5 + 16 * 64;
    constexpr int I7 = I6 + 16 * 32;
    constexpr int I8 = I7 + 16 * 256;
    constexpr int I9 = I8 + 16 * 256;
    constexpr int I10 = I9 + 16 * 256;
    for (int it = gw; it < I10; it += NGW) {
        if (it < I0) tr_item(a.in[I_WIN] + 512, 1024, 3072, 80, (bf16_t*)(ws + WS_W1T), a.in[I_NMIX], RmId{512}, scr, it, lane);
        else if (it < I1) tr_item(a.in[I_GLUW], 512, 512, 16, (bf16_t*)(ws + WS_WGLU), nullptr, RmId{0}, scr, it - I0, lane);
        else if (it < I2) tr_item(a.in[I_BRP], 512, 1024, 32, (bf16_t*)(ws + WS_WBRP), nullptr, RmId{0}, scr, it - I1, lane);
        else if (it < I3) tr_item(a.in[I_BRS], 512, 1024, 32, (bf16_t*)(ws + WS_WBRS), nullptr, RmId{0}, scr, it - I2, lane);
        else if (it < I4) tr_item(a.in[I_WOUT], 1024, 1024, 32, (bf16_t*)(ws + WS_WOUT), nullptr, RmId{0}, scr, it - I3, lane);
        else if (it < I5) tr_item(a.in[I_WQ], 1024, 1024, 32, (bf16_t*)(ws + WS_WQ), a.in[I_NX], RmId{0}, scr, it - I4, lane);
        else if (it < I6) tr_item(a.in[I_WKV], 1024, 2048, 64, (bf16_t*)(ws + WS_WKV), a.in[I_NMEM], RmId{0}, scr, it - I5, lane);
        else if (it < I7) tr_item(a.in[I_WO], 1024, 1024, 32, (bf16_t*)(ws + WS_WO), nullptr, RmId{0}, scr, it - I6, lane);
        else if (it < I8) { const int r = it - I7, e = r >> 8; tr_item(a.in[I_W1] + (size_t)e * 1024 * 512, 1024, 512, 16, (bf16_t*)(ws + WS_W13) + (size_t)e * 1024 * 1024, a.in[I_NFFN], RmIl{0}, scr, r & 255, lane); }
        else if (it < I9) { const int r = it - I8, e = r >> 8; tr_item(a.in[I_W3] + (size_t)e * 1024 * 512, 1024, 512, 16, (bf16_t*)(ws + WS_W13) + (size_t)e * 1024 * 1024, a.in[I_NFFN], RmIl{4}, scr, r & 255, lane); }
        else { const int r = it - I9, e = r >> 8; tr_item(a.in[I_W2] + (size_t)e * 512 * 1024, 512, 1024, 32, (bf16_t*)(ws + WS_W2T) + (size_t)e * 1024 * 512, nullptr, RmId{0}, scr, r & 255, lane); }
    }
    {
        const float* win = a.in[I_WIN]; const float* pw = a.in[I_POOLW]; const float* ps = a.in[I_POOLS]; const float* nm = a.in[I_NMIX];
        bf16_t* w1t = (bf16_t*)(ws + WS_W1T);
        for (int it = F.vcu * 512 + F.tid; it < 512 * 128; it += F.G * 512) {
            const int n = it & 511, kb = it >> 9, g = n >> 7, d = n & 127, k0 = kb * 8;
            float acc[8];
#pragma unroll
            for (int j = 0; j < 8; ++j) acc[j] = 0.f;
            for (int c = 0; c < 128; ++c) {
                const float p = pw[(size_t)(g * 128 + c) * 128 + d];
#pragma unroll
                for (int j = 0; j < 8; ++j) acc[j] += win[(size_t)(k0 + j) * 3072 + g * 128 + c] * p;
            }
            const float sc = ps[n];
            u32x4 o;
            o.x = pk2(acc[0] * sc * nm[k0 + 0], acc[1] * sc * nm[k0 + 1]); o.y = pk2(acc[2] * sc * nm[k0 + 2], acc[3] * sc * nm[k0 + 3]);
            o.z = pk2(acc[4] * sc * nm[k0 + 4], acc[5] * sc * nm[k0 + 5]); o.w = pk2(acc[6] * sc * nm[k0 + 6], acc[7] * sc * nm[k0 + 7]);
            *(u32x4*)(w1t + (size_t)n * 1024 + k0) = o;
        }
    }
    {
        float* rt = (float*)(ws + WS_RT); const float* nf = a.in[I_NFFN];
        for (int it = F.vcu * 512 + F.tid; it < 20 * 1024; it += F.G * 512) {
            const int j = it >> 10, k = it & 1023;
            rt[it] = nf[k] * (j < 4 ? a.in[I_RGW][k * 4 + j] : a.in[I_REW][k * 16 + (j - 4)]);
        }
    }
    for (int m = gw; m < T; m += NGW) rms_row_to_bf16(a.in[I_X] + (size_t)m * D, (bf16_t*)(ws + WS_A) + (size_t)m * D, lane);
    for (int m = gw; m < MROWS; m += NGW) rms_row_to_bf16(a.in[I_MEM] + (size_t)m * D, (bf16_t*)(ws + WS_MEMN) + (size_t)m * D, lane);
    for (int it = F.vcu; it < 256; it += F.G) ssm_tables_item(a, F, it >> 3, it & 7);
    __syncthreads();
}

DI void p2_pool(Frame& F) {
    const bf16_t* zw = (const bf16_t*)(F.ws + WS_ZW); bf16_t* yp = (bf16_t*)(F.ws + WS_YP);
    for (int it = F.vcu * 512 + F.tid; it < T * 64; it += F.G * 512) {
        const int t = it >> 6, ch = (it & 63) * 8, s = t & (SEQ - 1), w = 2 << (ch >> 7), cnt = (s + 1 < w) ? s + 1 : w;
        f32x4 z0, z1; load8bf(zw + (size_t)t * 512 + ch, z0, z1);
        f32x4 s0 = z0, s1 = z1;
        for (int j = 1; j < cnt; ++j) { f32x4 a, b; load8bf(zw + (size_t)(t - j) * 512 + ch, a, b); s0 += a; s1 += b; }
        const float inv = 1.f / (float)cnt;
        store8bf(yp + (size_t)t * 512 + ch, s0 * inv - z0, s1 * inv - z1);
    }
}
DI void p2_ssm_naive(const Args& a, Frame& F) {
    if (F.wave != 0) return;
    const bf16_t* vs = (const bf16_t*)(F.ws + WS_VS); bf16_t* yg = (bf16_t*)(F.ws + WS_YG);
    const int n = F.lane;
    for (int item = F.vcu; item < BATCH * NSG; item += F.G) {
        const int b = item >> 5, g = item & 31;
        const float dt = expf(a.in[I_LOGDT][g]), ar = a.in[I_ARE][g * 64 + n], ai = a.in[I_AIM][g * 64 + n];
        const float mag = expf(ar * dt); float sn, cs; sincosf(ai * dt, &sn, &cs);
        const float lr = mag * cs, li = mag * sn, den = ar * ar + ai * ai, nr = lr - 1.f, ni = li;
        const float fre = (nr * ar + ni * ai) / den, fim = (ni * ar - nr * ai) / den;
        float bbr[16], bbi[16], cr[16], ci[16], dsk[16];
#pragma unroll
        for (int c = 0; c < 16; ++c) {
            const float br = a.in[I_BRE][(size_t)(g * 64 + n) * 16 + c], bi = a.in[I_BIM][(size_t)(g * 64 + n) * 16 + c];
            bbr[c] = fre * br - fim * bi; bbi[c] = fre * bi + fim * br;
            cr[c] = a.in[I_CRE][(size_t)(g * 16 + c) * 64 + n]; ci[c] = a.in[I_CIM][(size_t)(g * 16 + c) * 64 + n];
            dsk[c] = (n == 0) ? a.in[I_SD][g * 16 + c] : 0.f;
        }
        float hr = 0.f, hi = 0.f;
        const int myc = (((n >> 5) & 1) << 3) | (((n >> 4) & 1) << 2) | (((n >> 3) & 1) << 1) | ((n >> 2) & 1);
        for (int s = 0; s < SEQ; ++s) {
            const size_t t = (size_t)b * SEQ + s;
            f32x4 va, vb, vc, vd; load8bf(vs + ((size_t)g * T + t) * 16, va, vb); load8bf(vs + ((size_t)g * T + t) * 16 + 8, vc, vd);
            float v[16];
#pragma unroll
            for (int j = 0; j < 4; ++j) { v[j] = va[j]; v[4 + j] = vb[j]; v[8 + j] = vc[j]; v[12 + j] = vd[j]; }
            float ur = 0.f, ui = 0.f;
#pragma unroll
            for (int c = 0; c < 16; ++c) { ur += bbr[c] * v[c]; ui += bbi[c] * v[c]; }
            const float nhr = lr * hr - li * hi + ur, nhi = lr * hi + li * hr + ui; hr = nhr; hi = nhi;
            float p[16];
#pragma unroll
            for (int c = 0; c < 16; ++c) p[c] = cr[c] * hr - ci[c] * hi + dsk[c] * v[c];
#pragma unroll
            for (int i = 0; i < 8; ++i) { const bool up = (n & 32) != 0; const float keep = up ? p[i + 8] : p[i], send = up ? p[i] : p[i + 8]; p[i] = keep + __shfl_xor(send, 32); }
#pragma unroll
            for (int i = 0; i < 4; ++i) { const bool up = (n & 16) != 0; const float keep = up ? p[i + 4] : p[i], send = up ? p[i] : p[i + 4]; p[i] = keep + __shfl_xor(send, 16); }
#pragma unroll
            for (int i = 0; i < 2; ++i) { const bool up = (n & 8) != 0; const float keep = up ? p[i + 2] : p[i], send = up ? p[i] : p[i + 2]; p[i] = keep + __shfl_xor(send, 8); }
            { const bool up = (n & 4) != 0; const float keep = up ? p[1] : p[0], send = up ? p[0] : p[1]; p[0] = keep + __shfl_xor(send, 4); }
            float y = p[0]; y += __shfl_xor(y, 1); y += __shfl_xor(y, 2);
            if ((n & 3) == 0) yg[t * 512 + g * 16 + myc] = (bf16_t)f2bf(gelu_tanh(y));
        }
    }
}


DI void p7_attn_naive(Frame& F) {
    bf16_t* q = (bf16_t*)(F.ws + WS_Q); const bf16_t* kc = (const bf16_t*)(F.ws + WS_KC); const bf16_t* vt = (const bf16_t*)(F.ws + WS_VT);
    const float* ssq8 = (const float*)(F.ws + WS_SSQ8);
    LAS float* qs = (LAS float*)(F.lds + F.wave * 2048); LAS float* ps = qs + 256;
    const int lane = F.lane, gw = F.vcu * NWAVES + F.wave, NGW = F.G * NWAVES;
    for (int it = gw; it < T * XH; it += NGW) {
        const int t = it >> 2, h = it & 3, b = t >> 13;
        const float inv = 1.f / sqrtf(wave_sum(ssq8[(size_t)t * 128 + lane] + ssq8[(size_t)t * 128 + 64 + lane]) * (1.f / 1024.f) + EPS);
        { const u32x2 w = *(const u32x2*)(q + (size_t)t * 1024 + h * 256 + lane * 4);
          qs[lane * 4 + 0] = bf2f(w.x & 0xffffu); qs[lane * 4 + 1] = bf2f(w.x >> 16); qs[lane * 4 + 2] = bf2f(w.y & 0xffffu); qs[lane * 4 + 3] = bf2f(w.y >> 16); }
        LDS_WAIT(); __builtin_amdgcn_wave_barrier();
        float sc[4];
#pragma unroll
        for (int kk = 0; kk < 4; ++kk) {
            const bf16_t* kr = kc + (size_t)(b * 256 + kk * 64 + lane) * 1024 + h * 256; float s = 0.f;
#pragma unroll 1
            for (int d = 0; d < 256; d += 8) { f32x4 k0, k1; load8bf(kr + d, k0, k1); const f32x4 q0 = *(const LAS f32x4*)(qs + d), q1 = *(const LAS f32x4*)(qs + d + 4);
                s += (k0[0] * q0[0] + k0[1] * q0[1]) + (k0[2] * q0[2] + k0[3] * q0[3]) + (k1[0] * q1[0] + k1[1] * q1[1]) + (k1[2] * q1[2] + k1[3] * q1[3]); }
            sc[kk] = s * inv * 0.0625f;
        }
        const float m = wave_max(fmaxf(fmaxf(sc[0], sc[1]), fmaxf(sc[2], sc[3])));
        float l = 0.f;
#pragma unroll
        for (int kk = 0; kk < 4; ++kk) { const float p = __expf(sc[kk] - m); l += p; ps[kk * 64 + lane] = p; }
        l = wave_sum(l);
        LDS_WAIT(); __builtin_amdgcn_wave_barrier();
        float o[4] = {0.f, 0.f, 0.f, 0.f};
#pragma unroll
        for (int j = 0; j < 4; ++j) {
            const bf16_t* vr = vt + ((size_t)((b * 4 + h) * 256 + lane * 4 + j)) * 256;
#pragma unroll 1
            for (int k = 0; k < 256; k += 8) { f32x4 v0, v1; load8bf(vr + k, v0, v1); const f32x4 p0 = *(const LAS f32x4*)(ps + k), p1 = *(const LAS f32x4*)(ps + k + 4);
                o[j] += (v0[0] * p0[0] + v0[1] * p0[1]) + (v0[2] * p0[2] + v0[3] * p0[3]) + (v1[0] * p1[0] + v1[1] * p1[1]) + (v1[2] * p1[2] + v1[3] * p1[3]); }
        }
        const float il = 1.f / l;
        u32x2 w; w.x = pk2(o[0] * il, o[1] * il); w.y = pk2(o[2] * il, o[3] * il);
        *(u32x2*)(q + (size_t)t * 1024 + h * 256 + lane * 4) = w;
        LDS_WAIT(); __builtin_amdgcn_wave_barrier();
    }
}

DI void p9_router(const Args& a, Frame& F) {
    const float* h2 = a.out; const float* rt = (const float*)(F.ws + WS_RT);
    int* ptok = (int*)(F.ws + WS_PTOK); float* pcomb = (float*)(F.ws + WS_PCOMB); float* pscale = (float*)(F.ws + WS_PSCALE);
    LAS int* rec_e = (LAS int*)(F.lds);
    LAS float* rec_w = (LAS float*)(F.lds + 1024);
    LAS float* rec_s = (LAS float*)(F.lds + 2048);
    const int lane = F.lane;
    for (int chunk = F.vcu; chunk < T / 128; chunk += F.G) {
        __syncthreads();
        for (int i = 0; i < 16; ++i) {
            const int lt = F.wave * 16 + i, t = chunk * 128 + lt;
            const f32x4* hr = (const f32x4*)(h2 + (size_t)t * 1024) + lane;
            f32x4 v[4]; float ss = 0.f;
#pragma unroll
            for (int j = 0; j < 4; ++j) { v[j] = hr[64 * j]; ss += (v[j].x * v[j].x + v[j].y * v[j].y) + (v[j].z * v[j].z + v[j].w * v[j].w); }
            const float inv = 1.f / sqrtf(wave_sum(ss) * (1.f / 1024.f) + EPS);
            LAS float* lgs = (LAS float*)(F.lds + 4096 + F.wave * 128);
#pragma unroll 1
            for (int o = 0; o < 20; ++o) {
                const f32x4* rr = (const f32x4*)(rt + o * 1024) + lane; float s = 0.f;
#pragma unroll
                for (int j = 0; j < 4; ++j) { const f32x4 r = rr[64 * j]; s += (v[j].x * r.x + v[j].y * r.y) + (v[j].z * r.z + v[j].w * r.w); }
                s = wave_sum(s) * inv;
                if (lane == 0) lgs[o] = s;
            }
            LDS_WAIT(); __builtin_amdgcn_wave_barrier();
            if (lane == 0) {
                float lg[20];
#pragma unroll
                for (int o = 0; o < 20; ++o) lg[o] = lgs[o];
                float gl[4]; int gi = 0;
#pragma unroll
                for (int j = 0; j < 4; ++j) gl[j] = lg[j] + a.in[I_RGB][j];
                float gm = gl[0];
#pragma unroll
                for (int j = 1; j < 4; ++j) if (gl[j] > gm) { gm = gl[j]; gi = j; }
                float gs = 0.f;
#pragma unroll
                for (int j = 0; j < 4; ++j) gs += __expf(gl[j] - gm);
                const float gate = 1.f / gs;
                float el[4];
#pragma unroll
                for (int j = 0; j < 4; ++j) {
                    float x = 0.f;
#pragma unroll
                    for (int g2 = 0; g2 < 4; ++g2) x = (gi == g2) ? lg[4 + g2 * 4 + j] + a.in[I_REB][g2 * 4 + j] : x;
                    el[j] = x;
                }
                int i1 = 0; float v1 = el[0];
#pragma unroll
                for (int j = 1; j < 4; ++j) if (el[j] > v1) { v1 = el[j]; i1 = j; }
                int i2 = -1; float v2 = -3.0e38f;
#pragma unroll
                for (int j = 0; j < 4; ++j) if (j != i1 && el[j] > v2) { v2 = el[j]; i2 = j; }
                const float ex = __expf(v2 - v1), w1 = 1.f / (1.f + ex), w2 = ex * w1;
                rec_e[lt * 2 + 0] = gi * 4 + i1; rec_e[lt * 2 + 1] = gi * 4 + i2;
                rec_w[lt * 2 + 0] = w1 * gate; rec_w[lt * 2 + 1] = w2 * gate; rec_s[lt] = inv;
            }
        }
        __syncthreads();
        if (F.tid < 16) {
            const int e = F.tid; int n = 0;
            for (int p = 0; p < 256; ++p) n += (rec_e[p] == e) ? 1 : 0;
            int base = 0;
            if (n > 0) base = (int)__hip_atomic_fetch_add((unsigned*)(F.ctl + CW_CNT + 64 * e), (unsigned)n, RLX_AGENT);
            for (int p = 0; p < 256; ++p) if (rec_e[p] == e) {
                const int t = chunk * 128 + (p >> 1);
                ptok[e * T + base] = t | ((p & 1) ? (int)0x80000000 : 0); pcomb[e * T + base] = rec_w[p]; pscale[e * T + base] = rec_s[p >> 1]; ++base;
            }
        }
    }
    __syncthreads();
}
DI void moe_prefix(Frame& F) {
    volatile LAS int* tp = (volatile LAS int*)(F.lds + XTAB_OFF);
    __syncthreads();
    if (F.tid == 0) {
        int acc = 0;
        for (int e = 0; e < 16; ++e) { const int c = (int)__hip_atomic_load((unsigned*)(F.ctl + CW_CNT + 64 * e), RLX_AGENT); tp[e] = acc; tp[32 + e] = c; acc += (c + 255) >> 8; }
        tp[16] = acc;
    }
    __syncthreads();
}
DI void p12_final(const Args& a, Frame& F) {
    const bf16_t* pk0 = (const bf16_t*)(F.ws + WS_PK0); const bf16_t* pk1 = (const bf16_t*)(F.ws + WS_PK1); const float* nf = a.in[I_NFIN];
    const int lane = F.lane, gw = F.vcu * NWAVES + F.wave, NGW = F.G * NWAVES;
    for (int m = gw; m < T; m += NGW) {
        f32x4* hr = (f32x4*)(a.out + (size_t)m * 1024) + lane;
        f32x4 v[4]; float ss = 0.f;
#pragma unroll
        for (int j = 0; j < 4; ++j) {
            v[j] = hr[64 * j];
            const u32x2 p = *((const u32x2*)(pk0 + (size_t)m * 1024) + lane + 64 * j), r = *((const u32x2*)(pk1 + (size_t)m * 1024) + lane + 64 * j);
            v[j].x += bf2f(p.x & 0xffffu) + bf2f(r.x & 0xffffu); v[j].y += bf2f(p.x >> 16) + bf2f(r.x >> 16);
            v[j].z += bf2f(p.y & 0xffffu) + bf2f(r.y & 0xffffu); v[j].w += bf2f(p.y >> 16) + bf2f(r.y >> 16);
            ss += (v[j].x * v[j].x + v[j].y * v[j].y) + (v[j].z * v[j].z + v[j].w * v[j].w);
        }
        const float inv = 1.f / sqrtf(wave_sum(ss) * (1.f / 1024.f) + EPS);
#pragma unroll
        for (int j = 0; j < 4; ++j) { const f32x4 g = *((const f32x4*)nf + lane + 64 * j); hr[64 * j] = v[j] * inv * g; }
    }
}

constexpr int N_STEPS = 15;
constexpr int GEMM_STEPS = 0x35E6;
#ifndef SKIPMASK
#define SKIPMASK 0
#endif
#ifndef SSM_NAIVE
#define SSM_NAIVE 0
#endif
#ifndef MFMA_MASK
#define MFMA_MASK 0x35E6
#endif
DI bool use_mfma(int s) { return ((MFMA_MASK >> s) & 1) != 0; }
DI bool seam_after(int s) { return s != 1 && s != N_STEPS - 1; }
DI void grid_bar(CArgs* ap) {
    const Args a = phase_args(ap);
    extern __shared__ __attribute__((aligned(16))) unsigned char lds[];
    XcdBarrier b; b.bar = (unsigned*)(a.ws + WS_CTL) + CW_BAR; b.x = xb_xcc_id(); b.st = (volatile LAS unsigned*)((LAS unsigned char*)lds + MISC_OFF) + 8;
    xcd_barrier(b);
}
DI void gemm_step(int s, const Args& a, Frame& F, pg8::Gemm& g, pg8::USched& S, UEpi& E) {
    unsigned char* ws = a.ws;
    const volatile LAS int* tp = (const volatile LAS int*)(F.lds + XTAB_OFF);
    size_t oA = WS_A, oB = WS_W1T, oA2 = 0, oB2 = 0, bstride = 0; int K = 1024, M = T, N = 1024, mode = 0, id = E_PROJ;
    if (s == 1)       { N = INW; }
    else if (s == 2)  { oA = WS_MEMN; oB = WS_WKV; M = MROWS; N = 2048; id = E_KV; }
    else if (s == 5)  { oA = WS_YG; oB = WS_WGLU; K = 512; N = 512; id = E_GLU; }
    else if (s == 6)  { oA = WS_YP; oB = WS_WBRP; oA2 = WS_YS2; oB2 = WS_WBRS; K = 512; mode = 1; id = use_mfma(6) ? E_BR : E_BRN; }
    else if (s == 7)  { oA = WS_MG; oB = WS_WOUT; id = E_WOUT; }
    else if (s == 8)  { oB = WS_WQ; id = E_Q; }
    else if (s == 10) { oA = WS_Q; oB = WS_WO; id = E_WO; }
    else if (s == 12) { oB = WS_W13; bstride = (size_t)1024 * 1024; mode = 2; id = E_UP; }
    else              { oA = WS_HID; oB = WS_W2T; K = 512; bstride = (size_t)1024 * 512; mode = 3; id = E_DOWN; }
    g.A = (const bf16_t*)(ws + oA); g.Bt = (const bf16_t*)(ws + oB); g.K = K; g.A2 = (const bf16_t*)(ws + oA2); g.Bt2 = (const bf16_t*)(ws + oB2); g.bstride = bstride;
    S.mode = mode; S.tp = tp; S.ptok = (const int*)(ws + WS_PTOK); S.nN = 4;
    S.so.init(M, N, F.G, F.bid);
    E.id = id; E.tp = tp; E.ws = ws; E.x = a.in[I_X]; E.out = a.out; E.glub = a.in[I_GLUB];
}
DI bool is_gemm_step(int s) { return ((GEMM_STEPS >> s) & 1) != 0; }

__global__ void __launch_bounds__(NWAVES * 64, 2) mk_fwd(Args args) {
    extern __shared__ __attribute__((aligned(16))) unsigned char lds[];
    CArgs* ap = (CArgs*)__builtin_amdgcn_kernarg_segment_ptr();
    const int lo = args.ph_lo, hi = args.ph_hi;
    {
        LAS unsigned char* l = (LAS unsigned char*)lds;
        for (int u = threadIdx.x; u < (LDS_BYTES - LDSCTL_OFF) / 4; u += NWAVES * 64) ((LAS unsigned*)(l + LDSCTL_OFF))[u] = 0u;
        __syncthreads();
        if (!MK_PER_PHASE) (void)xcd_barrier_post((unsigned*)(args.ws + WS_CTL) + CW_BAR, (volatile LAS unsigned*)(l + MISC_OFF) + 8);
    }
    for (int s = lo; s < hi; ++s) {
        {
            const Args a = phase_args(ap); Frame F = make_frame(a);
            if (is_gemm_step(s)) {
                if (s >= 12) moe_prefix(F);
                pg8::Gemm g; pg8::USched S; UEpi E;
                gemm_step(s, a, F, g, S, E);
                if (use_mfma(s)) {
                    unsigned char* ws = a.ws; const volatile LAS int* tp = E.tp; LAS unsigned char* ring = F.lds + RING_OFF;
                    switch (s) {
                    case 1:  if constexpr (MFMA_MASK & (1 << 1))  pg8::gemm_phase<false>(ring, g, S, FProj{(bf16_t*)(ws + WS_ZW), (bf16_t*)(ws + WS_VS), (bf16_t*)(ws + WS_G)}, F.tid); break;
                    case 2:  if constexpr (MFMA_MASK & (1 << 2))  pg8::gemm_phase<false>(ring, g, S, FKV{(bf16_t*)(ws + WS_KC), (bf16_t*)(ws + WS_VT)}, F.tid); break;
                    case 5:  if constexpr (MFMA_MASK & (1 << 5))  pg8::gemm_phase<false>(ring, g, S, FGlu{(const bf16_t*)(ws + WS_YG), a.in[I_GLUB], (bf16_t*)(ws + WS_YS2)}, F.tid); break;
                    case 6:  if constexpr (MFMA_MASK & (1 << 6))  pg8::gemm_phase<false>(ring, g, S, FBr{(const bf16_t*)(ws + WS_G), (bf16_t*)(ws + WS_MG)}, F.tid); break;
                    case 7:  if constexpr (MFMA_MASK & (1 << 7))  pg8::gemm_phase<false>(ring, g, S, FWout{a.in[I_X], a.out, (bf16_t*)(ws + WS_A), (float*)(ws + WS_SSQ8)}, F.tid); break;
                    case 8:  if constexpr (MFMA_MASK & (1 << 8))  pg8::gemm_phase<false>(ring, g, S, FStoreBf{(bf16_t*)(ws + WS_Q)}, F.tid); break;
                    case 10: if constexpr (MFMA_MASK & (1 << 10)) pg8::gemm_phase<false>(ring, g, S, FWo{a.out, (bf16_t*)(ws + WS_A)}, F.tid); break;
                    case 12: if constexpr (MFMA_MASK & (1 << 12)) pg8::gemm_phase<true>(ring, g, S, FUp{tp, (const float*)(ws + WS_PSCALE), (bf16_t*)(ws + WS_HID)}, F.tid); break;
                    default: if constexpr (MFMA_MASK & (1 << 13)) pg8::gemm_phase<false>(ring, g, S, FDown{tp, (const int*)(ws + WS_PTOK), (const float*)(ws + WS_PCOMB), (bf16_t*)(ws + WS_PK0), (bf16_t*)(ws + WS_PK1)}, F.tid); break;
                    }
                } else { if constexpr ((MFMA_MASK & GEMM_STEPS) != GEMM_STEPS) pg8::ngemm_phase(F.lds + RING_OFF, g, S, E, F.tid); }
            } else if (s == 0) p0_prologue(a, F);
            else if (s == 3) { p2_pool(F); if constexpr (SSM_NAIVE) p2_ssm_naive(a, F); else ssm_pass<false>(F); }
            else if (s == 4) { if constexpr (!SSM_NAIVE) ssm_pass<true>(F); }
            else if (s == 9) p7_attn_naive(F);
            else if (s == 11) p9_router(a, F);
            else p12_final(a, F);
        }
        if (!MK_PER_PHASE && s + 1 < hi && seam_after(s)) grid_bar(ap);
    }
}

extern "C" void kernel_launch(void* const* d_in, const int* in_sizes, int n_in, void* d_out, int out_size, void* d_ws, size_t ws_size, hipStream_t stream) {
    static int grid = 0;
    if (grid == 0) {
        if (n_in != 33 || in_sizes[0] != T * D || out_size != T * D || ws_size < WS_END) {
            fprintf(stderr, "kernel_launch: shape/workspace mismatch (n_in %d, in0 %d, out %d, ws %zu, need %zu); nothing launched\n", n_in, n_in > 0 ? in_sizes[0] : -1, out_size, ws_size, (size_t)WS_END); grid = -1; return; }
        int dev = 0, cus = 0, per_cu = 0;
        if (hipGetDevice(&dev) != hipSuccess || hipDeviceGetAttribute(&cus, hipDeviceAttributeMultiprocessorCount, dev) != hipSuccess) { fprintf(stderr, "kernel_launch: device query failed\n"); grid = -1; return; }
        if (hipFuncSetAttribute((const void*)mk_fwd, hipFuncAttributeMaxDynamicSharedMemorySize, LDS_BYTES) != hipSuccess) { fprintf(stderr, "kernel_launch: hipFuncSetAttribute failed\n"); grid = -1; return; }
        if (hipOccupancyMaxActiveBlocksPerMultiprocessor(&per_cu, (const void*)mk_fwd, NWAVES * 64, LDS_BYTES) != hipSuccess || per_cu < 1) {
            fprintf(stderr, "kernel_launch: occupancy query reports %d workgroups per CU; nothing launched\n", per_cu); (void)hipGetLastError(); grid = -1; return; }
        grid = cus;
    }
    if (grid < 0) return;
    if (hipMemsetAsync((char*)d_ws + WS_CTL, 0, CTL_ZERO_BYTES, stream) != hipSuccess) { fprintf(stderr, "kernel_launch: memset failed\n"); return; }
    Args a{};
    for (int i = 0; i < 33; ++i) a.in[i] = (const float*)d_in[i];
    a.out = (float*)d_out; a.ws = (unsigned char*)d_ws;
    const int cuts[] = {0, 1, 3, 4, 5, 6, 7, 8, 9, 10, 11, 12, 13, 14, 15};
    const int nl = MK_PER_PHASE ? 14 : 1;
    for (int li = 0; li < nl; ++li) {
        a.ph_lo = MK_PER_PHASE ? cuts[li] : 0; a.ph_hi = MK_PER_PHASE ? cuts[li + 1] : N_STEPS; a.li = li;
        hipLaunchKernelGGL(mk_fwd, dim3(grid), dim3(NWAVES * 64), LDS_BYTES, stream, a);
        const hipError_t le = hipPeekAtLastError();
        if (le != hipSuccess) { fprintf(stderr, "kernel_launch: launch %d failed: %s\n", li, hipGetErrorName(le)); break; }
    }
}
```

```cpp
#include <hip/hip_runtime.h>
#include <cstdio>
#include <cstdint>

#define GAS __attribute__((address_space(1)))
#define LAS __attribute__((address_space(3)))
typedef unsigned short bf16_t;
typedef float f32x4 __attribute__((ext_vector_type(4)));
typedef float f32x2 __attribute__((ext_vector_type(2)));
typedef unsigned u32x4 __attribute__((ext_vector_type(4)));
typedef unsigned u32x2 __attribute__((ext_vector_type(2)));
typedef short bf16x8 __attribute__((ext_vector_type(8)));
typedef GAS unsigned gu32;
#define RLX_AGENT __ATOMIC_RELAXED, __HIP_MEMORY_SCOPE_AGENT
#define LDS_WAIT() asm volatile("s_waitcnt lgkmcnt(0)" ::: "memory")
#define VM_WAIT() asm volatile("s_waitcnt vmcnt(0)" ::: "memory")
#define DI __device__ __forceinline__

#ifndef MK_PER_PHASE
#define MK_PER_PHASE 0
#endif

constexpr int BATCH = 4, SEQ = 8192, D = 1024, T = BATCH * SEQ;
constexpr int PW = 512, SW = 512, NSG = 32, GD = 16, NS = 64, INW = 3072;
constexpr int MEM = 256, XH = 4, XHD = 256, MROWS = BATCH * MEM;
constexpr int NE = 16, DE = 512;
constexpr float EPS = 1e-6f;
constexpr int NWAVES = 8;

constexpr size_t MiB = 1u << 20;
constexpr size_t WS_CTL = 0, CTL_ZERO_BYTES = 1 * MiB;
constexpr size_t WS_W1T = 1 * MiB;
constexpr size_t WS_WGLU = 7 * MiB;
constexpr size_t WS_WBRP = WS_WGLU + MiB / 2;
constexpr size_t WS_WBRS = WS_WBRP + MiB;
constexpr size_t WS_WOUT = WS_WBRS + MiB;
constexpr size_t WS_WQ = WS_WOUT + 2 * MiB;
constexpr size_t WS_WKV = WS_WQ + 2 * MiB;
constexpr size_t WS_WO = WS_WKV + 4 * MiB;
constexpr size_t WS_W13 = 20 * MiB;
constexpr size_t WS_W2T = 52 * MiB;
constexpr size_t WS_MEMN = 68 * MiB;
constexpr size_t WS_KC = 70 * MiB;
constexpr size_t WS_VT = 72 * MiB;
constexpr size_t WS_SSMT = 74 * MiB;
constexpr size_t WS_WSA = WS_SSMT;
constexpr size_t WS_TDA = WS_SSMT + 2 * MiB;
constexpr size_t WS_WOA = WS_TDA + MiB / 2;
constexpr size_t WS_MU = WS_WOA + 2 * MiB;
constexpr size_t WS_NU = WS_MU + 16384;
constexpr size_t WS_RT = 84 * MiB;
constexpr size_t WS_SSQ8 = 85 * MiB;
constexpr size_t WS_PTOK = 101 * MiB;
constexpr size_t WS_PCOMB = 103 * MiB;
constexpr size_t WS_PSCALE = 105 * MiB;
constexpr size_t WS_SLOC = 107 * MiB;
constexpr size_t WS_VRM = 109 * MiB;
constexpr size_t WS_A = 112 * MiB;
constexpr size_t WS_ZW = 176 * MiB;
constexpr size_t WS_VS = 208 * MiB;
constexpr size_t WS_MG = 176 * MiB;
constexpr size_t WS_Q = 176 * MiB;
constexpr size_t WS_G = 240 * MiB;
constexpr size_t WS_PK0 = 240 * MiB, WS_PK1 = 304 * MiB;
constexpr size_t WS_YP = 368 * MiB, WS_YG = 400 * MiB, WS_YS2 = 432 * MiB;
constexpr size_t WS_HID = 368 * MiB;
constexpr size_t WS_END = 464 * MiB;
constexpr int CW_TMO = 0, CW_CODE = 1;
constexpr int CW_BAR = 4096;
constexpr int CW_CNT = 16384;

constexpr int RING_OFF = 0, RING_BYTES = 131072;
constexpr int LDS_BYTES = 163840;
constexpr int LDSCTL_OFF = LDS_BYTES - 2048, MISC_OFF = LDSCTL_OFF + 320;
constexpr int XTAB_OFF = LDSCTL_OFF + 512;
constexpr int SSM_WS = 0, SSM_TD = 65536, SSM_WO = 81920, SSM_SCR = 147456;

DI float bf2f(unsigned b) { return __uint_as_float(b << 16); }
DI unsigned f2bf(float f) { unsigned u = __float_as_uint(f); return (u + 0x7fffu + ((u >> 16) & 1u)) >> 16; }
DI unsigned pk2(float lo, float hi) { return f2bf(lo) | (f2bf(hi) << 16); }
DI float sigm(float x) { return 1.f / (1.f + __expf(-x)); }
DI float gelu_tanh(float x) { return x * sigm(1.5957691216057308f * (x + 0.044715f * x * x * x)); }
DI int lane_id() { int l; asm volatile("v_mbcnt_lo_u32_b32 %0, -1, 0\n\tv_mbcnt_hi_u32_b32 %0, -1, %0" : "=&v"(l)); return l; }
DI float wave_sum(float v) {
#pragma unroll
    for (int o = 1; o < 64; o <<= 1) v += __shfl_xor(v, o);
    return v;
}
DI float wave_max(float v) {
#pragma unroll
    for (int o = 1; o < 64; o <<= 1) v = fmaxf(v, __shfl_xor(v, o));
    return v;
}
DI void store8bf(bf16_t* p, const f32x4& a, const f32x4& b) {
    u32x4 w; w.x = pk2(a[0], a[1]); w.y = pk2(a[2], a[3]); w.z = pk2(b[0], b[1]); w.w = pk2(b[2], b[3]);
    *(u32x4*)p = w;
}
DI void load8bf(const bf16_t* p, f32x4& a, f32x4& b) {
    const u32x4 w = *(const u32x4*)p;
    a[0] = bf2f(w.x & 0xffffu); a[1] = bf2f(w.x >> 16); a[2] = bf2f(w.y & 0xffffu); a[3] = bf2f(w.y >> 16);
    b[0] = bf2f(w.z & 0xffffu); b[1] = bf2f(w.z >> 16); b[2] = bf2f(w.w & 0xffffu); b[3] = bf2f(w.w >> 16);
}

#define XB_TMO      128
#define XB_XCNT(j)  (256  + 64 * (j))
#define XB_XSUB(j)  (1280 + 64 * (j))
#define XB_XGEN(j)  (2304 + 64 * (j))
#define XB_TOP      3328
#define XB_TOPGEN   3392
#define XCD_BAR_WORDS 3456
#define XB_SPIN_CAP (1u << 18)
DI unsigned xb_ld(unsigned* p)              { return __hip_atomic_load(p, __ATOMIC_RELAXED, __HIP_MEMORY_SCOPE_AGENT); }
DI unsigned xb_add(unsigned* p, unsigned v) { return __hip_atomic_fetch_add(p, v, __ATOMIC_RELAXED, __HIP_MEMORY_SCOPE_AGENT); }
DI unsigned xb_xcc_id() { return (unsigned)__builtin_amdgcn_s_getreg((3 << 11) | 20) & 0xFu; }
#define XB_SPIN(cond, bar) do { unsigned _sp = 0; while (cond) { __builtin_amdgcn_s_sleep(1); \
    if ((++_sp & 255u) == 0u) { if (xb_ld(&(bar)[XB_TMO])) break; if (_sp > XB_SPIN_CAP) { atomicAdd(&(bar)[XB_TMO], 1u); break; } } } } while (0)
struct XcdBarrier { unsigned* bar; unsigned x; volatile LAS unsigned* st; };
DI XcdBarrier xcd_barrier_post(unsigned* bar, volatile LAS unsigned* st, bool t0) {
    XcdBarrier b; b.bar = bar; b.x = xb_xcc_id(); b.st = st;
    if (t0) (void)xb_add(&bar[XB_XCNT(b.x)], 1u);
    return b;
}
DI void xcd_barrier_complete(unsigned* bar, unsigned x, unsigned& nloc, unsigned& nx) {
    const unsigned G = gridDim.x * gridDim.y * gridDim.z;
    unsigned sum, cnt, mine, sp = 0u;
    for (;;) {
        sum = 0u; cnt = 0u; mine = 0u;
#pragma unroll
        for (unsigned j = 0; j < 16; ++j) { const unsigned c = xb_ld(&bar[XB_XCNT(j)]); sum += c; cnt += (c > 0u) ? 1u : 0u; mine = (j == x) ? c : mine; }
        if (sum == G) break;
        __builtin_amdgcn_s_sleep(1);
        if ((++sp & 255u) == 0u) { if (xb_ld(&bar[XB_TMO])) break; if (sp > XB_SPIN_CAP) { atomicAdd(&bar[XB_TMO], 1u); break; } }
    }
    nloc = mine > 0u ? mine : 1u; nx = cnt > 0u ? cnt : 1u;
}
DI void xcd_barrier(const XcdBarrier& b, bool t0) {
    asm volatile("s_waitcnt vmcnt(0)" ::: "memory");
    __syncthreads();
    if (t0) {
        unsigned* bar = b.bar;
        __builtin_amdgcn_s_waitcnt(0);
        unsigned nloc = b.st[0], nx = b.st[1];
        if (nloc == 0u) { xcd_barrier_complete(bar, b.x, nloc, nx); b.st[0] = nloc; b.st[1] = nx; }
        const unsigned old = xb_add(&bar[XB_XSUB(b.x)], 1u);
        const unsigned gen = old / nloc;
        if (old + 1u == (gen + 1u) * nloc) {
            __builtin_amdgcn_fence(__ATOMIC_RELEASE, "agent");
            asm volatile("s_waitcnt vmcnt(0)" ::: "memory");
            const unsigned og = xb_add(&bar[XB_TOP], 1u);
            const unsigned tg = og / nx;
            if (og + 1u == (tg + 1u) * nx) xb_add(&bar[XB_TOPGEN], 1u);
            else XB_SPIN(xb_ld(&bar[XB_TOPGEN]) == tg, bar);
            __builtin_amdgcn_fence(__ATOMIC_ACQUIRE, "agent");
            xb_add(&bar[XB_XGEN(b.x)], 1u);
            asm volatile("s_waitcnt vmcnt(0)" ::: "memory");
        } else {
            XB_SPIN(xb_ld(&bar[XB_XGEN(b.x)]) == gen, bar);
            __builtin_amdgcn_fence(__ATOMIC_ACQUIRE, "agent");
            asm volatile("s_waitcnt vmcnt(0)" ::: "memory");
        }
    }
    __syncthreads();
}

namespace pg8 {
constexpr int BM = 256, BK = 64, HALF = 128, NXCD = 8, WGM = 8;
struct Unit { int pm, pn, e; };
struct Gemm { const bf16_t* A; const bf16_t* Bt; int K; const bf16_t* A2; const bf16_t* Bt2; size_t bstride; };

struct StaticOrder {
    int nM, nN, nwg, G, c;
    DI void init(int M, int N, int G_, int c_) { nM = M / BM; nN = N / BM; nwg = nM * nN; G = G_; c = c_; }
    DI bool tile(int L, Unit& u) const {
        if (L >= nwg) return false;
        int wgid = L; { const int q = nwg / NXCD, r = nwg % NXCD, xcd = wgid % NXCD, off = wgid / NXCD; wgid = (xcd < r ? xcd * (q + 1) : r * (q + 1) + (xcd - r) * q) + off; }
        const int nig = WGM * nN, gid = wgid / nig, fm = gid * WGM, gsz = (nM - fm) < WGM ? (nM - fm) : WGM;
        u.pm = fm + ((wgid % nig) % gsz); u.pn = (wgid % nig) / gsz; u.e = 0; return true;
    }
    DI bool next(int i, Unit& u) const { return tile(i * G + c, u); }
    DI const bf16_t* a_base(const Gemm& g, const Unit&) const { return g.A; }
    DI const bf16_t* a_row(const Gemm& g, const Unit& u, int r) const { return g.A + (size_t)(u.pm * BM + r) * g.K; }
    DI const bf16_t* b_row(const Gemm& g, const Unit& u, int n) const { return g.Bt + (size_t)(u.pn * BM + n) * g.K; }
};
struct USched {
    int mode; StaticOrder so; const volatile LAS int* tp; const int* ptok; int nN;
    DI bool next(int i, Unit& u) const {
        if (mode == 0) return so.tile(i * so.G + so.c, u);
        if (mode == 1) { if (!so.tile((i >> 1) * so.G + so.c, u)) return false; u.e = i & 1; return true; }
        const int L = i * so.G + so.c, total = tp[16] * nN; if (L >= total) return false;
        const int mt = L / nN; int e = 0;
#pragma unroll
        for (int j = 1; j < 16; ++j) e += (mt >= tp[j]) ? 1 : 0;
        u.pm = __builtin_amdgcn_readfirstlane(mt); u.pn = __builtin_amdgcn_readfirstlane(L % nN); u.e = __builtin_amdgcn_readfirstlane(e); return true;
    }
    DI const bf16_t* a_base(const Gemm& g, const Unit& u) const { return (mode == 1 && u.e) ? g.A2 : g.A; }
    DI const bf16_t* a_row(const Gemm& g, const Unit& u, int r) const {
        if (mode == 2) {
            const int slot = (u.pm - tp[u.e]) * BM + r; const int cnt = tp[32 + u.e];
            const int tok = slot < cnt ? (ptok[u.e * T + slot] & 0x7fffffff) : 0;
            return g.A + (size_t)tok * g.K;
        }
        return a_base(g, u) + (size_t)(u.pm * BM + r) * g.K;
    }
    DI const bf16_t* b_row(const Gemm& g, const Unit& u, int n) const {
        const bf16_t* b = (mode == 1 && u.e) ? g.Bt2 : g.Bt;
        if (mode >= 2) b += (size_t)u.e * g.bstride;
        return b + (size_t)(u.pn * BM + n) * g.K;
    }
};


template <class Epi, class Sched>
DI void ngemm_phase(LAS unsigned char* lds, const Gemm g, const Sched& S, const Epi& E, const int tid) {
    LAS float* As = (LAS float*)lds;
    LAS float* Bs = As + 16 * 132;
    const int lr = tid >> 2, kq = tid & 3, tx = tid & 15, ty = tid >> 4;
    Unit u;
    for (int i = 0; S.next(i, u); ++i) {
        for (int sub = 0; sub < 4; ++sub) {
            const int sm = (sub >> 1) * 128, sn = (sub & 1) * 128;
            float acc[4][8];
#pragma unroll
            for (int r = 0; r < 4; ++r)
#pragma unroll
                for (int c = 0; c < 8; ++c) acc[r][c] = 0.f;
            const bf16_t* arow = S.a_row(g, u, sm + lr) + kq * 4;
            const bf16_t* brow = S.b_row(g, u, sn + lr) + kq * 4;
            for (int k0 = 0; k0 < g.K; k0 += 16) {
                __syncthreads();
                const u32x2 av = *(const u32x2*)(arow + k0), bv = *(const u32x2*)(brow + k0);
                As[(kq * 4 + 0) * 132 + lr] = bf2f(av.x & 0xffffu); As[(kq * 4 + 1) * 132 + lr] = bf2f(av.x >> 16);
                As[(kq * 4 + 2) * 132 + lr] = bf2f(av.y & 0xffffu); As[(kq * 4 + 3) * 132 + lr] = bf2f(av.y >> 16);
                Bs[(kq * 4 + 0) * 132 + lr] = bf2f(bv.x & 0xffffu); Bs[(kq * 4 + 1) * 132 + lr] = bf2f(bv.x >> 16);
                Bs[(kq * 4 + 2) * 132 + lr] = bf2f(bv.y & 0xffffu); Bs[(kq * 4 + 3) * 132 + lr] = bf2f(bv.y >> 16);
                __syncthreads();
#pragma unroll
                for (int k = 0; k < 16; ++k) {
                    const f32x4 a4 = *(const LAS f32x4*)(As + k * 132 + ty * 4);
                    const f32x4 b0 = *(const LAS f32x4*)(Bs + k * 132 + tx * 8), b1 = *(const LAS f32x4*)(Bs + k * 132 + tx * 8 + 4);
#pragma unroll
                    for (int r = 0; r < 4; ++r) {
#pragma unroll
                        for (int c = 0; c < 4; ++c) { acc[r][c] += a4[r] * b0[c]; acc[r][4 + c] += a4[r] * b1[c]; }
                    }
                }
            }
#pragma unroll
            for (int r = 0; r < 4; ++r) {
                f32x4 v0 = {acc[r][0], acc[r][1], acc[r][2], acc[r][3]}, v1 = {acc[r][4], acc[r][5], acc[r][6], acc[r][7]};
                E(u, u.pm * BM + sm + ty * 4 + r, u.pn * BM + sn + tx * 8, v0, v1);
            }
        }
    }
    __syncthreads();
}

template <class F> DI void epi_drive(const F& f, const Unit& u, f32x4 (&acc)[2][2][4][2], int wr, int wc, int fr, int fq) {
#pragma unroll
    for (int ai = 0; ai < 2; ++ai)
#pragma unroll
        for (int m = 0; m < 4; ++m) { const int row = u.pm * 256 + ai * 128 + wr * 64 + m * 16 + fr;
#pragma unroll
            for (int bj = 0; bj < 2; ++bj) f(u, row, u.pn * 256 + bj * 128 + wc * 32 + 8 * fq, acc[ai][bj][m][0], acc[ai][bj][m][1]);
            asm volatile("" ::: "memory"); }
}
DI int lds_byte(int r, int c) { const int st = (r >> 4) * 2 + (c >> 5), rr = r & 15, cc = c & 31, ob = rr * 64 + cc * 2; return st * 1024 + (ob ^ (((ob >> 9) & 1) << 5)); }
DI void stage_rc(int b, int& R, int& C) { const int st = b / 1024, sb = b % 1024, swz = sb ^ (((sb >> 9) & 1) << 5); R = (st >> 1) * 16 + swz / 64; C = (st & 1) * 32 + (swz % 64) / 2; }
DI int perm32(int rho) { const int n = rho >> 4, i = rho & 15; return 8 * (i >> 2) + 4 * n + (i & 3); }
constexpr int HTB = HALF * BK * 2;
template <bool GATHER, class F, class Sched>
DI void gemm_phase(LAS unsigned char* lds, const Gemm g, const Sched& S, const F& E, const int tid) {
    const int wid = __builtin_amdgcn_readfirstlane(tid >> 6), lane = tid & 63, wr = wid >> 2, wc = wid & 3, fr = lane & 15, fq = lane >> 4;
    const int K = g.K, nt = K / BK;
    int Rr[2], Cc[2]; unsigned voffB[2];
#pragma unroll
    for (int i = 0; i < 2; ++i) { int R, C; stage_rc(tid * 16 + i * 8192, R, C); Rr[i] = R; Cc[i] = C; const int Rb = (R & ~31) + perm32(R & 31); voffB[i] = (unsigned)(Rb * K + C) * 2u; }
    const size_t kstep = (size_t)(BK * 2);
    const size_t hstep = (size_t)HALF * K * 2;
    const unsigned ldsw = (unsigned)wid * 1024u;
    const int aoff = lds_byte(wr * 64 + fr, fq * 8), boff = lds_byte(wc * 32 + fr, fq * 8);
#define PG8_SA(b, h) (((b) * 2 + (h)) * HTB)
#define PG8_SB(b, h) ((4 + (b) * 2 + (h)) * HTB)
#define PG8_STAGE2(bufoff, gbase, v0_, v1_) do { \
        __builtin_amdgcn_global_load_lds((const unsigned*)((const char*)(gbase) + (v0_)), (LAS unsigned*)(lds + (bufoff) + ldsw), 16, 0, 0); \
        __builtin_amdgcn_global_load_lds((const unsigned*)((const char*)(gbase) + (v1_)), (LAS unsigned*)(lds + (bufoff) + ldsw + 8192), 16, 0, 0); } while (0)
#define PG8_STAGEB(bufoff, gbase) PG8_STAGE2(bufoff, gbase, voffB[0], voffB[1])
#define PG8_LDA(dst, b, h) do { _Pragma("unroll") for (int m = 0; m < 4; ++m) _Pragma("unroll") for (int k = 0; k < 2; ++k) dst[m][k] = *(const LAS bf16x8*)(lds + PG8_SA(b, h) + aoff + m * 2048 + k * 1024); } while (0)
#define PG8_LDB(dst, b, h) do { _Pragma("unroll") for (int n = 0; n < 2; ++n) _Pragma("unroll") for (int k = 0; k < 2; ++k) dst[n][k] = *(const LAS bf16x8*)(lds + PG8_SB(b, h) + boff + n * 2048 + k * 1024); } while (0)
#define PG8_MMA(ai, bj, At, Bt) do { __builtin_amdgcn_s_setprio(1); _Pragma("unroll") for (int m = 0; m < 4; ++m) _Pragma("unroll") for (int n = 0; n < 2; ++n) _Pragma("unroll") for (int k = 0; k < 2; ++k) \
        acc[ai][bj][m][n] = __builtin_amdgcn_mfma_f32_16x16x32_bf16(Bt[n][k], At[m][k], acc[ai][bj][m][n], 0, 0, 0); __builtin_amdgcn_s_setprio(0); } while (0)
#define PG8_WAIT_V(n) asm volatile("s_waitcnt vmcnt(" #n ")" ::: "memory")
#define PG8_WAIT_L(n) asm volatile("s_waitcnt lgkmcnt(" #n ")" ::: "memory")
#define PG8_BAR __builtin_amdgcn_s_barrier()
#define PG8_SCHED __builtin_amdgcn_sched_barrier(0)
    Unit cur, nxt; int ui = 0;
    if (!S.next(0, cur)) return;
    f32x4 acc[2][2][4][2];
#pragma unroll
    for (int a = 0; a < 2; ++a)
#pragma unroll
        for (int b = 0; b < 2; ++b)
#pragma unroll
            for (int m = 0; m < 4; ++m)
#pragma unroll
                for (int n = 0; n < 2; ++n) acc[a][b][m][n] = (f32x4){0.f, 0.f, 0.f, 0.f};
    bf16x8 At[4][2], B0[2][2], B1[2][2];
    const char* cA = GATHER ? (const char*)S.a_base(g, cur) : (const char*)S.a_row(g, cur, 0); const char* cB = (const char*)S.b_row(g, cur, 0);
    unsigned vc00, vc01, vc10, vc11;
    if constexpr (GATHER) {
        vc00 = (unsigned)((const char*)S.a_row(g, cur, Rr[0]) - cA) + (unsigned)Cc[0] * 2u; vc01 = (unsigned)((const char*)S.a_row(g, cur, Rr[1]) - cA) + (unsigned)Cc[1] * 2u;
        vc10 = (unsigned)((const char*)S.a_row(g, cur, HALF + Rr[0]) - cA) + (unsigned)Cc[0] * 2u; vc11 = (unsigned)((const char*)S.a_row(g, cur, HALF + Rr[1]) - cA) + (unsigned)Cc[1] * 2u;
    } else {
        vc00 = (unsigned)(Rr[0] * K + Cc[0]) * 2u; vc01 = (unsigned)(Rr[1] * K + Cc[1]) * 2u; vc10 = vc00 + (unsigned)hstep; vc11 = vc01 + (unsigned)hstep;
    }
    PG8_STAGEB(PG8_SB(0, 0), cB); PG8_STAGEB(PG8_SB(0, 1), cB + hstep); PG8_STAGE2(PG8_SA(0, 0), cA, vc00, vc01); PG8_STAGE2(PG8_SA(0, 1), cA, vc10, vc11);
    if (wr == 1) PG8_BAR;
    PG8_WAIT_V(2); PG8_BAR;
    PG8_STAGEB(PG8_SB(1, 0), cB + kstep); PG8_STAGE2(PG8_SA(1, 0), cA + kstep, vc00, vc01); PG8_STAGEB(PG8_SB(1, 1), cB + hstep + kstep);
    PG8_WAIT_V(6); PG8_BAR;
    for (;;) {
        const bool has_next = S.next(ui + 1, nxt);
        const char* nA = cA; const char* nB = cB; unsigned vn00 = vc00, vn01 = vc01, vn10 = vc10, vn11 = vc11;
        if (has_next) {
            nB = (const char*)S.b_row(g, nxt, 0);
            if constexpr (GATHER) {
                nA = (const char*)S.a_base(g, nxt);
                vn00 = (unsigned)((const char*)S.a_row(g, nxt, Rr[0]) - nA) + (unsigned)Cc[0] * 2u; vn01 = (unsigned)((const char*)S.a_row(g, nxt, Rr[1]) - nA) + (unsigned)Cc[1] * 2u;
                vn10 = (unsigned)((const char*)S.a_row(g, nxt, HALF + Rr[0]) - nA) + (unsigned)Cc[0] * 2u; vn11 = (unsigned)((const char*)S.a_row(g, nxt, HALF + Rr[1]) - nA) + (unsigned)Cc[1] * 2u;
            } else nA = (const char*)S.a_row(g, nxt, 0);
        }
        for (int t = 0; t < nt; t += 2) {
            const bool last = (t == nt - 2);
            const char* a1 = cA + (size_t)(t + 1) * kstep;
            const char* a2 = last ? nA : cA + (size_t)(t + 2) * kstep; const char* b2 = last ? nB : cB + (size_t)(t + 2) * kstep;
            const char* a3 = a2 + kstep; const char* b3 = b2 + kstep;
            const unsigned w00 = (GATHER && last) ? vn00 : vc00, w01 = (GATHER && last) ? vn01 : vc01, w10 = (GATHER && last) ? vn10 : vc10, w11 = (GATHER && last) ? vn11 : vc11;
            PG8_LDB(B0, 0, 0); PG8_LDB(B1, 0, 1); PG8_SCHED; PG8_LDA(At, 0, 0); PG8_STAGE2(PG8_SA(1, 1), a1, vc10, vc11);
            PG8_WAIT_V(8); PG8_WAIT_L(0); PG8_BAR; PG8_MMA(0, 0, At, B0); PG8_MMA(0, 1, At, B1); PG8_BAR; PG8_SCHED;
            PG8_LDA(At, 0, 1); PG8_STAGEB(PG8_SB(0, 0), b2); PG8_STAGEB(PG8_SB(0, 1), b2 + hstep); PG8_STAGE2(PG8_SA(0, 0), a2, w00, w01);
            PG8_WAIT_V(8); PG8_WAIT_L(0); PG8_BAR; PG8_MMA(1, 0, At, B0); PG8_MMA(1, 1, At, B1); PG8_BAR; PG8_SCHED;
            PG8_LDB(B0, 1, 0); PG8_LDB(B1, 1, 1); PG8_SCHED; PG8_LDA(At, 1, 0); PG8_STAGE2(PG8_SA(0, 1), a2, w10, w11);
            PG8_WAIT_V(8); PG8_WAIT_L(0); PG8_BAR; PG8_MMA(0, 0, At, B0); PG8_MMA(0, 1, At, B1); PG8_BAR; PG8_SCHED;
            PG8_LDA(At, 1, 1); PG8_STAGEB(PG8_SB(1, 0), b3); PG8_STAGEB(PG8_SB(1, 1), b3 + hstep); PG8_STAGE2(PG8_SA(1, 0), a3, w00, w01);
            PG8_WAIT_V(8); PG8_WAIT_L(0); PG8_BAR; PG8_MMA(1, 0, At, B0); PG8_MMA(1, 1, At, B1); PG8_BAR; PG8_SCHED;
        }
        if (wr == 0) PG8_BAR;
        epi_drive(E, cur, acc, wr, wc, fr, fq);
        const bool keep = E.keep(cur);
        if (!has_next) break;
        if (!keep) {
#pragma unroll
            for (int a = 0; a < 2; ++a)
#pragma unroll
                for (int b = 0; b < 2; ++b)
#pragma unroll
                    for (int m = 0; m < 4; ++m)
#pragma unroll
                        for (int n = 0; n < 2; ++n) acc[a][b][m][n] = (f32x4){0.f, 0.f, 0.f, 0.f};
        }
        cur = nxt; cA = nA; cB = nB; vc00 = vn00; vc01 = vn01; vc10 = vn10; vc11 = vn11; ++ui;
        if (wr == 1) PG8_BAR;
    }
    PG8_WAIT_V(0);
    PG8_BAR;
#undef PG8_SA
#undef PG8_SB
#undef PG8_STAGE2
#undef PG8_STAGEB
#undef PG8_LDA
#undef PG8_LDB
#undef PG8_MMA
#undef PG8_WAIT_V
#undef PG8_WAIT_L
#undef PG8_BAR
#undef PG8_SCHED
}
}

struct FProj {
    DI bool keep(const pg8::Unit&) const { return false; }
    bf16_t* zw; bf16_t* vs; bf16_t* g;
    DI void operator()(const pg8::Unit&, int row, int col, f32x4& v0, f32x4& v1) const {
        if (col < 512) store8bf(zw + (size_t)row * 512 + col, v0, v1);
        else if (col < 1024) { const int c0 = col - 512; store8bf(vs + ((size_t)(c0 >> 4) * T + row) * 16 + (c0 & 15), v0, v1); }
        else {
            f32x4 a, b;
#pragma unroll
            for (int j = 0; j < 4; ++j) { a[j] = sigm(v0[j]); b[j] = sigm(v1[j]); }
            store8bf(g + (size_t)row * 2048 + (col - 1024), a, b);
        }
    }
};
struct FKV {
    DI bool keep(const pg8::Unit&) const { return false; }
    bf16_t* kf; bf16_t* vf;
    DI void operator()(const pg8::Unit&, int row, int col, f32x4& v0, f32x4& v1) const {
        const int b = row >> 8, key = row & 255;
        if (col < 1024) {
            const int h = col >> 8, dim = col & 255;
            store8bf(kf + ((size_t)((((b * 4 + h) * 8 + (key >> 5)) * 16 + (dim >> 4)) * 64 + ((dim >> 3) & 1) * 32 + (key & 31))) * 8, v0, v1);
        } else store8bf(vf + (size_t)row * 1024 + (col - 1024), v0, v1);
    }
};
struct FGlu {
    DI bool keep(const pg8::Unit&) const { return false; }
    const bf16_t* yg; const float* bias; bf16_t* ys2;
    DI void operator()(const pg8::Unit&, int row, int col, f32x4& v0, f32x4& v1) const {
        f32x4 y0, y1; load8bf(yg + (size_t)row * 512 + col, y0, y1);
        const f32x4 b0 = *(const f32x4*)(bias + col), b1 = *(const f32x4*)(bias + col + 4);
        f32x4 a, b;
#pragma unroll
        for (int j = 0; j < 4; ++j) { a[j] = y0[j] * sigm(v0[j] + b0[j]); b[j] = y1[j] * sigm(v1[j] + b1[j]); }
        store8bf(ys2 + (size_t)row * 512 + col, a, b);
    }
};
struct FBrNaive {
    DI bool keep(const pg8::Unit&) const { return false; }
    const bf16_t* g; float* tmp; bf16_t* mg;
    DI void operator()(const pg8::Unit& u, int row, int col, f32x4& v0, f32x4& v1) const {
        f32x4 g0, g1; load8bf(g + (size_t)row * 2048 + (u.e ? 1024 : 0) + col, g0, g1);
        float* tp = tmp + (size_t)row * 1024 + col;
        if (u.e == 0) { *(f32x4*)tp = g0 * v0; *(f32x4*)(tp + 4) = g1 * v1; }
        else { const f32x4 t0 = *(const f32x4*)tp, t1 = *(const f32x4*)(tp + 4); store8bf(mg + (size_t)row * 1024 + col, t0 + g0 * v0, t1 + g1 * v1); }
    }
};
struct FBr {
    DI bool keep(const pg8::Unit& u) const { return u.e == 0; }
    const bf16_t* g; bf16_t* mg;
    DI void operator()(const pg8::Unit& u, int row, int col, f32x4& v0, f32x4& v1) const {
        f32x4 a0, a1, b0, b1; load8bf(g + (size_t)row * 2048 + col, a0, a1); load8bf(g + (size_t)row * 2048 + 1024 + col, b0, b1);
        if (u.e == 0) {
#pragma unroll
            for (int j = 0; j < 4; ++j) { v0[j] *= a0[j] / fmaxf(b0[j], 1e-30f); v1[j] *= a1[j] / fmaxf(b1[j], 1e-30f); }
        } else store8bf(mg + (size_t)row * 1024 + col, v0 * (f32x4){fmaxf(b0[0], 1e-30f), fmaxf(b0[1], 1e-30f), fmaxf(b0[2], 1e-30f), fmaxf(b0[3], 1e-30f)},
                                                       v1 * (f32x4){fmaxf(b1[0], 1e-30f), fmaxf(b1[1], 1e-30f), fmaxf(b1[2], 1e-30f), fmaxf(b1[3], 1e-30f)});
    }
};
struct FWout {
    DI bool keep(const pg8::Unit&) const { return false; }
    const float* x; float* out; bf16_t* hb; float* ssq8;
    DI void operator()(const pg8::Unit&, int row, int col, f32x4& v0, f32x4& v1) const {
        const size_t o = (size_t)row * 1024 + col;
        const f32x4 h0 = *(const f32x4*)(x + o) + v0, h1 = *(const f32x4*)(x + o + 4) + v1;
        *(f32x4*)(out + o) = h0; *(f32x4*)(out + o + 4) = h1;
        store8bf(hb + o, h0, h1);
        ssq8[(size_t)row * 128 + (col >> 3)] = (h0[0] * h0[0] + h0[1] * h0[1]) + (h0[2] * h0[2] + h0[3] * h0[3]) + (h1[0] * h1[0] + h1[1] * h1[1]) + (h1[2] * h1[2] + h1[3] * h1[3]);
    }
};
struct FStoreBf {
    DI bool keep(const pg8::Unit&) const { return false; }
    bf16_t* o;
    DI void operator()(const pg8::Unit&, int row, int col, f32x4& v0, f32x4& v1) const { store8bf(o + (size_t)row * 1024 + col, v0, v1); }
};
struct FWo {
    DI bool keep(const pg8::Unit&) const { return false; }
    float* out; bf16_t* hb;
    DI void operator()(const pg8::Unit&, int row, int col, f32x4& v0, f32x4& v1) const {
        const size_t o = (size_t)row * 1024 + col;
        const f32x4 h0 = *(const f32x4*)(out + o) + v0, h1 = *(const f32x4*)(out + o + 4) + v1;
        *(f32x4*)(out + o) = h0; *(f32x4*)(out + o + 4) = h1;
        store8bf(hb + o, h0, h1);
    }
};
struct FUp {
    DI bool keep(const pg8::Unit&) const { return false; }
    const volatile LAS int* tp; const float* pscale; bf16_t* hid;
    DI void operator()(const pg8::Unit& u, int row, int col, f32x4& v0, f32x4& v1) const {
        const int slot = row - tp[u.e] * 256;
        if (slot < tp[32 + u.e]) {
            const float s = pscale[u.e * T + slot];
            u32x2 w; float h[4];
#pragma unroll
            for (int j = 0; j < 4; ++j) { const float a = v0[j] * s, b = v1[j] * s; h[j] = a * sigm(a) * b; }
            w.x = pk2(h[0], h[1]); w.y = pk2(h[2], h[3]);
            *(u32x2*)(hid + (size_t)row * 512 + (col >> 1)) = w;
        }
    }
};
struct FDown {
    DI bool keep(const pg8::Unit&) const { return false; }
    const volatile LAS int* tp; const int* ptok; const float* pcomb; bf16_t* pk0; bf16_t* pk1;
    DI void operator()(const pg8::Unit& u, int row, int col, f32x4& v0, f32x4& v1) const {
        const int slot = row - tp[u.e] * 256;
        if (slot < tp[32 + u.e]) {
            const int t = ptok[u.e * T + slot]; const float c = pcomb[u.e * T + slot];
            bf16_t* dst = ((t < 0) ? pk1 : pk0) + (size_t)(t & 0x7fffffff) * 1024 + col;
            store8bf(dst, v0 * c, v1 * c);
        }
    }
};

enum { E_PROJ = 0, E_KV, E_GLU, E_BR, E_WOUT, E_Q, E_WO, E_UP, E_DOWN, E_BRN };
struct UEpi {
    int id; const volatile LAS int* tp; unsigned char* ws; const float* x; float* out; const float* glub;
    DI void operator()(const pg8::Unit& u, int row, int col, f32x4& v0, f32x4& v1) const {
        switch (id) {
        case E_PROJ: FProj{(bf16_t*)(ws + WS_ZW), (bf16_t*)(ws + WS_VS), (bf16_t*)(ws + WS_G)}(u, row, col, v0, v1); break;
        case E_KV:   FKV{(bf16_t*)(ws + WS_KC), (bf16_t*)(ws + WS_VRM)}(u, row, col, v0, v1); break;
        case E_GLU:  FGlu{(const bf16_t*)(ws + WS_YG), glub, (bf16_t*)(ws + WS_YS2)}(u, row, col, v0, v1); break;
        case E_BR:   FBr{(const bf16_t*)(ws + WS_G), (bf16_t*)(ws + WS_MG)}(u, row, col, v0, v1); break;
        case E_BRN:  FBrNaive{(const bf16_t*)(ws + WS_G), out, (bf16_t*)(ws + WS_MG)}(u, row, col, v0, v1); break;
        case E_WOUT: FWout{x, out, (bf16_t*)(ws + WS_A), (float*)(ws + WS_SSQ8)}(u, row, col, v0, v1); break;
        case E_Q:    FStoreBf{(bf16_t*)(ws + WS_Q)}(u, row, col, v0, v1); break;
        case E_WO:   FWo{out, (bf16_t*)(ws + WS_A)}(u, row, col, v0, v1); break;
        case E_UP:   FUp{tp, (const float*)(ws + WS_PSCALE), (bf16_t*)(ws + WS_HID)}(u, row, col, v0, v1); break;
        case E_DOWN: default: FDown{tp, (const int*)(ws + WS_PTOK), (const float*)(ws + WS_PCOMB), (bf16_t*)(ws + WS_PK0), (bf16_t*)(ws + WS_PK1)}(u, row, col, v0, v1); break;
        }
    }
    DI bool keep(const pg8::Unit& u) const { return id == E_BR && u.e == 0; }
    DI UEpi fresh() const { UEpi e = *this; asm volatile("" : "+s"(e.ws), "+s"(e.x), "+s"(e.out), "+s"(e.glub), "+s"(e.id)); return e; }
};

struct Args { const float* in[33]; float* out; unsigned char* ws; int ph_lo, ph_hi, li, pad; };
struct Frame {
    LAS unsigned char* lds; volatile LAS unsigned* MISC; gu32* ctl;
    int tid, lane, wave, vcu, G, bid; unsigned char* ws;
};
typedef __attribute__((address_space(4))) const Args CArgs;
#if defined(__HIP_DEVICE_COMPILE__)
DI Args phase_args(CArgs* p) { asm volatile("" : "+s"(p)); return *p; }
#else
DI Args phase_args(CArgs* p) { return Args{}; }
#endif
DI Frame make_frame(const Args& a, int wave0) {
    Frame F;
    extern __shared__ __attribute__((aligned(16))) unsigned char lds[];
    F.lds = (LAS unsigned char*)lds;
    F.MISC = (volatile LAS unsigned*)(F.lds + MISC_OFF);
    { int w = wave0; asm volatile("" : "+s"(w)); F.tid = w * 64 + lane_id(); }
    F.lane = F.tid & 63; F.wave = __builtin_amdgcn_readfirstlane(F.tid >> 6);
    int bx = blockIdx.x, gx = gridDim.x; asm volatile("" : "+s"(bx), "+s"(gx));
    F.G = gx; F.bid = bx; F.vcu = (F.G % 8 == 0) ? (bx % 8) * (F.G / 8) + bx / 8 : bx;
    F.ws = a.ws; F.ctl = (gu32*)(a.ws + WS_CTL);
    return F;
}
enum { I_X = 0, I_MEM, I_NMIX, I_WIN, I_POOLW, I_POOLS, I_ARE, I_AIM, I_LOGDT, I_BRE, I_BIM, I_CRE, I_CIM, I_SD, I_GLUW, I_GLUB, I_BRP, I_BRS,
       I_WOUT, I_NX, I_NMEM, I_WQ, I_WKV, I_WO, I_NFFN, I_RGW, I_RGB, I_REW, I_REB, I_W1, I_W3, I_W2, I_NFIN };

DI void ssm_tables_item(const Args& a, Frame& F, int g, int p) {
    LAS float* lamr = (LAS float*)(F.lds);
    LAS float* lami = lamr + 17 * 64;
    LAS float* Bbr = lami + 17 * 64;
    LAS float* Bbi = Bbr + 1024;
    LAS float* Cr = Bbi + 1024;
    LAS float* Ci = Cr + 1024;
    const int tid = F.tid;
    __syncthreads();
    if (tid < 64) {
        const int n = tid;
        const float dt = expf(a.in[I_LOGDT][g]), ar = a.in[I_ARE][g * 64 + n], ai = a.in[I_AIM][g * 64 + n];
        for (int m = 0; m <= 16; ++m) { const float mag = expf((float)m * ar * dt); float sn, cs; sincosf((float)m * ai * dt, &sn, &cs); lamr[m * 64 + n] = mag * cs; lami[m * 64 + n] = mag * sn; }
        const float lr = lamr[64 + n], li = lami[64 + n], den = ar * ar + ai * ai, nr = lr - 1.f, ni = li;
        const float fre = (nr * ar + ni * ai) / den, fim = (ni * ar - nr * ai) / den;
        for (int c = 0; c < 16; ++c) {
            const float br = a.in[I_BRE][(size_t)(g * 64 + n) * 16 + c], bi = a.in[I_BIM][(size_t)(g * 64 + n) * 16 + c];
            Bbr[n * 16 + c] = fre * br - fim * bi; Bbi[n * 16 + c] = fre * bi + fim * br;
        }
        if (p == 0) {
            float* mu = (float*)(F.ws + WS_MU) + g * 128; float* nu = (float*)(F.ws + WS_NU) + g * 128;
            mu[n] = lamr[16 * 64 + n]; mu[64 + n] = lami[16 * 64 + n];
            const float mag = expf(256.f * ar * dt); float sn, cs; sincosf(256.f * ai * dt, &sn, &cs); nu[n] = mag * cs; nu[64 + n] = mag * sn;
        }
    }
    for (int e = tid; e < 1024; e += 512) { Cr[e] = a.in[I_CRE][(size_t)g * 1024 + e]; Ci[e] = a.in[I_CIM][(size_t)g * 1024 + e]; }
    __syncthreads();
    bf16_t* wsa = (bf16_t*)(F.ws + WS_WSA); bf16_t* tda = (bf16_t*)(F.ws + WS_TDA); bf16_t* woa = (bf16_t*)(F.ws + WS_WOA);
    {
        const int nt = p;
        for (int e = tid; e < 4096; e += 512) {
            const int ks = e >> 9, l = (e >> 3) & 63, jj = e & 7, r = l & 15, q = l >> 4, npr = 16 * nt + r, n = npr & 63, i = 2 * ks + (q >> 1), cp = 8 * (q & 1) + jj, m = 15 - i;
            const float zr = lamr[m * 64 + n] * Bbr[n * 16 + cp] - lami[m * 64 + n] * Bbi[n * 16 + cp], zi = lamr[m * 64 + n] * Bbi[n * 16 + cp] + lami[m * 64 + n] * Bbr[n * 16 + cp];
            wsa[((size_t)(g * 8 + nt) * 8 + ks) * 512 + l * 8 + jj] = (bf16_t)f2bf(npr < 64 ? zr : zi);
        }
    }
    {
        for (int e = tid; e < 4096; e += 512) {
            const int i = 2 * p + (e >> 11), s = (e >> 9) & 3, l = (e >> 3) & 63, jj = e & 7, cc = l & 15, q = l >> 4;
            const int npr = 32 * s + (jj < 4 ? 4 * q + jj : 16 + 4 * q + jj - 4), n = npr & 63, m = i + 1;
            const float zr = Cr[cc * 64 + n] * lamr[m * 64 + n] - Ci[cc * 64 + n] * lami[m * 64 + n], zi = Cr[cc * 64 + n] * lami[m * 64 + n] + Ci[cc * 64 + n] * lamr[m * 64 + n];
            woa[((size_t)(g * 16 + i) * 4 + s) * 512 + l * 8 + jj] = (bf16_t)f2bf(npr < 64 ? zr : -zi);
        }
    }
    {
        for (int e = tid; e < 1024; e += 512) {
            const int d = 2 * p + (e >> 9), l = (e >> 3) & 63, jj = e & 7, cc = l & 15, q = l >> 4, kk = q >> 1, cp = 8 * (q & 1) + jj, m = d - kk;
            float acc = 0.f;
            if (m >= 0) {
                for (int n = 0; n < 64; ++n) {
                    const float tr = lamr[m * 64 + n] * Bbr[n * 16 + cp] - lami[m * 64 + n] * Bbi[n * 16 + cp], ti = lamr[m * 64 + n] * Bbi[n * 16 + cp] + lami[m * 64 + n] * Bbr[n * 16 + cp];
                    acc += Cr[cc * 64 + n] * tr - Ci[cc * 64 + n] * ti;
                }
                if (m == 0 && cc == cp) acc += a.in[I_SD][g * 16 + cc];
            }
            tda[((size_t)g * 16 + d) * 512 + l * 8 + jj] = (bf16_t)f2bf(acc);
        }
    }
}
template <int D_> DI float row_shr(float x) { return __int_as_float(__builtin_amdgcn_update_dpp(0, __float_as_int(x), 0x110 + D_, 0xf, 0xf, true)); }
template <int D_> DI void ssm_scan_step(f32x4 (&zr)[4], f32x4 (&zi)[4], f32x4 (&mr)[4], f32x4 (&mi)[4]) {
#pragma unroll
    for (int nt = 0; nt < 4; ++nt)
#pragma unroll
        for (int r = 0; r < 4; ++r) {
            const float sr = row_shr<D_>(zr[nt][r]), si = row_shr<D_>(zi[nt][r]);
            zr[nt][r] += mr[nt][r] * sr - mi[nt][r] * si; zi[nt][r] += mr[nt][r] * si + mi[nt][r] * sr;
            const float a2 = mr[nt][r] * mr[nt][r] - mi[nt][r] * mi[nt][r], b2 = 2.f * mr[nt][r] * mi[nt][r]; mr[nt][r] = a2; mi[nt][r] = b2;
        }
}
DI bf16x8 pack8(const f32x4& a, const f32x4& b) { u32x4 w; w.x = pk2(a[0], a[1]); w.y = pk2(a[2], a[3]); w.z = pk2(b[0], b[1]); w.w = pk2(b[2], b[3]); return __builtin_bit_cast(bf16x8, w); }
template <bool OUT>
DI void ssm_pass(Frame& F) {
    const bf16_t* vs = (const bf16_t*)(F.ws + WS_VS); bf16_t* yg = (bf16_t*)(F.ws + WS_YG);
    float* E = (float*)(F.ws + WS_SLOC); const float* MU = (const float*)(F.ws + WS_MU); const float* NU = (const float*)(F.ws + WS_NU);
    const int lane = F.lane, j = lane & 15, q = lane >> 4;
    for (int batch = F.vcu; batch < 512; batch += F.G) {
        const int g = batch & 31, tb = batch >> 5, tile = tb * 8 + F.wave;
        __syncthreads();
        {
            const u32x4* s0 = (const u32x4*)(F.ws + WS_WSA + (size_t)g * 65536); LAS u32x4* d0 = (LAS u32x4*)(F.lds + SSM_WS);
            for (int i = F.tid; i < 4096; i += 512) d0[i] = s0[i];
            if (OUT) {
                const u32x4* s1 = (const u32x4*)(F.ws + WS_TDA + (size_t)g * 16384); LAS u32x4* d1 = (LAS u32x4*)(F.lds + SSM_TD);
                for (int i = F.tid; i < 1024; i += 512) d1[i] = s1[i];
                const u32x4* s2 = (const u32x4*)(F.ws + WS_WOA + (size_t)g * 65536); LAS u32x4* d2 = (LAS u32x4*)(F.lds + SSM_WO);
                for (int i = F.tid; i < 4096; i += 512) d2[i] = s2[i];
            }
        }
        bf16x8 Bv[8];
        {
            const bf16_t* vb = vs + ((size_t)g * T + (size_t)tile * 256 + 16 * j + (q >> 1)) * 16 + 8 * (q & 1);
#pragma unroll
            for (int ks = 0; ks < 8; ++ks) Bv[ks] = *(const bf16x8*)(vb + ks * 32);
        }
        f32x4 hpr[4], hpi[4];
        if (OUT) {
            const int tq = tile & 31, t0 = tile - tq;
            const float nr = NU[g * 128 + lane], ni = NU[g * 128 + 64 + lane];
            float hr = 0.f, hi = 0.f;
            for (int tt = 0; tt < tq; ++tt) {
                const float er = E[((size_t)(t0 + tt) * 32 + g) * 128 + lane], ei = E[((size_t)(t0 + tt) * 32 + g) * 128 + 64 + lane];
                const float a2 = nr * hr - ni * hi + er, b2 = nr * hi + ni * hr + ei; hr = a2; hi = b2;
            }
            LAS float* sc = (LAS float*)(F.lds + SSM_SCR + F.wave * 512);
            sc[lane] = hr; sc[64 + lane] = hi;
            LDS_WAIT(); __builtin_amdgcn_wave_barrier();
#pragma unroll
            for (int nt = 0; nt < 4; ++nt) { hpr[nt] = *(const LAS f32x4*)(sc + 16 * nt + 4 * q); hpi[nt] = *(const LAS f32x4*)(sc + 64 + 16 * nt + 4 * q); }
        }
        f32x4 mr[4], mi[4];
#pragma unroll
        for (int nt = 0; nt < 4; ++nt) { mr[nt] = *(const f32x4*)(MU + g * 128 + 16 * nt + 4 * q); mi[nt] = *(const f32x4*)(MU + g * 128 + 64 + 16 * nt + 4 * q); }
        __syncthreads();
        f32x4 zr[4], zi[4];
#pragma unroll
        for (int nt = 0; nt < 4; ++nt) { zr[nt] = (f32x4){0.f, 0.f, 0.f, 0.f}; zi[nt] = (f32x4){0.f, 0.f, 0.f, 0.f}; }
#pragma unroll
        for (int nt = 0; nt < 4; ++nt)
#pragma unroll
            for (int ks = 0; ks < 8; ++ks) {
                const bf16x8 ar = *(const LAS bf16x8*)(F.lds + SSM_WS + ((nt * 8 + ks) * 64 + lane) * 16);
                const bf16x8 ai = *(const LAS bf16x8*)(F.lds + SSM_WS + (((nt + 4) * 8 + ks) * 64 + lane) * 16);
                zr[nt] = __builtin_amdgcn_mfma_f32_16x16x32_bf16(ar, Bv[ks], zr[nt], 0, 0, 0);
                zi[nt] = __builtin_amdgcn_mfma_f32_16x16x32_bf16(ai, Bv[ks], zi[nt], 0, 0, 0);
            }
        if (OUT) {
            if (j == 0) {
#pragma unroll
                for (int nt = 0; nt < 4; ++nt)
#pragma unroll
                    for (int r = 0; r < 4; ++r) { zr[nt][r] += mr[nt][r] * hpr[nt][r] - mi[nt][r] * hpi[nt][r]; zi[nt][r] += mr[nt][r] * hpi[nt][r] + mi[nt][r] * hpr[nt][r]; }
            }
        }
        ssm_scan_step<1>(zr, zi, mr, mi); ssm_scan_step<2>(zr, zi, mr, mi); ssm_scan_step<4>(zr, zi, mr, mi); ssm_scan_step<8>(zr, zi, mr, mi);
        if (!OUT) {
            if (j == 15) {
                float* e = E + ((size_t)tile * 32 + g) * 128;
#pragma unroll
                for (int nt = 0; nt < 4; ++nt) { *(f32x4*)(e + 16 * nt + 4 * q) = zr[nt]; *(f32x4*)(e + 64 + 16 * nt + 4 * q) = zi[nt]; }
            }
        } else {
            f32x4 h8[8];
#pragma unroll
            for (int nt = 0; nt < 4; ++nt)
#pragma unroll
                for (int r = 0; r < 4; ++r) { const float sr = row_shr<1>(zr[nt][r]), si = row_shr<1>(zi[nt][r]); h8[nt][r] = (j == 0) ? hpr[nt][r] : sr; h8[4 + nt][r] = (j == 0) ? hpi[nt][r] : si; }
            bf16x8 Hb[4];
#pragma unroll
            for (int s = 0; s < 4; ++s) Hb[s] = pack8(h8[2 * s], h8[2 * s + 1]);
            bf16_t* yo = yg + ((size_t)tile * 256 + 16 * j) * 512 + 16 * g + 4 * q;
#pragma unroll
            for (int i = 0; i < 16; ++i) {
                f32x4 c = (f32x4){0.f, 0.f, 0.f, 0.f};
#pragma unroll
                for (int ks = 0; ks <= i / 2; ++ks) c = __builtin_amdgcn_mfma_f32_16x16x32_bf16(*(const LAS bf16x8*)(F.lds + SSM_TD + ((i - 2 * ks) * 64 + lane) * 16), Bv[ks], c, 0, 0, 0);
#pragma unroll
                for (int s = 0; s < 4; ++s) c = __builtin_amdgcn_mfma_f32_16x16x32_bf16(*(const LAS bf16x8*)(F.lds + SSM_WO + ((i * 4 + s) * 64 + lane) * 16), Hb[s], c, 0, 0, 0);
                u32x2 w; w.x = pk2(gelu_tanh(c[0]), gelu_tanh(c[1])); w.y = pk2(gelu_tanh(c[2]), gelu_tanh(c[3]));
                *(u32x2*)(yo + (size_t)i * 512) = w;
            }
        }
    }
    __syncthreads();
}

template <class RM>
DI void tr_item(const float* W, int K, int ld, int nblk, bf16_t* WT, const float* kscale, RM rm, LAS float* scr, int item, int lane) {
    const int kb = item / nblk, nb = item % nblk, k0 = 64 * kb, n0 = 32 * nb;
#pragma unroll 8
    for (int i = 0; i < 32; ++i) { const int kk = 2 * i + (lane >> 5); const float s = kscale ? kscale[k0 + kk] : 1.f; scr[kk * 33 + (lane & 31)] = W[(size_t)(k0 + kk) * ld + n0 + (lane & 31)] * s; }
    LDS_WAIT(); asm volatile("" ::: "memory");
    const int c = lane & 7;
#pragma unroll
    for (int j = 0; j < 4; ++j) { const int n = (lane >> 3) + 8 * j; const LAS float* s = scr + (8 * c) * 33 + n;
        u32x4 o; o.x = pk2(s[0 * 33], s[1 * 33]); o.y = pk2(s[2 * 33], s[3 * 33]); o.z = pk2(s[4 * 33], s[5 * 33]); o.w = pk2(s[6 * 33], s[7 * 33]);
        *(u32x4*)(WT + (size_t)rm(n0 + n) * K + k0 + 8 * c) = o; }
    LDS_WAIT(); asm volatile("" ::: "memory");
}
struct RmId { int off; DI int operator()(int n) const { return off + n; } };
struct RmIl { int off; DI int operator()(int n) const { return 8 * (n >> 2) + (n & 3) + off; } };
DI void rms_row_to_bf16(const float* xrow, bf16_t* orow, int lane) {
    const f32x4* xr = (const f32x4*)xrow + lane;
    f32x4 v[4]; float s = 0.f;
#pragma unroll
    for (int j = 0; j < 4; ++j) { v[j] = xr[64 * j]; s += (v[j].x * v[j].x + v[j].y * v[j].y) + (v[j].z * v[j].z + v[j].w * v[j].w); }
    const float r = 1.f / sqrtf(wave_sum(s) * (1.f / 1024.f) + EPS);
    u32x2* o8 = (u32x2*)orow + lane;
#pragma unroll
    for (int j = 0; j < 4; ++j) { u32x2 w; w.x = pk2(v[j].x * r, v[j].y * r); w.y = pk2(v[j].z * r, v[j].w * r); o8[64 * j] = w; }
}
DI void p0_prologue(const Args& a, Frame& F) {
    unsigned char* ws = F.ws;
    LAS float* scr = (LAS float*)(F.lds + RING_OFF + F.wave * 16384);
    const int gw = F.vcu * NWAVES + F.wave, NGW = F.G * NWAVES, lane = F.lane;
    constexpr int I0 = 16 * 80;
    constexpr int I1 = I0 + 8 * 16;
    constexpr int I2 = I1 + 8 * 32;
    constexpr int I3 = I2 + 8 * 32;
    constexpr int I4 = I3 + 16 * 32;
    constexpr int I5 = I4 + 16 * 32;
    constexpr int I6 = I5 + 16 * 64;
    constexpr int I7 = I6 + 16 * 32;
    constexpr int I8 = I7 + 16 * 256;
    constexpr int I9 = I8 + 16 * 256;
    constexpr int I10 = I9 + 16 * 256;
    for (int it = gw; it < I10; it += NGW) {
        if (it < I0) tr_item(a.in[I_WIN] + 512, 1024, 3072, 80, (bf16_t*)(ws + WS_W1T), a.in[I_NMIX], RmId{512}, scr, it, lane);
        else if (it < I1) tr_item(a.in[I_GLUW], 512, 512, 16, (bf16_t*)(ws + WS_WGLU), nullptr, RmId{0}, scr, it - I0, lane);
        else if (it < I2) tr_item(a.in[I_BRP], 512, 1024, 32, (bf16_t*)(ws + WS_WBRP), nullptr, RmId{0}, scr, it - I1, lane);
        else if (it < I3) tr_item(a.in[I_BRS], 512, 1024, 32, (bf16_t*)(ws + WS_WBRS), nullptr, RmId{0}, scr, it - I2, lane);
        else if (it < I4) tr_item(a.in[I_WOUT], 1024, 1024, 32, (bf16_t*)(ws + WS_WOUT), nullptr, RmId{0}, scr, it - I3, lane);
        else if (it < I5) tr_item(a.in[I_WQ], 1024, 1024, 32, (bf16_t*)(ws + WS_WQ), a.in[I_NX], RmId{0}, scr, it - I4, lane);
        else if (it < I6) tr_item(a.in[I_WKV], 1024, 2048, 64, (bf16_t*)(ws + WS_WKV), a.in[I_NMEM], RmId{0}, scr, it - I5, lane);
        else if (it < I7) tr_item(a.in[I_WO], 1024, 1024, 32, (bf16_t*)(ws + WS_WO), nullptr, RmId{0}, scr, it - I6, lane);
        else if (it < I8) { const int r = it - I7, e = r >> 8; tr_item(a.in[I_W1] + (size_t)e * 1024 * 512, 1024, 512, 16, (bf16_t*)(ws + WS_W13) + (size_t)e * 1024 * 1024, a.in[I_NFFN], RmIl{0}, scr, r & 255, lane); }
        else if (it < I9) { const int r = it - I8, e = r >> 8; tr_item(a.in[I_W3] + (size_t)e * 1024 * 512, 1024, 512, 16, (bf16_t*)(ws + WS_W13) + (size_t)e * 1024 * 1024, a.in[I_NFFN], RmIl{4}, scr, r & 255, lane); }
        else { const int r = it - I9, e = r >> 8; tr_item(a.in[I_W2] + (size_t)e * 512 * 1024, 512, 1024, 32, (bf16_t*)(ws + WS_W2T) + (size_t)e * 1024 * 512, nullptr, RmId{0}, scr, r & 255, lane); }
    }
    {
        const float* win = a.in[I_WIN]; const float* pw = a.in[I_POOLW]; const float* ps = a.in[I_POOLS]; const float* nm = a.in[I_NMIX];
        bf16_t* w1t = (bf16_t*)(ws + WS_W1T);
        for (int it = F.vcu * 512 + F.tid; it < 512 * 128; it += F.G * 512) {
            const int n = it & 511, kb = it >> 9, g = n >> 7, d = n & 127, k0 = kb * 8;
            float acc[8];
#pragma unroll
            for (int j = 0; j < 8; ++j) acc[j] = 0.f;
            for (int c = 0; c < 128; ++c) {
                const float p = pw[(size_t)(g * 128 + c) * 128 + d];
#pragma unroll
                for (int j = 0; j < 8; ++j) acc[j] += win[(size_t)(k0 + j) * 3072 + g * 128 + c] * p;
            }
            const float sc = ps[n];
            u32x4 o;
            o.x = pk2(acc[0] * sc * nm[k0 + 0], acc[1] * sc * nm[k0 + 1]); o.y = pk2(acc[2] * sc * nm[k0 + 2], acc[3] * sc * nm[k0 + 3]);
            o.z = pk2(acc[4] * sc * nm[k0 + 4], acc[5] * sc * nm[k0 + 5]); o.w = pk2(acc[6] * sc * nm[k0 + 6], acc[7] * sc * nm[k0 + 7]);
            *(u32x4*)(w1t + (size_t)n * 1024 + k0) = o;
        }
    }
    {
        float* rt = (float*)(ws + WS_RT); const float* nf = a.in[I_NFFN];
        for (int it = F.vcu * 512 + F.tid; it < 20 * 1024; it += F.G * 512) {
            const int j = it >> 10, k = it & 1023;
            rt[it] = nf[k] * (j < 4 ? a.in[I_RGW][k * 4 + j] : a.in[I_REW][k * 16 + (j - 4)]);
        }
    }
    for (int m = gw; m < T; m += NGW) rms_row_to_bf16(a.in[I_X] + (size_t)m * D, (bf16_t*)(ws + WS_A) + (size_t)m * D, lane);
    for (int m = gw; m < MROWS; m += NGW) rms_row_to_bf16(a.in[I_MEM] + (size_t)m * D, (bf16_t*)(ws + WS_MEMN) + (size_t)m * D, lane);
    for (int it = F.vcu; it < 256; it += F.G) ssm_tables_item(a, F, it >> 3, it & 7);
    __syncthreads();
}

DI void p2_pool(Frame& F) {
    const bf16_t* zw = (const bf16_t*)(F.ws + WS_ZW); bf16_t* yp = (bf16_t*)(F.ws + WS_YP);
    for (int it = F.vcu * 512 + F.tid; it < T * 64; it += F.G * 512) {
        const int t = it >> 6, ch = (it & 63) * 8, s = t & (SEQ - 1), w = 2 << (ch >> 7), cnt = (s + 1 < w) ? s + 1 : w;
        f32x4 z0, z1; load8bf(zw + (size_t)t * 512 + ch, z0, z1);
        f32x4 s0 = z0, s1 = z1;
        for (int j = 1; j < cnt; ++j) { f32x4 a, b; load8bf(zw + (size_t)(t - j) * 512 + ch, a, b); s0 += a; s1 += b; }
        const float inv = 1.f / (float)cnt;
        store8bf(yp + (size_t)t * 512 + ch, s0 * inv - z0, s1 * inv - z1);
    }
}
DI void p2_ssm_naive(const Args& a, Frame& F) {
    if (F.wave != 0) return;
    const bf16_t* vs = (const bf16_t*)(F.ws + WS_VS); bf16_t* yg = (bf16_t*)(F.ws + WS_YG);
    const int n = F.lane;
    for (int item = F.vcu; item < BATCH * NSG; item += F.G) {
        const int b = item >> 5, g = item & 31;
        const float dt = expf(a.in[I_LOGDT][g]), ar = a.in[I_ARE][g * 64 + n], ai = a.in[I_AIM][g * 64 + n];
        const float mag = expf(ar * dt); float sn, cs; sincosf(ai * dt, &sn, &cs);
        const float lr = mag * cs, li = mag * sn, den = ar * ar + ai * ai, nr = lr - 1.f, ni = li;
        const float fre = (nr * ar + ni * ai) / den, fim = (ni * ar - nr * ai) / den;
        float bbr[16], bbi[16], cr[16], ci[16], dsk[16];
#pragma unroll
        for (int c = 0; c < 16; ++c) {
            const float br = a.in[I_BRE][(size_t)(g * 64 + n) * 16 + c], bi = a.in[I_BIM][(size_t)(g * 64 + n) * 16 + c];
            bbr[c] = fre * br - fim * bi; bbi[c] = fre * bi + fim * br;
            cr[c] = a.in[I_CRE][(size_t)(g * 16 + c) * 64 + n]; ci[c] = a.in[I_CIM][(size_t)(g * 16 + c) * 64 + n];
            dsk[c] = (n == 0) ? a.in[I_SD][g * 16 + c] : 0.f;
        }
        float hr = 0.f, hi = 0.f;
        const int myc = (((n >> 5) & 1) << 3) | (((n >> 4) & 1) << 2) | (((n >> 3) & 1) << 1) | ((n >> 2) & 1);
        for (int s = 0; s < SEQ; ++s) {
            const size_t t = (size_t)b * SEQ + s;
            f32x4 va, vb, vc, vd; load8bf(vs + ((size_t)g * T + t) * 16, va, vb); load8bf(vs + ((size_t)g * T + t) * 16 + 8, vc, vd);
            float v[16];
#pragma unroll
            for (int j = 0; j < 4; ++j) { v[j] = va[j]; v[4 + j] = vb[j]; v[8 + j] = vc[j]; v[12 + j] = vd[j]; }
            float ur = 0.f, ui = 0.f;
#pragma unroll
            for (int c = 0; c < 16; ++c) { ur += bbr[c] * v[c]; ui += bbi[c] * v[c]; }
            const float nhr = lr * hr - li * hi + ur, nhi = lr * hi + li * hr + ui; hr = nhr; hi = nhi;
            float p[16];
#pragma unroll
            for (int c = 0; c < 16; ++c) p[c] = cr[c] * hr - ci[c] * hi + dsk[c] * v[c];
#pragma unroll
            for (int i = 0; i < 8; ++i) { const bool up = (n & 32) != 0; const float keep = up ? p[i + 8] : p[i], send = up ? p[i] : p[i + 8]; p[i] = keep + __shfl_xor(send, 32); }
#pragma unroll
            for (int i = 0; i < 4; ++i) { const bool up = (n & 16) != 0; const float keep = up ? p[i + 4] : p[i], send = up ? p[i] : p[i + 4]; p[i] = keep + __shfl_xor(send, 16); }
#pragma unroll
            for (int i = 0; i < 2; ++i) { const bool up = (n & 8) != 0; const float keep = up ? p[i + 2] : p[i], send = up ? p[i] : p[i + 2]; p[i] = keep + __shfl_xor(send, 8); }
            { const bool up = (n & 4) != 0; const float keep = up ? p[1] : p[0], send = up ? p[0] : p[1]; p[0] = keep + __shfl_xor(send, 4); }
            float y = p[0]; y += __shfl_xor(y, 1); y += __shfl_xor(y, 2);
            if ((n & 3) == 0) yg[t * 512 + g * 16 + myc] = (bf16_t)f2bf(gelu_tanh(y));
        }
    }
}


typedef float f32x16 __attribute__((ext_vector_type(16)));
DI void build_vf(Frame& F) {
    const bf16_t* vrm = (const bf16_t*)(F.ws + WS_VRM); bf16_t* vf = (bf16_t*)(F.ws + WS_VT);
    for (int it = F.vcu * 512 + F.tid; it < 16 * 8 * 16 * 64; it += F.G * 512) {
        const int l = it & 63, kk = (it >> 6) & 15, dt = (it >> 10) & 7, bh = it >> 13, b = bh >> 2, h = bh & 3, d = 32 * dt + (l & 31), hh = l >> 5;
        unsigned short e[8];
#pragma unroll
        for (int jj = 0; jj < 8; ++jj) { const int key = 16 * kk + 8 * (jj >> 2) + 4 * hh + (jj & 3); e[jj] = vrm[(size_t)(b * 256 + key) * 1024 + h * 256 + d]; }
        u32x4 w; w.x = e[0] | ((unsigned)e[1] << 16); w.y = e[2] | ((unsigned)e[3] << 16); w.z = e[4] | ((unsigned)e[5] << 16); w.w = e[6] | ((unsigned)e[7] << 16);
        *(u32x4*)(vf + (size_t)it * 8) = w;
    }
}
DI void attn_phase(Frame& F) {
    bf16_t* qo = (bf16_t*)(F.ws + WS_Q); const float* ssq8 = (const float*)(F.ws + WS_SSQ8);
    const int lane = F.lane, c = lane & 31, h2 = lane >> 5;
    for (int L = F.vcu; L < (T / 256) * XH; L += F.G) {
        const int bh = L >> 5, tq = L & 31, b = bh >> 2, h = bh & 3;
        const size_t trow = (size_t)(b * 32 + tq) * 256 + F.wave * 32 + c;
        float ss = 0.f;
        { const f32x4* sp = (const f32x4*)(ssq8 + trow * 128 + h2 * 64);
#pragma unroll 4
          for (int i = 0; i < 16; ++i) { const f32x4 t = sp[i]; ss += (t.x + t.y) + (t.z + t.w); } }
        ss += __shfl_xor(ss, 32);
        const float qscale = 0.0625f / sqrtf(ss * (1.f / 1024.f) + EPS);
        const bf16_t* qp = qo + trow * 1024 + h * 256 + 8 * h2;
        bf16x8 qcur = *(const bf16x8*)qp;
        __syncthreads();
        { const u32x4* s = (const u32x4*)(F.ws + WS_KC + (size_t)bh * 131072); LAS u32x4* d = (LAS u32x4*)(F.lds);
          for (int i = F.tid; i < 8192; i += 512) d[i] = s[i]; }
        __syncthreads();
        f32x16 st[8];
#pragma unroll
        for (int kt = 0; kt < 8; ++kt)
#pragma unroll
            for (int r = 0; r < 16; ++r) st[kt][r] = 0.f;
#pragma unroll 1
        for (int ds = 0; ds < 16; ++ds) {
            const bf16x8 qn = *(const bf16x8*)(qp + ((ds + 1) & 15) * 16);
#pragma unroll
            for (int kt = 0; kt < 8; ++kt)
                st[kt] = __builtin_amdgcn_mfma_f32_32x32x16_bf16(*(const LAS bf16x8*)(F.lds + ((kt * 16 + ds) * 64 + lane) * 16), qcur, st[kt], 0, 0, 0);
            qcur = qn;
        }
        float m = -3.0e38f;
#pragma unroll
        for (int kt = 0; kt < 8; ++kt)
#pragma unroll
            for (int r = 0; r < 16; ++r) { st[kt][r] *= qscale; m = fmaxf(m, st[kt][r]); }
        m = fmaxf(m, __shfl_xor(m, 32));
        float l = 0.f;
#pragma unroll
        for (int kt = 0; kt < 8; ++kt)
#pragma unroll
            for (int r = 0; r < 16; ++r) { const float p = __expf(st[kt][r] - m); st[kt][r] = p; l += p; }
        l += __shfl_xor(l, 32);
        const float il = 1.f / l;
        bf16x8 Pb[16];
#pragma unroll
        for (int kt = 0; kt < 8; ++kt)
#pragma unroll
            for (int s = 0; s < 2; ++s) {
                u32x4 w; w.x = pk2(st[kt][8 * s + 0], st[kt][8 * s + 1]); w.y = pk2(st[kt][8 * s + 2], st[kt][8 * s + 3]); w.z = pk2(st[kt][8 * s + 4], st[kt][8 * s + 5]); w.w = pk2(st[kt][8 * s + 6], st[kt][8 * s + 7]);
                Pb[kt * 2 + s] = __builtin_bit_cast(bf16x8, w);
            }
        __syncthreads();
        { const u32x4* s = (const u32x4*)(F.ws + WS_VT + (size_t)bh * 131072); LAS u32x4* d = (LAS u32x4*)(F.lds);
          for (int i = F.tid; i < 8192; i += 512) d[i] = s[i]; }
        __syncthreads();
        bf16_t* op = qo + trow * 1024 + h * 256 + 4 * h2;
#pragma unroll
        for (int dt = 0; dt < 8; ++dt) {
            f32x16 o;
#pragma unroll
            for (int r = 0; r < 16; ++r) o[r] = 0.f;
#pragma unroll
            for (int kk = 0; kk < 16; ++kk)
                o = __builtin_amdgcn_mfma_f32_32x32x16_bf16(*(const LAS bf16x8*)(F.lds + ((dt * 16 + kk) * 64 + lane) * 16), Pb[kk], o, 0, 0, 0);
#pragma unroll
            for (int g4 = 0; g4 < 4; ++g4) { u32x2 w; w.x = pk2(o[4 * g4 + 0] * il, o[4 * g4 + 1] * il); w.y = pk2(o[4 * g4 + 2] * il, o[4 * g4 + 3] * il);
                *(u32x2*)(op + 32 * dt + 8 * g4) = w; }
        }
    }
    __syncthreads();
}

DI void p9_router(const Args& a, Frame& F) {
    const float* h2 = a.out; const float* rt = (const float*)(F.ws + WS_RT);
    int* ptok = (int*)(F.ws + WS_PTOK); float* pcomb = (float*)(F.ws + WS_PCOMB); float* pscale = (float*)(F.ws + WS_PSCALE);
    LAS int* rec_e = (LAS int*)(F.lds);
    LAS float* rec_w = (LAS float*)(F.lds + 1024);
    LAS float* rec_s = (LAS float*)(F.lds + 2048);
    const int lane = F.lane;
    for (int chunk = F.vcu; chunk < T / 128; chunk += F.G) {
        __syncthreads();
        for (int i = 0; i < 16; ++i) {
            const int lt = F.wave * 16 + i, t = chunk * 128 + lt;
            const f32x4* hr = (const f32x4*)(h2 + (size_t)t * 1024) + lane;
            f32x4 v[4]; float ss = 0.f;
#pragma unroll
            for (int j = 0; j < 4; ++j) { v[j] = hr[64 * j]; ss += (v[j].x * v[j].x + v[j].y * v[j].y) + (v[j].z * v[j].z + v[j].w * v[j].w); }
            const float inv = 1.f / sqrtf(wave_sum(ss) * (1.f / 1024.f) + EPS);
            LAS float* lgs = (LAS float*)(F.lds + 4096 + F.wave * 128);
#pragma unroll 1
            for (int o = 0; o < 20; ++o) {
                const f32x4* rr = (const f32x4*)(rt + o * 1024) + lane; float s = 0.f;
#pragma unroll
                for (int j = 0; j < 4; ++j) { const f32x4 r = rr[64 * j]; s += (v[j].x * r.x + v[j].y * r.y) + (v[j].z * r.z + v[j].w * r.w); }
                s = wave_sum(s) * inv;
                if (lane == 0) lgs[o] = s;
            }
            LDS_WAIT(); __builtin_amdgcn_wave_barrier();
            if (lane == 0) {
                float lg[20];
#pragma unroll
                for (int o = 0; o < 20; ++o) lg[o] = lgs[o];
                float gl[4]; int gi = 0;
#pragma unroll
                for (int j = 0; j < 4; ++j) gl[j] = lg[j] + a.in[I_RGB][j];
                float gm = gl[0];
#pragma unroll
                for (int j = 1; j < 4; ++j) if (gl[j] > gm) { gm = gl[j]; gi = j; }
                float gs = 0.f;
#pragma unroll
                for (int j = 0; j < 4; ++j) gs += __expf(gl[j] - gm);
                const float gate = 1.f / gs;
                float el[4];
#pragma unroll
                for (int j = 0; j < 4; ++j) {
                    float x = 0.f;
#pragma unroll
                    for (int g2 = 0; g2 < 4; ++g2) x = (gi == g2) ? lg[4 + g2 * 4 + j] + a.in[I_REB][g2 * 4 + j] : x;
                    el[j] = x;
                }
                int i1 = 0; float v1 = el[0];
#pragma unroll
                for (int j = 1; j < 4; ++j) if (el[j] > v1) { v1 = el[j]; i1 = j; }
                int i2 = -1; float v2 = -3.0e38f;
#pragma unroll
                for (int j = 0; j < 4; ++j) if (j != i1 && el[j] > v2) { v2 = el[j]; i2 = j; }
                const float ex = __expf(v2 - v1), w1 = 1.f / (1.f + ex), w2 = ex * w1;
                rec_e[lt * 2 + 0] = gi * 4 + i1; rec_e[lt * 2 + 1] = gi * 4 + i2;
                rec_w[lt * 2 + 0] = w1 * gate; rec_w[lt * 2 + 1] = w2 * gate; rec_s[lt] = inv;
            }
        }
        __syncthreads();
        if (F.tid < 16) {
            const int e = F.tid; int n = 0;
            for (int p = 0; p < 256; ++p) n += (rec_e[p] == e) ? 1 : 0;
            int base = 0;
            if (n > 0) base = (int)__hip_atomic_fetch_add((unsigned*)(F.ctl + CW_CNT + 64 * e), (unsigned)n, RLX_AGENT);
            for (int p = 0; p < 256; ++p) if (rec_e[p] == e) {
                const int t = chunk * 128 + (p >> 1);
                ptok[e * T + base] = t | ((p & 1) ? (int)0x80000000 : 0); pcomb[e * T + base] = rec_w[p]; pscale[e * T + base] = rec_s[p >> 1]; ++base;
            }
        }
    }
    __syncthreads();
}
DI void moe_prefix(Frame& F) {
    volatile LAS int* tp = (volatile LAS int*)(F.lds + XTAB_OFF);
    __syncthreads();
    if (F.tid == 0) {
        int acc = 0;
        for (int e = 0; e < 16; ++e) { const int c = (int)__hip_atomic_load((unsigned*)(F.ctl + CW_CNT + 64 * e), RLX_AGENT); tp[e] = acc; tp[32 + e] = c; acc += (c + 255) >> 8; }
        tp[16] = acc;
    }
    __syncthreads();
}
DI void p12_final(const Args& a, Frame& F) {
    const bf16_t* pk0 = (const bf16_t*)(F.ws + WS_PK0); const bf16_t* pk1 = (const bf16_t*)(F.ws + WS_PK1); const float* nf = a.in[I_NFIN];
    const int lane = F.lane, gw = F.vcu * NWAVES + F.wave, NGW = F.G * NWAVES;
    for (int m = gw; m < T; m += NGW) {
        f32x4* hr = (f32x4*)(a.out + (size_t)m * 1024) + lane;
        f32x4 v[4]; float ss = 0.f;
#pragma unroll
        for (int j = 0; j < 4; ++j) {
            v[j] = hr[64 * j];
            const u32x2 p = *((const u32x2*)(pk0 + (size_t)m * 1024) + lane + 64 * j), r = *((const u32x2*)(pk1 + (size_t)m * 1024) + lane + 64 * j);
            v[j].x += bf2f(p.x & 0xffffu) + bf2f(r.x & 0xffffu); v[j].y += bf2f(p.x >> 16) + bf2f(r.x >> 16);
            v[j].z += bf2f(p.y & 0xffffu) + bf2f(r.y & 0xffffu); v[j].w += bf2f(p.y >> 16) + bf2f(r.y >> 16);
            ss += (v[j].x * v[j].x + v[j].y * v[j].y) + (v[j].z * v[j].z + v[j].w * v[j].w);
        }
        const float inv = 1.f / sqrtf(wave_sum(ss) * (1.f / 1024.f) + EPS);
#pragma unroll
        for (int j = 0; j < 4; ++j) { const f32x4 g = *((const f32x4*)nf + lane + 64 * j); hr[64 * j] = v[j] * inv * g; }
    }
}

constexpr int N_STEPS = 15;
constexpr int GEMM_STEPS = 0x35E6;
#ifndef SKIPMASK
#define SKIPMASK 0
#endif
#ifndef SSM_NAIVE
#define SSM_NAIVE 0
#endif
#ifndef MFMA_MASK
#define MFMA_MASK 0x35E6
#endif
DI bool use_mfma(int s) { return ((MFMA_MASK >> s) & 1) != 0; }
DI bool seam_after(int s) { return s != 1 && s != N_STEPS - 1; }
DI void grid_bar(CArgs* ap, int wave0) {
    const Args a = phase_args(ap);
    extern __shared__ __attribute__((aligned(16))) unsigned char lds[];
    XcdBarrier b; b.bar = (unsigned*)(a.ws + WS_CTL) + CW_BAR; b.x = xb_xcc_id(); b.st = (volatile LAS unsigned*)((LAS unsigned char*)lds + MISC_OFF) + 8;
    xcd_barrier(b, wave0 == 0 && lane_id() == 0);
}
DI void gemm_step(int s, const Args& a, Frame& F, pg8::Gemm& g, pg8::USched& S, UEpi& E) {
    unsigned char* ws = a.ws;
    const volatile LAS int* tp = (const volatile LAS int*)(F.lds + XTAB_OFF);
    size_t oA = WS_A, oB = WS_W1T, oA2 = 0, oB2 = 0, bstride = 0; int K = 1024, M = T, N = 1024, mode = 0, id = E_PROJ;
    if (s == 1)       { N = INW; }
    else if (s == 2)  { oA = WS_MEMN; oB = WS_WKV; M = MROWS; N = 2048; id = E_KV; }
    else if (s == 5)  { oA = WS_YG; oB = WS_WGLU; K = 512; N = 512; id = E_GLU; }
    else if (s == 6)  { oA = WS_YP; oB = WS_WBRP; oA2 = WS_YS2; oB2 = WS_WBRS; K = 512; mode = 1; id = use_mfma(6) ? E_BR : E_BRN; }
    else if (s == 7)  { oA = WS_MG; oB = WS_WOUT; id = E_WOUT; }
    else if (s == 8)  { oB = WS_WQ; id = E_Q; }
    else if (s == 10) { oA = WS_Q; oB = WS_WO; id = E_WO; }
    else if (s == 12) { oB = WS_W13; bstride = (size_t)1024 * 1024; mode = 2; id = E_UP; }
    else              { oA = WS_HID; oB = WS_W2T; K = 512; bstride = (size_t)1024 * 512; mode = 3; id = E_DOWN; }
    g.A = (const bf16_t*)(ws + oA); g.Bt = (const bf16_t*)(ws + oB); g.K = K; g.A2 = (const bf16_t*)(ws + oA2); g.Bt2 = (const bf16_t*)(ws + oB2); g.bstride = bstride;
    S.mode = mode; S.tp = tp; S.ptok = (const int*)(ws + WS_PTOK); S.nN = 4;
    S.so.init(M, N, F.G, F.bid);
    E.id = id; E.tp = tp; E.ws = ws; E.x = a.in[I_X]; E.out = a.out; E.glub = a.in[I_GLUB];
}
DI bool is_gemm_step(int s) { return ((GEMM_STEPS >> s) & 1) != 0; }

template <int S_>
DI void run_step(CArgs* ap, int wave0) {
    const Args a = phase_args(ap); Frame F = make_frame(a, wave0);
    constexpr int s = S_;
    if constexpr (((GEMM_STEPS >> S_) & 1) != 0) {
        if constexpr (S_ >= 12) moe_prefix(F);
        pg8::Gemm g; pg8::USched S; UEpi E;
        gemm_step(s, a, F, g, S, E);
        if constexpr (((MFMA_MASK >> S_) & 1) != 0) {
            unsigned char* ws = a.ws; const volatile LAS int* tp = E.tp; LAS unsigned char* ring = F.lds + RING_OFF; (void)tp;
            if constexpr (S_ == 1)  pg8::gemm_phase<false>(ring, g, S, FProj{(bf16_t*)(ws + WS_ZW), (bf16_t*)(ws + WS_VS), (bf16_t*)(ws + WS_G)}, F.tid);
            if constexpr (S_ == 2)  pg8::gemm_phase<false>(ring, g, S, FKV{(bf16_t*)(ws + WS_KC), (bf16_t*)(ws + WS_VRM)}, F.tid);
            if constexpr (S_ == 5)  pg8::gemm_phase<false>(ring, g, S, FGlu{(const bf16_t*)(ws + WS_YG), a.in[I_GLUB], (bf16_t*)(ws + WS_YS2)}, F.tid);
            if constexpr (S_ == 6)  pg8::gemm_phase<false>(ring, g, S, FBr{(const bf16_t*)(ws + WS_G), (bf16_t*)(ws + WS_MG)}, F.tid);
            if constexpr (S_ == 7)  pg8::gemm_phase<false>(ring, g, S, FWout{a.in[I_X], a.out, (bf16_t*)(ws + WS_A), (float*)(ws + WS_SSQ8)}, F.tid);
            if constexpr (S_ == 8)  pg8::gemm_phase<false>(ring, g, S, FStoreBf{(bf16_t*)(ws + WS_Q)}, F.tid);
            if constexpr (S_ == 10) pg8::gemm_phase<false>(ring, g, S, FWo{a.out, (bf16_t*)(ws + WS_A)}, F.tid);
            if constexpr (S_ == 12) pg8::gemm_phase<true>(ring, g, S, FUp{tp, (const float*)(ws + WS_PSCALE), (bf16_t*)(ws + WS_HID)}, F.tid);
            if constexpr (S_ == 13) pg8::gemm_phase<false>(ring, g, S, FDown{tp, (const int*)(ws + WS_PTOK), (const float*)(ws + WS_PCOMB), (bf16_t*)(ws + WS_PK0), (bf16_t*)(ws + WS_PK1)}, F.tid);
        } else pg8::ngemm_phase(F.lds + RING_OFF, g, S, E, F.tid);
    } else if constexpr (S_ == 0) p0_prologue(a, F);
    else if constexpr (S_ == 3) { build_vf(F); p2_pool(F); if constexpr (SSM_NAIVE) p2_ssm_naive(a, F); else ssm_pass<false>(F); }
    else if constexpr (S_ == 4) { if constexpr (!SSM_NAIVE) ssm_pass<true>(F); }
    else if constexpr (S_ == 9) attn_phase(F);
    else if constexpr (S_ == 11) p9_router(a, F);
    else p12_final(a, F);
}

__global__ void __launch_bounds__(NWAVES * 64, 2) mk_fwd(Args args) {
    extern __shared__ __attribute__((aligned(16))) unsigned char lds[];
    CArgs* ap = (CArgs*)__builtin_amdgcn_kernarg_segment_ptr();
    const int lo = args.ph_lo, hi = args.ph_hi;
    const int wave0 = __builtin_amdgcn_readfirstlane((int)threadIdx.x >> 6);
    {
        LAS unsigned char* l = (LAS unsigned char*)lds;
        for (int u = wave0 * 64 + lane_id(); u < (LDS_BYTES - LDSCTL_OFF) / 4; u += NWAVES * 64) ((LAS unsigned*)(l + LDSCTL_OFF))[u] = 0u;
        __syncthreads();
        if (!MK_PER_PHASE) (void)xcd_barrier_post((unsigned*)(args.ws + WS_CTL) + CW_BAR, (volatile LAS unsigned*)(l + MISC_OFF) + 8, wave0 == 0 && lane_id() == 0);
    }
#define STEP(k) do { if (lo <= (k) && (k) < hi) { run_step<k>(ap, wave0); if (!MK_PER_PHASE && (k) + 1 < hi && seam_after(k)) grid_bar(ap, wave0); } } while (0)
    STEP(0); STEP(1); STEP(2); STEP(3); STEP(4); STEP(5); STEP(6); STEP(7); STEP(8); STEP(9); STEP(10); STEP(11); STEP(12); STEP(13); STEP(14);
#undef STEP
}

extern "C" void kernel_launch(void* const* d_in, const int* in_sizes, int n_in, void* d_out, int out_size, void* d_ws, size_t ws_size, hipStream_t stream) {
    static int grid = 0;
    if (grid == 0) {
        if (n_in != 33 || in_sizes[0] != T * D || out_size != T * D || ws_size < WS_END) {
            fprintf(stderr, "kernel_launch: shape/workspace mismatch (n_in %d, in0 %d, out %d, ws %zu, need %zu); nothing launched\n", n_in, n_in > 0 ? in_sizes[0] : -1, out_size, ws_size, (size_t)WS_END); grid = -1; return; }
        int dev = 0, cus = 0, per_cu = 0;
        if (hipGetDevice(&dev) != hipSuccess || hipDeviceGetAttribute(&cus, hipDeviceAttributeMultiprocessorCount, dev) != hipSuccess) { fprintf(stderr, "kernel_launch: device query failed\n"); grid = -1; return; }
        if (hipFuncSetAttribute((const void*)mk_fwd, hipFuncAttributeMaxDynamicSharedMemorySize, LDS_BYTES) != hipSuccess) { fprintf(stderr, "kernel_launch: hipFuncSetAttribute failed\n"); grid = -1; return; }
        if (hipOccupancyMaxActiveBlocksPerMultiprocessor(&per_cu, (const void*)mk_fwd, NWAVES * 64, LDS_BYTES) != hipSuccess || per_cu < 1) {
            fprintf(stderr, "kernel_launch: occupancy query reports %d workgroups per CU; nothing launched\n", per_cu); (void)hipGetLastError(); grid = -1; return; }
        grid = cus;
    }
    if (grid < 0) return;
    if (hipMemsetAsync((char*)d_ws + WS_CTL, 0, CTL_ZERO_BYTES, stream) != hipSuccess) { fprintf(stderr, "kernel_launch: memset failed\n"); return; }
    Args a{};
    for (int i = 0; i < 33; ++i) a.in[i] = (const float*)d_in[i];
    a.out = (float*)d_out; a.ws = (unsigned char*)d_ws;
    const int cuts[] = {0, 1, 3, 4, 5, 6, 7, 8, 9, 10, 11, 12, 13, 14, 15};
    const int nl = MK_PER_PHASE ? 14 : 1;
    for (int li = 0; li < nl; ++li) {
        a.ph_lo = MK_PER_PHASE ? cuts[li] : 0; a.ph_hi = MK_PER_PHASE ? cuts[li + 1] : N_STEPS; a.li = li;
        hipLaunchKernelGGL(mk_fwd, dim3(grid), dim3(NWAVES * 64), LDS_BYTES, stream, a);
        const hipError_t le = hipPeekAtLastError();
        if (le != hipSuccess) { fprintf(stderr, "kernel_launch: launch %d failed: %s\n", li, hipGetErrorName(le)); break; }
    }
}
```

```cpp
#include <hip/hip_runtime.h>
#include <cstdio>
#include <cstdint>

#define GAS __attribute__((address_space(1)))
#define LAS __attribute__((address_space(3)))
typedef unsigned short bf16_t;
typedef float f32x4 __attribute__((ext_vector_type(4)));
typedef float f32x2 __attribute__((ext_vector_type(2)));
typedef unsigned u32x4 __attribute__((ext_vector_type(4)));
typedef unsigned u32x2 __attribute__((ext_vector_type(2)));
typedef short bf16x8 __attribute__((ext_vector_type(8)));
typedef GAS unsigned gu32;
#define RLX_AGENT __ATOMIC_RELAXED, __HIP_MEMORY_SCOPE_AGENT
#define LDS_WAIT() asm volatile("s_waitcnt lgkmcnt(0)" ::: "memory")
#define VM_WAIT() asm volatile("s_waitcnt vmcnt(0)" ::: "memory")
#define DI __device__ __forceinline__

#ifndef MK_PER_PHASE
#define MK_PER_PHASE 0
#endif

#ifndef PROBE_LO
#define PROBE_LO -1
#endif
#ifndef PROBE_HI
#define PROBE_HI -1
#endif
#define PROBE_ON (PROBE_LO >= 0)
#ifndef PROBE_BARSTEP
#define PROBE_BARSTEP -1
#endif
#ifndef PROBE_GEMMSTEP
#define PROBE_GEMMSTEP -1
#endif
#if PROBE_LO >= 0
#define PACC_T0(F) unsigned long long _pt0 = ((F).bid == 0 && (F).tid == 0) ? __builtin_amdgcn_s_memrealtime() : 0ull
#define PACC(F, k) do { if ((F).bid == 0 && (F).tid == 0) { const unsigned long long _n = __builtin_amdgcn_s_memrealtime(); ((unsigned long long*)((F).ws + 512 * 1024))[33 + 2 * (k)] += _n - _pt0; _pt0 = _n; } } while (0)
#else
#define PACC_T0(F) do { } while (0)
#define PACC(F, k) do { } while (0)
#endif
constexpr size_t WS_TS = 512 * 1024;

constexpr int BATCH = 4, SEQ = 8192, D = 1024, T = BATCH * SEQ;
constexpr int PW = 512, SW = 512, NSG = 32, GD = 16, NS = 64, INW = 3072;
constexpr int MEM = 256, XH = 4, XHD = 256, MROWS = BATCH * MEM;
constexpr int NE = 16, DE = 512;
constexpr float EPS = 1e-6f;
constexpr int NWAVES = 8;

constexpr size_t MiB = 1u << 20;
constexpr size_t WS_CTL = 0, CTL_ZERO_BYTES = 1 * MiB;
constexpr size_t WS_W1T = 1 * MiB;
constexpr size_t WS_WGLU = 7 * MiB;
constexpr size_t WS_WBRP = WS_WGLU + MiB / 2;
constexpr size_t WS_WBRS = WS_WBRP + MiB;
constexpr size_t WS_WOUT = WS_WBRS + MiB;
constexpr size_t WS_WQ = WS_WOUT + 2 * MiB;
constexpr size_t WS_WKV = WS_WQ + 2 * MiB;
constexpr size_t WS_WO = WS_WKV + 4 * MiB;
constexpr size_t WS_W13 = 20 * MiB;
constexpr size_t WS_W2T = 52 * MiB;
constexpr size_t WS_MEMN = 68 * MiB;
constexpr size_t WS_KC = 70 * MiB;
constexpr size_t WS_VT = 72 * MiB;
constexpr size_t WS_SSMT = 74 * MiB;
constexpr size_t WS_WSA = WS_SSMT;
constexpr size_t WS_TDA = WS_SSMT + 2 * MiB;
constexpr size_t WS_WOA = WS_TDA + MiB / 2;
constexpr size_t WS_MU = WS_WOA + 2 * MiB;
constexpr size_t WS_NU = WS_MU + 16384;
constexpr size_t WS_RT = 84 * MiB;
constexpr size_t WS_SSQ8 = 85 * MiB;
constexpr size_t WS_PTOK = 101 * MiB;
constexpr size_t WS_PCOMB = 103 * MiB;
constexpr size_t WS_PSCALE = 105 * MiB;
constexpr size_t WS_SLOC = 107 * MiB;
constexpr size_t WS_VRM = 109 * MiB;
constexpr size_t WS_A = 112 * MiB;
constexpr size_t WS_ZW = 176 * MiB;
constexpr size_t WS_VS = 208 * MiB;
constexpr size_t WS_MG = 176 * MiB;
constexpr size_t WS_Q = 176 * MiB;
constexpr size_t WS_G = 240 * MiB;
constexpr size_t WS_PKR = 176 * MiB;
constexpr size_t WS_RMSX = 103 * MiB + 512 * 1024;
constexpr size_t WS_TSLOT = 103 * MiB;
constexpr size_t WS_TCOMB = 104 * MiB;
constexpr size_t WS_YP = 368 * MiB, WS_YG = 400 * MiB, WS_YS2 = 432 * MiB;
constexpr size_t WS_HID = 368 * MiB;
constexpr size_t WS_END = 464 * MiB;
constexpr int CW_TMO = 0, CW_CODE = 1;
constexpr int CW_BAR = 4096;
constexpr int CW_CNT = 16384;

constexpr int RING_OFF = 0, RING_BYTES = 131072;
constexpr int LDS_BYTES = 163840;
constexpr int LDSCTL_OFF = LDS_BYTES - 2048, MISC_OFF = LDSCTL_OFF + 320;
constexpr int XTAB_OFF = LDSCTL_OFF + 512;
constexpr int SSM_WS = 0, SSM_TD = 65536, SSM_WO = 81920, SSM_SCR = 147456;

DI float bf2f(unsigned b) { return __uint_as_float(b << 16); }
DI unsigned f2bf(float f) { unsigned u = __float_as_uint(f); return (u + 0x7fffu + ((u >> 16) & 1u)) >> 16; }
typedef __bf16 bf16x2_t __attribute__((ext_vector_type(2)));
DI unsigned pk2(float lo, float hi) { const f32x2 v = {lo, hi}; const bf16x2_t b = __builtin_convertvector(v, bf16x2_t); return __builtin_bit_cast(unsigned, b); }
DI float sigm(float x) { return __builtin_amdgcn_rcpf(1.f + __expf(-x)); }
DI float gelu_tanh(float x) { return x * sigm(1.5957691216057308f * (x + 0.044715f * x * x * x)); }
DI int lane_id() { int l; asm volatile("v_mbcnt_lo_u32_b32 %0, -1, 0\n\tv_mbcnt_hi_u32_b32 %0, -1, %0" : "=&v"(l)); return l; }
DI float wave_sum(float v) {
#pragma unroll
    for (int o = 1; o < 64; o <<= 1) v += __shfl_xor(v, o);
    return v;
}
DI float wave_max(float v) {
#pragma unroll
    for (int o = 1; o < 64; o <<= 1) v = fmaxf(v, __shfl_xor(v, o));
    return v;
}
DI void store8bf(bf16_t* p, const f32x4& a, const f32x4& b) {
    u32x4 w; w.x = pk2(a[0], a[1]); w.y = pk2(a[2], a[3]); w.z = pk2(b[0], b[1]); w.w = pk2(b[2], b[3]);
    *(u32x4*)p = w;
}
DI void load8bf(const bf16_t* p, f32x4& a, f32x4& b) {
    const u32x4 w = *(const u32x4*)p;
    a[0] = bf2f(w.x & 0xffffu); a[1] = bf2f(w.x >> 16); a[2] = bf2f(w.y & 0xffffu); a[3] = bf2f(w.y >> 16);
    b[0] = bf2f(w.z & 0xffffu); b[1] = bf2f(w.z >> 16); b[2] = bf2f(w.w & 0xffffu); b[3] = bf2f(w.w >> 16);
}

#define XB_TMO      128
#define XB_XCNT(j)  (256  + 64 * (j))
#define XB_XSUB(j)  (1280 + 64 * (j))
#define XB_XGEN(j)  (2304 + 64 * (j))
#define XB_TOP      3328
#define XB_TOPGEN   3392
#define XCD_BAR_WORDS 3456
#define XB_SPIN_CAP (1u << 18)
DI unsigned xb_ld(unsigned* p)              { return __hip_atomic_load(p, __ATOMIC_RELAXED, __HIP_MEMORY_SCOPE_AGENT); }
DI unsigned xb_add(unsigned* p, unsigned v) { return __hip_atomic_fetch_add(p, v, __ATOMIC_RELAXED, __HIP_MEMORY_SCOPE_AGENT); }
DI unsigned xb_xcc_id() { return (unsigned)__builtin_amdgcn_s_getreg((3 << 11) | 20) & 0xFu; }
#define XB_SPIN(cond, bar) do { unsigned _sp = 0; while (cond) { __builtin_amdgcn_s_sleep(1); \
    if ((++_sp & 255u) == 0u) { if (xb_ld(&(bar)[XB_TMO])) break; if (_sp > XB_SPIN_CAP) { atomicAdd(&(bar)[XB_TMO], 1u); break; } } } } while (0)
struct XcdBarrier { unsigned* bar; unsigned x; volatile LAS unsigned* st; };
DI XcdBarrier xcd_barrier_post(unsigned* bar, volatile LAS unsigned* st, bool t0) {
    XcdBarrier b; b.bar = bar; b.x = xb_xcc_id(); b.st = st;
    if (t0) (void)xb_add(&bar[XB_XCNT(b.x)], 1u);
    return b;
}
DI void xcd_barrier_complete(unsigned* bar, unsigned x, unsigned& nloc, unsigned& nx, int lane) {
    const unsigned G = gridDim.x * gridDim.y * gridDim.z;
    unsigned sum, cnt, mine, sp = 0u;
    for (;;) {
        const unsigned c = xb_ld(&bar[XB_XCNT(lane & 15)]);
        sum = c; cnt = (c > 0u) ? 1u : 0u;
#pragma unroll
        for (int o = 1; o < 16; o <<= 1) { sum += __shfl_xor(sum, o); cnt += __shfl_xor(cnt, o); }
        mine = __shfl(c, (int)x);
        if (sum == G) break;
        __builtin_amdgcn_s_sleep(1);
        if ((++sp & 255u) == 0u) { if (xb_ld(&bar[XB_TMO])) break; if (sp > XB_SPIN_CAP) { if (lane == 0) atomicAdd(&bar[XB_TMO], 1u); break; } }
    }
    nloc = mine > 0u ? mine : 1u; nx = cnt > 0u ? cnt : 1u;
}
DI void xcd_barrier(const XcdBarrier& b, bool w0, int lane) {
    asm volatile("s_waitcnt vmcnt(0)" ::: "memory");
    __syncthreads();
    if (w0) {
        unsigned* bar = b.bar;
        unsigned nloc = b.st[0], nx = b.st[1];
        if (nloc == 0u) { xcd_barrier_complete(bar, b.x, nloc, nx, lane); if (lane == 0) { b.st[0] = nloc; b.st[1] = nx; } }
        if (lane == 0) {
            __builtin_amdgcn_s_waitcnt(0);
            const unsigned old = xb_add(&bar[XB_XSUB(b.x)], 1u);
            const unsigned gen = old / nloc;
            if (old == gen * nloc) asm volatile("buffer_wbl2 sc1" ::: "memory");
            if (old + 1u == (gen + 1u) * nloc) {
                __builtin_amdgcn_fence(__ATOMIC_RELEASE, "agent");
                asm volatile("s_waitcnt vmcnt(0)" ::: "memory");
                const unsigned og = xb_add(&bar[XB_TOP], 1u);
                const unsigned tg = og / nx;
                if (og + 1u == (tg + 1u) * nx) xb_add(&bar[XB_TOPGEN], 1u);
                else XB_SPIN(xb_ld(&bar[XB_TOPGEN]) == tg, bar);
                xb_add(&bar[XB_XGEN(b.x)], 1u);
                __builtin_amdgcn_fence(__ATOMIC_ACQUIRE, "agent");
                asm volatile("s_waitcnt vmcnt(0)" ::: "memory");
            } else {
                XB_SPIN(xb_ld(&bar[XB_XGEN(b.x)]) == gen, bar);
                __builtin_amdgcn_fence(__ATOMIC_ACQUIRE, "agent");
                asm volatile("s_waitcnt vmcnt(0)" ::: "memory");
            }
        }
    }
    __syncthreads();
}

DI void stage_lds(LAS unsigned char* dst, const unsigned char* src, int bytes, int wave, int lane) {
    for (int p = wave; p < (bytes >> 10); p += NWAVES)
        __builtin_amdgcn_global_load_lds((const unsigned*)(src + (size_t)p * 1024 + lane * 16), (LAS unsigned*)(dst + p * 1024), 16, 0, 0);
}
namespace pg8 {
constexpr int BM = 256, BK = 64, HALF = 128, NXCD = 8, WGM = 8;
struct Unit { int pm, pn, e; };
struct Gemm { const bf16_t* A; const bf16_t* Bt; int K; const bf16_t* A2; const bf16_t* Bt2; size_t bstride; unsigned long long* pts; };

struct StaticOrder {
    int nM, nN, nwg, G, c;
    DI void init(int M, int N, int G_, int c_) { nM = M / BM; nN = N / BM; nwg = nM * nN; G = G_; c = c_; }
    DI bool tile(int L, Unit& u) const {
        if (L >= nwg) return false;
        int wgid = L; { const int q = nwg / NXCD, r = nwg % NXCD, xcd = wgid % NXCD, off = wgid / NXCD; wgid = (xcd < r ? xcd * (q + 1) : r * (q + 1) + (xcd - r) * q) + off; }
        const int nig = WGM * nN, gid = wgid / nig, fm = gid * WGM, gsz = (nM - fm) < WGM ? (nM - fm) : WGM;
        u.pm = fm + ((wgid % nig) % gsz); u.pn = (wgid % nig) / gsz; u.e = 0; return true;
    }
    DI bool next(int i, Unit& u) const { return tile(i * G + c, u); }
    DI const bf16_t* a_base(const Gemm& g, const Unit&) const { return g.A; }
    DI const bf16_t* a_row(const Gemm& g, const Unit& u, int r) const { return g.A + (size_t)(u.pm * BM + r) * g.K; }
    DI const bf16_t* b_row(const Gemm& g, const Unit& u, int n) const { return g.Bt + (size_t)(u.pn * BM + n) * g.K; }
};
struct USched {
    int mode; StaticOrder so; const volatile LAS int* tp; const int* ptok; int nN; int one_pm, one_pn;
    DI bool next(int i, Unit& u) const {
        if (mode == 4) { if (i != 0) return false; u.pm = one_pm; u.pn = one_pn; u.e = 0; return true; }
        if (mode == 0) return so.tile(i * so.G + so.c, u);
        if (mode == 1) { if (!so.tile((i >> 1) * so.G + so.c, u)) return false; u.e = i & 1; return true; }
        const int L = i * so.G + so.c, total = tp[16] * nN; if (L >= total) return false;
        const int mt = L / nN; int e = 0;
#pragma unroll
        for (int j = 1; j < 16; ++j) e += (mt >= tp[j]) ? 1 : 0;
        u.pm = __builtin_amdgcn_readfirstlane(mt); u.pn = __builtin_amdgcn_readfirstlane(L % nN); u.e = __builtin_amdgcn_readfirstlane(e); return true;
    }
    DI const bf16_t* a_base(const Gemm& g, const Unit& u) const { return (mode == 1 && u.e) ? g.A2 : g.A; }
    DI const bf16_t* a_row(const Gemm& g, const Unit& u, int r) const {
        if (mode == 2) {
            const int slot = (u.pm - tp[u.e]) * BM + r; const int cnt = tp[32 + u.e];
            const int tok = ptok[u.e * T + (slot < cnt ? slot : 0)] & 0x7fffffff;
            return g.A + (size_t)tok * g.K;
        }
        return a_base(g, u) + (size_t)(u.pm * BM + r) * g.K;
    }
    DI const bf16_t* b_row(const Gemm& g, const Unit& u, int n) const {
        const bf16_t* b = (mode == 1 && u.e) ? g.Bt2 : g.Bt;
        if (mode >= 2) b += (size_t)u.e * g.bstride;
        return b + (size_t)(u.pn * BM + n) * g.K;
    }
};


template <class Epi, class Sched>
DI void ngemm_phase(LAS unsigned char* lds, const Gemm g, const Sched& S, const Epi& E, const int tid) {
    LAS float* As = (LAS float*)lds;
    LAS float* Bs = As + 16 * 132;
    const int lr = tid >> 2, kq = tid & 3, tx = tid & 15, ty = tid >> 4;
    Unit u;
    for (int i = 0; S.next(i, u); ++i) {
        for (int sub = 0; sub < 4; ++sub) {
            const int sm = (sub >> 1) * 128, sn = (sub & 1) * 128;
            float acc[4][8];
#pragma unroll
            for (int r = 0; r < 4; ++r)
#pragma unroll
                for (int c = 0; c < 8; ++c) acc[r][c] = 0.f;
            const bf16_t* arow = S.a_row(g, u, sm + lr) + kq * 4;
            const bf16_t* brow = S.b_row(g, u, sn + lr) + kq * 4;
            for (int k0 = 0; k0 < g.K; k0 += 16) {
                __syncthreads();
                const u32x2 av = *(const u32x2*)(arow + k0), bv = *(const u32x2*)(brow + k0);
                As[(kq * 4 + 0) * 132 + lr] = bf2f(av.x & 0xffffu); As[(kq * 4 + 1) * 132 + lr] = bf2f(av.x >> 16);
                As[(kq * 4 + 2) * 132 + lr] = bf2f(av.y & 0xffffu); As[(kq * 4 + 3) * 132 + lr] = bf2f(av.y >> 16);
                Bs[(kq * 4 + 0) * 132 + lr] = bf2f(bv.x & 0xffffu); Bs[(kq * 4 + 1) * 132 + lr] = bf2f(bv.x >> 16);
                Bs[(kq * 4 + 2) * 132 + lr] = bf2f(bv.y & 0xffffu); Bs[(kq * 4 + 3) * 132 + lr] = bf2f(bv.y >> 16);
                __syncthreads();
#pragma unroll
                for (int k = 0; k < 16; ++k) {
                    const f32x4 a4 = *(const LAS f32x4*)(As + k * 132 + ty * 4);
                    const f32x4 b0 = *(const LAS f32x4*)(Bs + k * 132 + tx * 8), b1 = *(const LAS f32x4*)(Bs + k * 132 + tx * 8 + 4);
#pragma unroll
                    for (int r = 0; r < 4; ++r) {
#pragma unroll
                        for (int c = 0; c < 4; ++c) { acc[r][c] += a4[r] * b0[c]; acc[r][4 + c] += a4[r] * b1[c]; }
                    }
                }
            }
#pragma unroll
            for (int r = 0; r < 4; ++r) {
                f32x4 v0 = {acc[r][0], acc[r][1], acc[r][2], acc[r][3]}, v1 = {acc[r][4], acc[r][5], acc[r][6], acc[r][7]};
                E(u, u.pm * BM + sm + ty * 4 + r, u.pn * BM + sn + tx * 8, v0, v1);
            }
        }
    }
    __syncthreads();
}

template <class F> DI void epi_drive(const F& f, const Unit& u, f32x4 (&acc)[2][2][4][2], int wr, int wc, int fr, int fq) {
#pragma unroll
    for (int ai = 0; ai < 2; ++ai) {
#pragma unroll
        for (int m = 0; m < 4; ++m) { const int row = u.pm * 256 + ai * 128 + wr * 64 + m * 16 + fr;
#pragma unroll
            for (int bj = 0; bj < 2; ++bj) f(u, row, u.pn * 256 + bj * 128 + wc * 32 + 8 * fq, acc[ai][bj][m][0], acc[ai][bj][m][1]); }
    }
}
template <class F> DI void epi_drive2(const F& f, const Unit& u, f32x4 (&acc)[2][2][4][2], int wr, int wc, int fr, int fq) {
#pragma unroll
    for (int ai = 0; ai < 2; ++ai) {
        typename F::Opnd op[4][2];
#pragma unroll
        for (int m = 0; m < 4; ++m)
#pragma unroll
            for (int bj = 0; bj < 2; ++bj) op[m][bj] = f.load(u, u.pm * 256 + ai * 128 + wr * 64 + m * 16 + fr, u.pn * 256 + bj * 128 + wc * 32 + 8 * fq);
#pragma unroll
        for (int m = 0; m < 4; ++m)
#pragma unroll
            for (int bj = 0; bj < 2; ++bj) f.apply(u, u.pm * 256 + ai * 128 + wr * 64 + m * 16 + fr, u.pn * 256 + bj * 128 + wc * 32 + 8 * fq, op[m][bj], acc[ai][bj][m][0], acc[ai][bj][m][1]);
    }
}
DI int lds_byte(int r, int c) { const int st = (r >> 4) * 2 + (c >> 5), rr = r & 15, cc = c & 31, ob = rr * 64 + cc * 2; return st * 1024 + (ob ^ (((ob >> 9) & 1) << 5)); }
DI void stage_rc(int b, int& R, int& C) { const int st = b / 1024, sb = b % 1024, swz = sb ^ (((sb >> 9) & 1) << 5); R = (st >> 1) * 16 + swz / 64; C = (st & 1) * 32 + (swz % 64) / 2; }
DI int perm32(int rho) { const int n = rho >> 4, i = rho & 15; return 8 * (i >> 2) + 4 * n + (i & 3); }
constexpr int HTB = HALF * BK * 2;
template <bool GATHER, class F, class Sched>
DI void gemm_phase(LAS unsigned char* lds, const Gemm g, const Sched& S, const F& E, const int tid) {
    const int wid = __builtin_amdgcn_readfirstlane(tid >> 6), lane = tid & 63, wr = wid >> 2, wc = wid & 3, fr = lane & 15, fq = lane >> 4;
    const int K = g.K, nt = K / BK;
    int Rr[2], Cc[2]; unsigned voffB[2];
#pragma unroll
    for (int i = 0; i < 2; ++i) { int R, C; stage_rc(tid * 16 + i * 8192, R, C); Rr[i] = R; Cc[i] = C; const int Rb = (R & ~31) + perm32(R & 31); voffB[i] = (unsigned)(Rb * K + C) * 2u; }
    const size_t kstep = (size_t)(BK * 2);
    const size_t hstep = (size_t)HALF * K * 2;
    const unsigned ldsw = (unsigned)wid * 1024u;
    const int aoff = lds_byte(wr * 64 + fr, fq * 8), boff = lds_byte(wc * 32 + fr, fq * 8);
#define PG8_SA(b, h) (((b) * 2 + (h)) * HTB)
#define PG8_SB(b, h) ((4 + (b) * 2 + (h)) * HTB)
#define PG8_STAGE2(bufoff, gbase, v0_, v1_) do { \
        __builtin_amdgcn_global_load_lds((const unsigned*)((const char*)(gbase) + (v0_)), (LAS unsigned*)(lds + (bufoff) + ldsw), 16, 0, 0); \
        __builtin_amdgcn_global_load_lds((const unsigned*)((const char*)(gbase) + (v1_)), (LAS unsigned*)(lds + (bufoff) + ldsw + 8192), 16, 0, 0); } while (0)
#define PG8_STAGEB(bufoff, gbase) PG8_STAGE2(bufoff, gbase, voffB[0], voffB[1])
#define PG8_LDA(dst, b, h) do { _Pragma("unroll") for (int m = 0; m < 4; ++m) _Pragma("unroll") for (int k = 0; k < 2; ++k) dst[m][k] = *(const LAS bf16x8*)(lds + PG8_SA(b, h) + aoff + m * 2048 + k * 1024); } while (0)
#define PG8_LDB(dst, b, h) do { _Pragma("unroll") for (int n = 0; n < 2; ++n) _Pragma("unroll") for (int k = 0; k < 2; ++k) dst[n][k] = *(const LAS bf16x8*)(lds + PG8_SB(b, h) + boff + n * 2048 + k * 1024); } while (0)
#define PG8_MMA(ai, bj, At, Bt) do { __builtin_amdgcn_s_setprio(1); _Pragma("unroll") for (int m = 0; m < 4; ++m) _Pragma("unroll") for (int n = 0; n < 2; ++n) _Pragma("unroll") for (int k = 0; k < 2; ++k) \
        acc[ai][bj][m][n] = __builtin_amdgcn_mfma_f32_16x16x32_bf16(Bt[n][k], At[m][k], acc[ai][bj][m][n], 0, 0, 0); __builtin_amdgcn_s_setprio(0); } while (0)
#define PG8_WAIT_V(n) asm volatile("s_waitcnt vmcnt(" #n ")" ::: "memory")
#define PG8_WAIT_L(n) asm volatile("s_waitcnt lgkmcnt(" #n ")" ::: "memory")
#define PG8_BAR __builtin_amdgcn_s_barrier()
#define PG8_SCHED __builtin_amdgcn_sched_barrier(0)
    Unit cur, nxt; int ui = 0;
    if (!S.next(0, cur)) return;
    f32x4 acc[2][2][4][2];
#pragma unroll
    for (int a = 0; a < 2; ++a)
#pragma unroll
        for (int b = 0; b < 2; ++b)
#pragma unroll
            for (int m = 0; m < 4; ++m)
#pragma unroll
                for (int n = 0; n < 2; ++n) acc[a][b][m][n] = (f32x4){0.f, 0.f, 0.f, 0.f};
    bf16x8 At[4][2], B0[2][2], B1[2][2];
    const char* cA = GATHER ? (const char*)S.a_base(g, cur) : (const char*)S.a_row(g, cur, 0); const char* cB = (const char*)S.b_row(g, cur, 0);
    unsigned vc00, vc01, vc10, vc11;
    if constexpr (GATHER) {
        vc00 = (unsigned)((const char*)S.a_row(g, cur, Rr[0]) - cA) + (unsigned)Cc[0] * 2u; vc01 = (unsigned)((const char*)S.a_row(g, cur, Rr[1]) - cA) + (unsigned)Cc[1] * 2u;
        vc10 = (unsigned)((const char*)S.a_row(g, cur, HALF + Rr[0]) - cA) + (unsigned)Cc[0] * 2u; vc11 = (unsigned)((const char*)S.a_row(g, cur, HALF + Rr[1]) - cA) + (unsigned)Cc[1] * 2u;
    } else {
        vc00 = (unsigned)(Rr[0] * K + Cc[0]) * 2u; vc01 = (unsigned)(Rr[1] * K + Cc[1]) * 2u; vc10 = vc00 + (unsigned)hstep; vc11 = vc01 + (unsigned)hstep;
    }
    PG8_STAGEB(PG8_SB(0, 0), cB); PG8_STAGEB(PG8_SB(0, 1), cB + hstep); PG8_STAGE2(PG8_SA(0, 0), cA, vc00, vc01); PG8_STAGE2(PG8_SA(0, 1), cA, vc10, vc11);
    if (wr == 1) PG8_BAR;
    PG8_WAIT_V(2); PG8_BAR;
    PG8_STAGEB(PG8_SB(1, 0), cB + kstep); PG8_STAGE2(PG8_SA(1, 0), cA + kstep, vc00, vc01); PG8_STAGEB(PG8_SB(1, 1), cB + hstep + kstep);
    PG8_WAIT_V(6); PG8_BAR;
    unsigned long long _gt = g.pts ? __builtin_amdgcn_s_memrealtime() : 0ull;
    for (;;) {
        const bool has_next = S.next(ui + 1, nxt);
        const char* nA = cA; const char* nB = cB; unsigned vn00 = vc00, vn01 = vc01, vn10 = vc10, vn11 = vc11;
        if (has_next) {
            nB = (const char*)S.b_row(g, nxt, 0);
            if constexpr (GATHER) {
                nA = (const char*)S.a_base(g, nxt);
                vn00 = (unsigned)((const char*)S.a_row(g, nxt, Rr[0]) - nA) + (unsigned)Cc[0] * 2u; vn01 = (unsigned)((const char*)S.a_row(g, nxt, Rr[1]) - nA) + (unsigned)Cc[1] * 2u;
                vn10 = (unsigned)((const char*)S.a_row(g, nxt, HALF + Rr[0]) - nA) + (unsigned)Cc[0] * 2u; vn11 = (unsigned)((const char*)S.a_row(g, nxt, HALF + Rr[1]) - nA) + (unsigned)Cc[1] * 2u;
            } else nA = (const char*)S.a_row(g, nxt, 0);
        }
        for (int t = 0; t < nt; t += 2) {
            const bool last = (t == nt - 2);
            const char* a1 = cA + (size_t)(t + 1) * kstep;
            const char* a2 = last ? nA : cA + (size_t)(t + 2) * kstep; const char* b2 = last ? nB : cB + (size_t)(t + 2) * kstep;
            const char* a3 = a2 + kstep; const char* b3 = b2 + kstep;
            const unsigned w00 = (GATHER && last) ? vn00 : vc00, w01 = (GATHER && last) ? vn01 : vc01, w10 = (GATHER && last) ? vn10 : vc10, w11 = (GATHER && last) ? vn11 : vc11;
            PG8_LDB(B0, 0, 0); PG8_LDB(B1, 0, 1); PG8_SCHED; PG8_LDA(At, 0, 0); PG8_STAGE2(PG8_SA(1, 1), a1, vc10, vc11);
            PG8_WAIT_V(8); PG8_WAIT_L(0); PG8_BAR; PG8_MMA(0, 0, At, B0); PG8_MMA(0, 1, At, B1); PG8_BAR; PG8_SCHED;
            PG8_LDA(At, 0, 1); PG8_STAGEB(PG8_SB(0, 0), b2); PG8_STAGEB(PG8_SB(0, 1), b2 + hstep); PG8_STAGE2(PG8_SA(0, 0), a2, w00, w01);
            PG8_WAIT_V(8); PG8_WAIT_L(0); PG8_BAR; PG8_MMA(1, 0, At, B0); PG8_MMA(1, 1, At, B1); PG8_BAR; PG8_SCHED;
            PG8_LDB(B0, 1, 0); PG8_LDB(B1, 1, 1); PG8_SCHED; PG8_LDA(At, 1, 0); PG8_STAGE2(PG8_SA(0, 1), a2, w10, w11);
            PG8_WAIT_V(8); PG8_WAIT_L(0); PG8_BAR; PG8_MMA(0, 0, At, B0); PG8_MMA(0, 1, At, B1); PG8_BAR; PG8_SCHED;
            PG8_LDA(At, 1, 1); PG8_STAGEB(PG8_SB(1, 0), b3); PG8_STAGEB(PG8_SB(1, 1), b3 + hstep); PG8_STAGE2(PG8_SA(1, 0), a3, w00, w01);
            PG8_WAIT_V(8); PG8_WAIT_L(0); PG8_BAR; PG8_MMA(1, 0, At, B0); PG8_MMA(1, 1, At, B1); PG8_BAR; PG8_SCHED;
        }
        if (wr == 0) PG8_BAR;
        if (g.pts) { const unsigned long long _n = __builtin_amdgcn_s_memrealtime(); g.pts[33 + 16] += _n - _gt; _gt = _n; }
        E.epilogue(cur, acc, wr, wc, fr, fq);
        const bool keep = E.keep(cur);
        if (g.pts) { const unsigned long long _n = __builtin_amdgcn_s_memrealtime(); g.pts[33 + 18] += _n - _gt; _gt = _n; }
        if (!has_next) break;
        if (!keep) {
#pragma unroll
            for (int a = 0; a < 2; ++a)
#pragma unroll
                for (int b = 0; b < 2; ++b)
#pragma unroll
                    for (int m = 0; m < 4; ++m)
#pragma unroll
                        for (int n = 0; n < 2; ++n) acc[a][b][m][n] = (f32x4){0.f, 0.f, 0.f, 0.f};
        }
        cur = nxt; cA = nA; cB = nB; vc00 = vn00; vc01 = vn01; vc10 = vn10; vc11 = vn11; ++ui;
        if (wr == 1) PG8_BAR;
    }
    PG8_WAIT_V(0);
    PG8_BAR;
#undef PG8_SA
#undef PG8_SB
#undef PG8_STAGE2
#undef PG8_STAGEB
#undef PG8_LDA
#undef PG8_LDB
#undef PG8_MMA
#undef PG8_WAIT_V
#undef PG8_WAIT_L
#undef PG8_BAR
#undef PG8_SCHED
}
}

#define EPI_DEFAULT DI void epilogue(const pg8::Unit& u, f32x4 (&acc)[2][2][4][2], int wr, int wc, int fr, int fq) const { pg8::epi_drive(*this, u, acc, wr, wc, fr, fq); }
struct FProj {
    DI bool keep(const pg8::Unit&) const { return false; }
    EPI_DEFAULT
    bf16_t* zw; bf16_t* vs; bf16_t* g;
    DI void operator()(const pg8::Unit&, int row, int col, f32x4& v0, f32x4& v1) const {
        if (col < 512) store8bf(zw + (size_t)row * 512 + col, v0, v1);
        else if (col < 1024) { const int c0 = col - 512; store8bf(vs + ((size_t)(c0 >> 4) * T + row) * 16 + (c0 & 15), v0, v1); }
        else {
            const int ch = (col - 1024) >> 1; float r[4], g2[4];
#pragma unroll
            for (int j = 0; j < 4; ++j) { const float ea = fminf(__expf(-v0[j]), 1e18f), eb = fminf(__expf(-v1[j]), 1e18f); g2[j] = __builtin_amdgcn_rcpf(1.f + eb); r[j] = (1.f + eb) * __builtin_amdgcn_rcpf(1.f + ea); }
            u32x2 wr_, wg; wr_.x = pk2(r[0], r[1]); wr_.y = pk2(r[2], r[3]); wg.x = pk2(g2[0], g2[1]); wg.y = pk2(g2[2], g2[3]);
            *(u32x2*)(g + (size_t)row * 1024 + ch) = wr_; *(u32x2*)(g + (size_t)T * 1024 + (size_t)row * 1024 + ch) = wg;
        }
    }
};
struct FKV {
    DI bool keep(const pg8::Unit&) const { return false; }
    EPI_DEFAULT
    bf16_t* kf; bf16_t* vf;
    DI void operator()(const pg8::Unit&, int row, int col, f32x4& v0, f32x4& v1) const {
        const int b = row >> 8, key = row & 255;
        if (col < 1024) {
            const int h = col >> 8, dim = col & 255;
            store8bf(kf + ((size_t)((((b * 4 + h) * 8 + (key >> 5)) * 16 + (dim >> 4)) * 64 + ((dim >> 3) & 1) * 32 + (key & 31))) * 8, v0, v1);
        } else store8bf(vf + (size_t)row * 1024 + (col - 1024), v0, v1);
    }
};
struct FGlu {
    DI bool keep(const pg8::Unit&) const { return false; }
    const bf16_t* yg; const float* bias; bf16_t* ys2;
    typedef u32x4 Opnd;
    DI Opnd load(const pg8::Unit&, int row, int col) const { return *(const u32x4*)(yg + (size_t)row * 512 + col); }
    DI void apply(const pg8::Unit&, int row, int col, const Opnd& o, f32x4& v0, f32x4& v1) const {
        f32x4 a, b; a[0] = bf2f(o.x & 0xffffu); a[1] = bf2f(o.x >> 16); a[2] = bf2f(o.y & 0xffffu); a[3] = bf2f(o.y >> 16); b[0] = bf2f(o.z & 0xffffu); b[1] = bf2f(o.z >> 16); b[2] = bf2f(o.w & 0xffffu); b[3] = bf2f(o.w >> 16);
        const f32x4 b0 = *(const f32x4*)(bias + col), b1 = *(const f32x4*)(bias + col + 4);
        f32x4 p, q;
#pragma unroll
        for (int j = 0; j < 4; ++j) { p[j] = a[j] * sigm(v0[j] + b0[j]); q[j] = b[j] * sigm(v1[j] + b1[j]); }
        store8bf(ys2 + (size_t)row * 512 + col, p, q);
    }
    DI void epilogue(const pg8::Unit& u, f32x4 (&acc)[2][2][4][2], int wr, int wc, int fr, int fq) const { pg8::epi_drive2(*this, u, acc, wr, wc, fr, fq); }
    DI void operator()(const pg8::Unit& u, int row, int col, f32x4& v0, f32x4& v1) const { apply(u, row, col, load(u, row, col), v0, v1); }
};
struct FBrNaive {
    DI bool keep(const pg8::Unit&) const { return false; }
    const bf16_t* g; float* tmp; bf16_t* mg;
    DI void operator()(const pg8::Unit& u, int row, int col, f32x4& v0, f32x4& v1) const {
        f32x4 g0, g1; load8bf(g + (size_t)row * 2048 + (u.e ? 1024 : 0) + col, g0, g1);
        float* tp = tmp + (size_t)row * 1024 + col;
        if (u.e == 0) { *(f32x4*)tp = g0 * v0; *(f32x4*)(tp + 4) = g1 * v1; }
        else { const f32x4 t0 = *(const f32x4*)tp, t1 = *(const f32x4*)(tp + 4); store8bf(mg + (size_t)row * 1024 + col, t0 + g0 * v0, t1 + g1 * v1); }
    }
};
struct FBrMid { const bf16_t* g;
    DI void operator()(const pg8::Unit&, int row, int col, f32x4& v0, f32x4& v1) const { f32x4 a0, a1; load8bf(g + (size_t)row * 1024 + col, a0, a1); v0 *= a0; v1 *= a1; } };
struct FBrFin { const bf16_t* g; bf16_t* mg;
    typedef u32x4 Opnd;
    DI Opnd load(const pg8::Unit&, int row, int col) const { return *(const u32x4*)(g + (size_t)T * 1024 + (size_t)row * 1024 + col); }
    DI void apply(const pg8::Unit&, int row, int col, const Opnd& o, f32x4& v0, f32x4& v1) const { f32x4 a, b; a[0] = bf2f(o.x & 0xffffu); a[1] = bf2f(o.x >> 16); a[2] = bf2f(o.y & 0xffffu); a[3] = bf2f(o.y >> 16); b[0] = bf2f(o.z & 0xffffu); b[1] = bf2f(o.z >> 16); b[2] = bf2f(o.w & 0xffffu); b[3] = bf2f(o.w >> 16); store8bf(mg + (size_t)row * 1024 + col, v0 * a, v1 * b); }
    DI void operator()(const pg8::Unit& u, int row, int col, f32x4& v0, f32x4& v1) const { apply(u, row, col, load(u, row, col), v0, v1); } };
struct FBr {
    DI bool keep(const pg8::Unit& u) const { return u.e == 0; }
    const bf16_t* g; bf16_t* mg;
    DI void epilogue(const pg8::Unit& u, f32x4 (&acc)[2][2][4][2], int wr, int wc, int fr, int fq) const {
        if (u.e == 0) pg8::epi_drive(FBrMid{g}, u, acc, wr, wc, fr, fq); else pg8::epi_drive2(FBrFin{g, mg}, u, acc, wr, wc, fr, fq);
    }
    DI void operator()(const pg8::Unit& u, int row, int col, f32x4& v0, f32x4& v1) const { if (u.e == 0) FBrMid{g}(u, row, col, v0, v1); else FBrFin{g, mg}(u, row, col, v0, v1); }
};
struct FWout {
    DI bool keep(const pg8::Unit&) const { return false; }
    const float* rmsx; bf16_t* hb; float* ssq8;
    struct Opnd { u32x4 h; float rm; };
    DI Opnd load(const pg8::Unit&, int row, int col) const { Opnd o; o.h = *(const u32x4*)(hb + (size_t)row * 1024 + col); o.rm = rmsx[row]; return o; }
    DI void apply(const pg8::Unit&, int row, int col, const Opnd& o, f32x4& v0, f32x4& v1) const {
        f32x4 a, b; a[0] = bf2f(o.h.x & 0xffffu); a[1] = bf2f(o.h.x >> 16); a[2] = bf2f(o.h.y & 0xffffu); a[3] = bf2f(o.h.y >> 16); b[0] = bf2f(o.h.z & 0xffffu); b[1] = bf2f(o.h.z >> 16); b[2] = bf2f(o.h.w & 0xffffu); b[3] = bf2f(o.h.w >> 16);
        const f32x4 h0 = a * o.rm + v0, h1 = b * o.rm + v1;
        store8bf(hb + (size_t)row * 1024 + col, h0, h1);
        float s = (h0[0] * h0[0] + h0[1] * h0[1]) + (h0[2] * h0[2] + h0[3] * h0[3]) + (h1[0] * h1[0] + h1[1] * h1[1]) + (h1[2] * h1[2] + h1[3] * h1[3]);
        s += __shfl_xor(s, 16); s += __shfl_xor(s, 32);
        ssq8[(size_t)row * 32 + (col >> 5)] = s;
    }
    DI void epilogue(const pg8::Unit& u, f32x4 (&acc)[2][2][4][2], int wr, int wc, int fr, int fq) const { pg8::epi_drive2(*this, u, acc, wr, wc, fr, fq); }
    DI void operator()(const pg8::Unit& u, int row, int col, f32x4& v0, f32x4& v1) const { apply(u, row, col, load(u, row, col), v0, v1); }
};
struct FStoreBf {
    DI bool keep(const pg8::Unit&) const { return false; }
    EPI_DEFAULT
    bf16_t* o;
    DI void operator()(const pg8::Unit&, int row, int col, f32x4& v0, f32x4& v1) const { store8bf(o + (size_t)row * 1024 + col, v0, v1); }
};
struct FWo {
    DI bool keep(const pg8::Unit&) const { return false; }
    EPI_DEFAULT
    bf16_t* hb;
    DI void operator()(const pg8::Unit&, int row, int col, f32x4& v0, f32x4& v1) const {
        const size_t o = (size_t)row * 1024 + col;
        f32x4 a, b; load8bf(hb + o, a, b);
        store8bf(hb + o, a + v0, b + v1);
    }
};
struct FUp {
    DI bool keep(const pg8::Unit&) const { return false; }
    const volatile LAS int* tp; const float* pscale; bf16_t* hid;
    DI void epilogue(const pg8::Unit& u, f32x4 (&acc)[2][2][4][2], int wr, int wc, int fr, int fq) const {
        const int t0 = tp[u.e] * 256, cnt = tp[32 + u.e];
        float sc[2][4];
#pragma unroll
        for (int ai = 0; ai < 2; ++ai)
#pragma unroll
            for (int m = 0; m < 4; ++m) { const int slot = u.pm * 256 + ai * 128 + wr * 64 + m * 16 + fr - t0; sc[ai][m] = pscale[u.e * T + (slot < cnt ? slot : 0)]; }
#pragma unroll
        for (int ai = 0; ai < 2; ++ai)
#pragma unroll
            for (int m = 0; m < 4; ++m) { const int row = u.pm * 256 + ai * 128 + wr * 64 + m * 16 + fr; const bool ok = (row - t0) < cnt; const float s = sc[ai][m];
#pragma unroll
                for (int bj = 0; bj < 2; ++bj) { const int col = u.pn * 256 + bj * 128 + wc * 32 + 8 * fq; const f32x4 v0 = acc[ai][bj][m][0], v1 = acc[ai][bj][m][1];
                    float h[4];
#pragma unroll
                    for (int j = 0; j < 4; ++j) { const float a = v0[j] * s, b = v1[j] * s; h[j] = a * sigm(a) * b; }
                    u32x2 w; w.x = pk2(h[0], h[1]); w.y = pk2(h[2], h[3]);
                    if (ok) *(u32x2*)(hid + (size_t)row * 512 + (col >> 1)) = w; } }
    }
    DI void operator()(const pg8::Unit& u, int row, int col, f32x4& v0, f32x4& v1) const {
        const int slot = row - tp[u.e] * 256, cnt = tp[32 + u.e]; const float s = pscale[u.e * T + (slot < cnt ? slot : 0)];
        float h[4];
#pragma unroll
        for (int j = 0; j < 4; ++j) { const float a = v0[j] * s, b = v1[j] * s; h[j] = a * sigm(a) * b; }
        u32x2 w; w.x = pk2(h[0], h[1]); w.y = pk2(h[2], h[3]);
        if (slot < cnt) *(u32x2*)(hid + (size_t)row * 512 + (col >> 1)) = w;
    }
};
struct FDown {
    DI bool keep(const pg8::Unit&) const { return false; }
    EPI_DEFAULT
    bf16_t* pkr;
    DI void operator()(const pg8::Unit&, int row, int col, f32x4& v0, f32x4& v1) const { store8bf(pkr + (size_t)row * 1024 + col, v0, v1); }
};
enum { E_PROJ = 0, E_KV, E_GLU, E_BR, E_WOUT, E_Q, E_WO, E_UP, E_DOWN, E_BRN };
struct UEpi {
    int id; const volatile LAS int* tp; unsigned char* ws; const float* x; float* out; const float* glub;
    DI void operator()(const pg8::Unit& u, int row, int col, f32x4& v0, f32x4& v1) const {
        switch (id) {
        case E_PROJ: FProj{(bf16_t*)(ws + WS_ZW), (bf16_t*)(ws + WS_VS), (bf16_t*)(ws + WS_G)}(u, row, col, v0, v1); break;
        case E_KV:   FKV{(bf16_t*)(ws + WS_KC), (bf16_t*)(ws + WS_VRM)}(u, row, col, v0, v1); break;
        case E_GLU:  FGlu{(const bf16_t*)(ws + WS_YG), glub, (bf16_t*)(ws + WS_YS2)}(u, row, col, v0, v1); break;
        case E_BR:   FBr{(const bf16_t*)(ws + WS_G), (bf16_t*)(ws + WS_MG)}(u, row, col, v0, v1); break;
        case E_BRN:  FBrNaive{(const bf16_t*)(ws + WS_G), out, (bf16_t*)(ws + WS_MG)}(u, row, col, v0, v1); break;
        case E_WOUT: FWout{(const float*)(ws + WS_RMSX), (bf16_t*)(ws + WS_A), (float*)(ws + WS_SSQ8)}(u, row, col, v0, v1); break;
        case E_Q:    FStoreBf{(bf16_t*)(ws + WS_Q)}(u, row, col, v0, v1); break;
        case E_WO:   FWo{(bf16_t*)(ws + WS_A)}(u, row, col, v0, v1); break;
        case E_UP:   FUp{tp, (const float*)(ws + WS_PSCALE), (bf16_t*)(ws + WS_HID)}(u, row, col, v0, v1); break;
        case E_DOWN: default: FDown{(bf16_t*)(ws + WS_PKR)}(u, row, col, v0, v1); break;
        }
    }
    DI bool keep(const pg8::Unit& u) const { return id == E_BR && u.e == 0; }
    DI UEpi fresh() const { UEpi e = *this; asm volatile("" : "+s"(e.ws), "+s"(e.x), "+s"(e.out), "+s"(e.glub), "+s"(e.id)); return e; }
};

struct Args { const float* in[33]; float* out; unsigned char* ws; int ph_lo, ph_hi, li, pad; };
struct Frame {
    LAS unsigned char* lds; volatile LAS unsigned* MISC; gu32* ctl;
    int tid, lane, wave, vcu, G, bid; unsigned char* ws;
};
typedef __attribute__((address_space(4))) const Args CArgs;
#if defined(__HIP_DEVICE_COMPILE__)
DI Args phase_args(CArgs* p) { asm volatile("" : "+s"(p)); return *p; }
#else
DI Args phase_args(CArgs* p) { return Args{}; }
#endif
DI Frame make_frame(const Args& a, int wave0) {
    Frame F;
    extern __shared__ __attribute__((aligned(16))) unsigned char lds[];
    F.lds = (LAS unsigned char*)lds;
    F.MISC = (volatile LAS unsigned*)(F.lds + MISC_OFF);
    { int w = wave0; asm volatile("" : "+s"(w)); F.tid = w * 64 + lane_id(); }
    F.lane = F.tid & 63; F.wave = __builtin_amdgcn_readfirstlane(F.tid >> 6);
    int bx = blockIdx.x, gx = gridDim.x; asm volatile("" : "+s"(bx), "+s"(gx));
    F.G = gx; F.bid = bx; F.vcu = (F.G % 8 == 0) ? (bx % 8) * (F.G / 8) + bx / 8 : bx;
    F.ws = a.ws; F.ctl = (gu32*)(a.ws + WS_CTL);
    return F;
}
enum { I_X = 0, I_MEM, I_NMIX, I_WIN, I_POOLW, I_POOLS, I_ARE, I_AIM, I_LOGDT, I_BRE, I_BIM, I_CRE, I_CIM, I_SD, I_GLUW, I_GLUB, I_BRP, I_BRS,
       I_WOUT, I_NX, I_NMEM, I_WQ, I_WKV, I_WO, I_NFFN, I_RGW, I_RGB, I_REW, I_REB, I_W1, I_W3, I_W2, I_NFIN };

DI void ssm_tables_item(const Args& a, Frame& F, int g, int p) {
    LAS float* lamr = (LAS float*)(F.lds);
    LAS float* lami = lamr + 17 * 64;
    LAS float* Bbr = lami + 17 * 64;
    LAS float* Bbi = Bbr + 1024;
    LAS float* Cr = Bbi + 1024;
    LAS float* Ci = Cr + 1024;
    const int tid = F.tid;
    __syncthreads();
    {
        const int n = tid & 63, mg = tid >> 6;
        const float dt = expf(a.in[I_LOGDT][g]), ar = a.in[I_ARE][g * 64 + n], ai = a.in[I_AIM][g * 64 + n];
        for (int m = mg; m <= 16; m += 8) { const float mag = expf((float)m * ar * dt); float sn, cs; sincosf((float)m * ai * dt, &sn, &cs); lamr[m * 64 + n] = mag * cs; lami[m * 64 + n] = mag * sn; }
        if (p == 0 && mg == 7) {
            float* nu = (float*)(F.ws + WS_NU) + g * 128;
            const float mag = expf(256.f * ar * dt); float sn, cs; sincosf(256.f * ai * dt, &sn, &cs); nu[n] = mag * cs; nu[64 + n] = mag * sn;
        }
    }
    __syncthreads();
    if (tid < 64) {
        const int n = tid;
        const float ar = a.in[I_ARE][g * 64 + n], ai = a.in[I_AIM][g * 64 + n];
        const float lr = lamr[64 + n], li = lami[64 + n], den = ar * ar + ai * ai, nr = lr - 1.f, ni = li;
        const float fre = (nr * ar + ni * ai) / den, fim = (ni * ar - nr * ai) / den;
        for (int c = 0; c < 16; ++c) {
            const float br = a.in[I_BRE][(size_t)(g * 64 + n) * 16 + c], bi = a.in[I_BIM][(size_t)(g * 64 + n) * 16 + c];
            Bbr[n * 16 + c] = fre * br - fim * bi; Bbi[n * 16 + c] = fre * bi + fim * br;
        }
        if (p == 0) { float* mu = (float*)(F.ws + WS_MU) + g * 128; mu[n] = lamr[16 * 64 + n]; mu[64 + n] = lami[16 * 64 + n]; }
    }
    for (int e = tid; e < 1024; e += 512) { Cr[e] = a.in[I_CRE][(size_t)g * 1024 + e]; Ci[e] = a.in[I_CIM][(size_t)g * 1024 + e]; }
    __syncthreads();
    bf16_t* wsa = (bf16_t*)(F.ws + WS_WSA); bf16_t* tda = (bf16_t*)(F.ws + WS_TDA); bf16_t* woa = (bf16_t*)(F.ws + WS_WOA);
    {
        const int nt = p;
        for (int e = tid; e < 4096; e += 512) {
            const int ks = e >> 9, l = (e >> 3) & 63, jj = e & 7, r = l & 15, q = l >> 4, npr = 16 * nt + r, n = npr & 63, i = 2 * ks + (q >> 1), cp = 8 * (q & 1) + jj, m = 15 - i;
            const float zr = lamr[m * 64 + n] * Bbr[n * 16 + cp] - lami[m * 64 + n] * Bbi[n * 16 + cp], zi = lamr[m * 64 + n] * Bbi[n * 16 + cp] + lami[m * 64 + n] * Bbr[n * 16 + cp];
            wsa[((size_t)(g * 8 + nt) * 8 + ks) * 512 + l * 8 + jj] = (bf16_t)f2bf(npr < 64 ? zr : zi);
        }
    }
    {
        for (int e = tid; e < 4096; e += 512) {
            const int i = 2 * p + (e >> 11), s = (e >> 9) & 3, l = (e >> 3) & 63, jj = e & 7, cc = l & 15, q = l >> 4;
            const int npr = 32 * s + (jj < 4 ? 4 * q + jj : 16 + 4 * q + jj - 4), n = npr & 63, m = i + 1;
            const float zr = Cr[cc * 64 + n] * lamr[m * 64 + n] - Ci[cc * 64 + n] * lami[m * 64 + n], zi = Cr[cc * 64 + n] * lami[m * 64 + n] + Ci[cc * 64 + n] * lamr[m * 64 + n];
            woa[((size_t)(g * 16 + i) * 4 + s) * 512 + l * 8 + jj] = (bf16_t)f2bf(npr < 64 ? zr : -zi);
        }
    }
    {
        for (int e = tid; e < 1024; e += 512) {
            const int d = 2 * p + (e >> 9), l = (e >> 3) & 63, jj = e & 7, cc = l & 15, q = l >> 4, kk = q >> 1, cp = 8 * (q & 1) + jj, m = d - kk;
            float acc = 0.f;
            if (m >= 0) {
                for (int n = 0; n < 64; ++n) {
                    const float tr = lamr[m * 64 + n] * Bbr[n * 16 + cp] - lami[m * 64 + n] * Bbi[n * 16 + cp], ti = lamr[m * 64 + n] * Bbi[n * 16 + cp] + lami[m * 64 + n] * Bbr[n * 16 + cp];
                    acc += Cr[cc * 64 + n] * tr - Ci[cc * 64 + n] * ti;
                }
                if (m == 0 && cc == cp) acc += a.in[I_SD][g * 16 + cc];
            }
            tda[((size_t)g * 16 + d) * 512 + l * 8 + jj] = (bf16_t)f2bf(acc);
        }
    }
}
template <int D_> DI float row_shr(float x) { return __int_as_float(__builtin_amdgcn_update_dpp(0, __float_as_int(x), 0x110 + D_, 0xf, 0xf, true)); }
template <int D_> DI void ssm_scan_step(f32x4 (&zr)[4], f32x4 (&zi)[4], f32x4 (&mr)[4], f32x4 (&mi)[4]) {
#pragma unroll
    for (int nt = 0; nt < 4; ++nt)
#pragma unroll
        for (int r = 0; r < 4; ++r) {
            const float sr = row_shr<D_>(zr[nt][r]), si = row_shr<D_>(zi[nt][r]);
            zr[nt][r] += mr[nt][r] * sr - mi[nt][r] * si; zi[nt][r] += mr[nt][r] * si + mi[nt][r] * sr;
            const float a2 = mr[nt][r] * mr[nt][r] - mi[nt][r] * mi[nt][r], b2 = 2.f * mr[nt][r] * mi[nt][r]; mr[nt][r] = a2; mi[nt][r] = b2;
        }
}
DI bf16x8 pack8(const f32x4& a, const f32x4& b) { u32x4 w; w.x = pk2(a[0], a[1]); w.y = pk2(a[2], a[3]); w.z = pk2(b[0], b[1]); w.w = pk2(b[2], b[3]); return __builtin_bit_cast(bf16x8, w); }
template <bool OUT>
DI void ssm_pass(Frame& F) {
    const bf16_t* vs = (const bf16_t*)(F.ws + WS_VS); bf16_t* yg = (bf16_t*)(F.ws + WS_YG);
    float* E = (float*)(F.ws + WS_SLOC); const float* MU = (const float*)(F.ws + WS_MU); const float* NU = (const float*)(F.ws + WS_NU);
    const int lane = F.lane, j = lane & 15, q = lane >> 4;
    int staged_g = -1;
    for (int batch = F.vcu; batch < 512; batch += F.G) {
        const int g = batch & 31, tb = batch >> 5, tile = tb * 8 + F.wave;
        PACC_T0(F);
        __syncthreads();
        if (g != staged_g) {
            stage_lds(F.lds + SSM_WS, F.ws + WS_WSA + (size_t)g * 65536, 65536, F.wave, lane);
            if (OUT) { stage_lds(F.lds + SSM_TD, F.ws + WS_TDA + (size_t)g * 16384, 16384, F.wave, lane); stage_lds(F.lds + SSM_WO, F.ws + WS_WOA + (size_t)g * 65536, 65536, F.wave, lane); }
            staged_g = g;
        }
        bf16x8 Bv[8];
        {
            const bf16_t* vb = vs + ((size_t)g * T + (size_t)tile * 256 + 16 * j + (q >> 1)) * 16 + 8 * (q & 1);
#pragma unroll
            for (int ks = 0; ks < 8; ++ks) Bv[ks] = *(const bf16x8*)(vb + ks * 32);
        }
        f32x4 hpr[4], hpi[4];
        if (OUT) {
            const int tq = tile & 31, t0 = tile - tq;
            const float nr = NU[g * 128 + lane], ni = NU[g * 128 + 64 + lane];
            float hr = 0.f, hi = 0.f, pr = 1.f, pi = 0.f;
            float er[31], ei[31];
#pragma unroll
            for (int i = 0; i < 31; ++i) { const int tt = (i < tq) ? (tile - 1 - i) : t0; const float* e = E + ((size_t)tt * 32 + g) * 128; er[i] = e[lane]; ei[i] = e[64 + lane]; }
#pragma unroll
            for (int i = 0; i < 31; ++i) { const float mk = (i < tq) ? 1.f : 0.f; hr += mk * (pr * er[i] - pi * ei[i]); hi += mk * (pr * ei[i] + pi * er[i]); const float a2 = pr * nr - pi * ni, b2 = pr * ni + pi * nr; pr = a2; pi = b2; }
            LAS float* sc = (LAS float*)(F.lds + SSM_SCR + F.wave * 512);
            sc[lane] = hr; sc[64 + lane] = hi;
            LDS_WAIT(); __builtin_amdgcn_wave_barrier();
#pragma unroll
            for (int nt = 0; nt < 4; ++nt) { hpr[nt] = *(const LAS f32x4*)(sc + 16 * nt + 4 * q); hpi[nt] = *(const LAS f32x4*)(sc + 64 + 16 * nt + 4 * q); }
        }
        f32x4 mr[4], mi[4];
#pragma unroll
        for (int nt = 0; nt < 4; ++nt) { mr[nt] = *(const f32x4*)(MU + g * 128 + 16 * nt + 4 * q); mi[nt] = *(const f32x4*)(MU + g * 128 + 64 + 16 * nt + 4 * q); }
        VM_WAIT(); __syncthreads();
        if (OUT) PACC(F, 4);
        f32x4 zr[4], zi[4];
#pragma unroll
        for (int nt = 0; nt < 4; ++nt) { zr[nt] = (f32x4){0.f, 0.f, 0.f, 0.f}; zi[nt] = (f32x4){0.f, 0.f, 0.f, 0.f}; }
#pragma unroll
        for (int nt = 0; nt < 4; ++nt)
#pragma unroll
            for (int ks = 0; ks < 8; ++ks) {
                const bf16x8 ar = *(const LAS bf16x8*)(F.lds + SSM_WS + ((nt * 8 + ks) * 64 + lane) * 16);
                const bf16x8 ai = *(const LAS bf16x8*)(F.lds + SSM_WS + (((nt + 4) * 8 + ks) * 64 + lane) * 16);
                zr[nt] = __builtin_amdgcn_mfma_f32_16x16x32_bf16(ar, Bv[ks], zr[nt], 0, 0, 0);
                zi[nt] = __builtin_amdgcn_mfma_f32_16x16x32_bf16(ai, Bv[ks], zi[nt], 0, 0, 0);
            }
        if (OUT) {
            if (j == 0) {
#pragma unroll
                for (int nt = 0; nt < 4; ++nt)
#pragma unroll
                    for (int r = 0; r < 4; ++r) { zr[nt][r] += mr[nt][r] * hpr[nt][r] - mi[nt][r] * hpi[nt][r]; zi[nt][r] += mr[nt][r] * hpi[nt][r] + mi[nt][r] * hpr[nt][r]; }
            }
        }
        ssm_scan_step<1>(zr, zi, mr, mi); ssm_scan_step<2>(zr, zi, mr, mi); ssm_scan_step<4>(zr, zi, mr, mi); ssm_scan_step<8>(zr, zi, mr, mi);
        if (OUT) PACC(F, 5);
        if (!OUT) {
            if (j == 15) {
                float* e = E + ((size_t)tile * 32 + g) * 128;
#pragma unroll
                for (int nt = 0; nt < 4; ++nt) { *(f32x4*)(e + 16 * nt + 4 * q) = zr[nt]; *(f32x4*)(e + 64 + 16 * nt + 4 * q) = zi[nt]; }
            }
        } else {
            f32x4 h8[8];
#pragma unroll
            for (int nt = 0; nt < 4; ++nt)
#pragma unroll
                for (int r = 0; r < 4; ++r) { const float sr = row_shr<1>(zr[nt][r]), si = row_shr<1>(zi[nt][r]); h8[nt][r] = (j == 0) ? hpr[nt][r] : sr; h8[4 + nt][r] = (j == 0) ? hpi[nt][r] : si; }
            bf16x8 Hb[4];
#pragma unroll
            for (int s = 0; s < 4; ++s) Hb[s] = pack8(h8[2 * s], h8[2 * s + 1]);
            bf16_t* yo = yg + ((size_t)tile * 256 + 16 * j) * 512 + 16 * g + 4 * q;
#pragma unroll
            for (int i = 0; i < 16; ++i) {
                f32x4 c = (f32x4){0.f, 0.f, 0.f, 0.f};
#pragma unroll
                for (int ks = 0; ks <= i / 2; ++ks) c = __builtin_amdgcn_mfma_f32_16x16x32_bf16(*(const LAS bf16x8*)(F.lds + SSM_TD + ((i - 2 * ks) * 64 + lane) * 16), Bv[ks], c, 0, 0, 0);
#pragma unroll
                for (int s = 0; s < 4; ++s) c = __builtin_amdgcn_mfma_f32_16x16x32_bf16(*(const LAS bf16x8*)(F.lds + SSM_WO + ((i * 4 + s) * 64 + lane) * 16), Hb[s], c, 0, 0, 0);
                u32x2 w; w.x = pk2(gelu_tanh(c[0]), gelu_tanh(c[1])); w.y = pk2(gelu_tanh(c[2]), gelu_tanh(c[3]));
                *(u32x2*)(yo + (size_t)i * 512) = w;
            }
            PACC(F, 6);
        }
    }
    __syncthreads();
}

template <class RM>
DI void tr_item(const float* W, int K, int ld, int nblk, bf16_t* WT, const float* kscale, RM rm, LAS float* scr, int item, int lane) {
    const int kb = item / nblk, nb = item % nblk, k0 = 64 * kb, n0 = 64 * nb;
    f32x4 v[16];
#pragma unroll
    for (int i = 0; i < 16; ++i) v[i] = *(const f32x4*)(W + (size_t)(k0 + 4 * i + (lane >> 4)) * ld + n0 + 4 * (lane & 15));
#pragma unroll
    for (int i = 0; i < 16; ++i) { const int kk = 4 * i + (lane >> 4); const float s = kscale ? kscale[k0 + kk] : 1.f; LAS float* d = scr + kk * 65 + 4 * (lane & 15);
        d[0] = v[i].x * s; d[1] = v[i].y * s; d[2] = v[i].z * s; d[3] = v[i].w * s; }
    LDS_WAIT(); asm volatile("" ::: "memory");
    const int c = lane & 7;
#pragma unroll
    for (int j = 0; j < 8; ++j) { const int n = (lane >> 3) + 8 * j; const LAS float* s = scr + (8 * c) * 65 + n;
        u32x4 o; o.x = pk2(s[0 * 65], s[1 * 65]); o.y = pk2(s[2 * 65], s[3 * 65]); o.z = pk2(s[4 * 65], s[5 * 65]); o.w = pk2(s[6 * 65], s[7 * 65]);
        *(u32x4*)(WT + (size_t)rm(n0 + n) * K + k0 + 8 * c) = o; }
    LDS_WAIT(); asm volatile("" ::: "memory");
}
struct RmId { int off; DI int operator()(int n) const { return off + n; } };
struct RmIl { int off; DI int operator()(int n) const { return 8 * (n >> 2) + (n & 3) + off; } };
DI void rms_rows4_to_bf16(const float* x, bf16_t* o, int lane, float* rms0) {
    f32x4 v[4][4]; float s[4];
#pragma unroll
    for (int u = 0; u < 4; ++u)
#pragma unroll
        for (int j = 0; j < 4; ++j) v[u][j] = __builtin_nontemporal_load((const f32x4*)(x + (size_t)u * 1024) + lane + 64 * j);
#pragma unroll
    for (int u = 0; u < 4; ++u) { float t = 0.f;
#pragma unroll
        for (int j = 0; j < 4; ++j) t += (v[u][j].x * v[u][j].x + v[u][j].y * v[u][j].y) + (v[u][j].z * v[u][j].z + v[u][j].w * v[u][j].w);
        s[u] = sqrtf(wave_sum(t) * (1.f / 1024.f) + EPS); }
    if (rms0 && lane == 0) { rms0[0] = s[0]; rms0[1] = s[1]; rms0[2] = s[2]; rms0[3] = s[3]; }
#pragma unroll
    for (int u = 0; u < 4; ++u) { const float r = 1.f / s[u]; u32x2* p = (u32x2*)(o + (size_t)u * 1024) + lane;
#pragma unroll
        for (int j = 0; j < 4; ++j) { u32x2 a; a.x = pk2(v[u][j].x * r, v[u][j].y * r); a.y = pk2(v[u][j].z * r, v[u][j].w * r); p[64 * j] = a; } }
}
DI void fold_item(const Args& a, Frame& F, int g, int kb) {
    LAS float* pwl = (LAS float*)(F.lds); LAS float* wl = pwl + 128 * 128;
    const float* win = a.in[I_WIN]; const float* pw = a.in[I_POOLW] + (size_t)g * 16384;
    __syncthreads();
    for (int i = F.tid; i < 4096; i += 512) *(LAS f32x4*)(pwl + 4 * i) = *(const f32x4*)(pw + 4 * i);
    for (int i = F.tid; i < 2048; i += 512) { const int k = i >> 5, c4 = (i & 31) * 4; *(LAS f32x4*)(wl + k * 128 + c4) = *(const f32x4*)(win + (size_t)(64 * kb + k) * 3072 + g * 128 + c4); }
    __syncthreads();
    const int d = F.tid & 127, kq = F.tid >> 7;
    float acc[16];
#pragma unroll
    for (int j = 0; j < 16; ++j) acc[j] = 0.f;
    for (int c = 0; c < 128; ++c) {
        const float p = pwl[c * 128 + d];
#pragma unroll
        for (int j = 0; j < 16; ++j) acc[j] += wl[(kq * 16 + j) * 128 + c] * p;
    }
    const int n = g * 128 + d, k0 = 64 * kb + kq * 16; const float sc = a.in[I_POOLS][n]; const float* nm = a.in[I_NMIX] + k0;
    bf16_t* o = (bf16_t*)(F.ws + WS_W1T) + (size_t)n * 1024 + k0;
    u32x4 w0, w1;
    w0.x = pk2(acc[0] * sc * nm[0], acc[1] * sc * nm[1]); w0.y = pk2(acc[2] * sc * nm[2], acc[3] * sc * nm[3]); w0.z = pk2(acc[4] * sc * nm[4], acc[5] * sc * nm[5]); w0.w = pk2(acc[6] * sc * nm[6], acc[7] * sc * nm[7]);
    w1.x = pk2(acc[8] * sc * nm[8], acc[9] * sc * nm[9]); w1.y = pk2(acc[10] * sc * nm[10], acc[11] * sc * nm[11]); w1.z = pk2(acc[12] * sc * nm[12], acc[13] * sc * nm[13]); w1.w = pk2(acc[14] * sc * nm[14], acc[15] * sc * nm[15]);
    *(u32x4*)o = w0; *(u32x4*)(o + 8) = w1;
}
DI void p0_prologue(const Args& a, Frame& F) {
    unsigned char* ws = F.ws;
    const int gw = F.vcu * NWAVES + F.wave, NGW = F.G * NWAVES, lane = F.lane;
    for (int it = F.vcu; it < 64; it += F.G) fold_item(a, F, it >> 4, it & 15);
    __syncthreads();
    LAS float* scr = (LAS float*)(F.lds + F.wave * 16640);
    constexpr int IA = 16 * 8;
    constexpr int IB = IA + 16 * 16;
    constexpr int I0 = IB + 16 * 16;
    constexpr int I1 = I0 + 8 * 8;
    constexpr int I2 = I1 + 8 * 16;
    constexpr int I3 = I2 + 8 * 16;
    constexpr int I4 = I3 + 16 * 16;
    constexpr int I5 = I4 + 16 * 16;
    constexpr int I6 = I5 + 16 * 32;
    constexpr int I7 = I6 + 16 * 16;
    constexpr int I8 = I7 + 16 * 128;
    constexpr int I9 = I8 + 16 * 128;
    constexpr int I10 = I9 + 16 * 128;
    for (int it = gw; it < I7; it += NGW) {
        if (it < IA) tr_item(a.in[I_WIN] + 512, 1024, 3072, 8, (bf16_t*)(ws + WS_W1T), a.in[I_NMIX], RmId{512}, scr, it, lane);
        else if (it < IB) tr_item(a.in[I_WIN] + 1024, 1024, 3072, 16, (bf16_t*)(ws + WS_W1T), a.in[I_NMIX], RmIl{1024}, scr, it - IA, lane);
        else if (it < I0) tr_item(a.in[I_WIN] + 2048, 1024, 3072, 16, (bf16_t*)(ws + WS_W1T), a.in[I_NMIX], RmIl{1028}, scr, it - IB, lane);
        else if (it < I1) tr_item(a.in[I_GLUW], 512, 512, 8, (bf16_t*)(ws + WS_WGLU), nullptr, RmId{0}, scr, it - I0, lane);
        else if (it < I2) tr_item(a.in[I_BRP], 512, 1024, 16, (bf16_t*)(ws + WS_WBRP), nullptr, RmId{0}, scr, it - I1, lane);
        else if (it < I3) tr_item(a.in[I_BRS], 512, 1024, 16, (bf16_t*)(ws + WS_WBRS), nullptr, RmId{0}, scr, it - I2, lane);
        else if (it < I4) tr_item(a.in[I_WOUT], 1024, 1024, 16, (bf16_t*)(ws + WS_WOUT), nullptr, RmId{0}, scr, it - I3, lane);
        else if (it < I5) tr_item(a.in[I_WQ], 1024, 1024, 16, (bf16_t*)(ws + WS_WQ), a.in[I_NX], RmId{0}, scr, it - I4, lane);
        else if (it < I6) tr_item(a.in[I_WKV], 1024, 2048, 32, (bf16_t*)(ws + WS_WKV), a.in[I_NMEM], RmId{0}, scr, it - I5, lane);
        else tr_item(a.in[I_WO], 1024, 1024, 16, (bf16_t*)(ws + WS_WO), nullptr, RmId{0}, scr, it - I6, lane);
    }
    (void)I8; (void)I9; (void)I10;
    {
        float* rt = (float*)(ws + WS_RT); const float* nf = a.in[I_NFFN];
        for (int it = F.vcu * 512 + F.tid; it < 32768; it += F.G * 512) {
            const int j = it & 3, l = (it >> 2) & 63, nt = (it >> 8) & 1, i = (it >> 9) & 3, cc = it >> 11, o = 16 * nt + (l & 15), k = 64 * cc + 16 * (l >> 4) + 4 * i + j;
            rt[it] = o < 20 ? nf[k] * (o < 4 ? a.in[I_RGW][k * 4 + o] : a.in[I_REW][k * 16 + (o - 4)]) : 0.f;
        }
    }
    for (int m = 4 * gw; m < T; m += 4 * NGW) rms_rows4_to_bf16(a.in[I_X] + (size_t)m * D, (bf16_t*)(ws + WS_A) + (size_t)m * D, lane, (float*)(ws + WS_RMSX) + m);
    for (int m = 4 * gw; m < MROWS; m += 4 * NGW) rms_rows4_to_bf16(a.in[I_MEM] + (size_t)m * D, (bf16_t*)(ws + WS_MEMN) + (size_t)m * D, lane, nullptr);
}

DI void p2_pool(Frame& F) {
    const bf16_t* zw = (const bf16_t*)(F.ws + WS_ZW); bf16_t* yp = (bf16_t*)(F.ws + WS_YP);
    for (int it = F.vcu * 512 + F.tid; it < (T / 16) * 64; it += F.G * 512) {
        const int t0 = (it >> 6) * 16, ch = (it & 63) * 8, s0 = t0 & (SEQ - 1), w = 2 << (ch >> 7);
        const bf16_t* zc = zw + ch;
        f32x4 a0 = {0.f, 0.f, 0.f, 0.f}, a1 = {0.f, 0.f, 0.f, 0.f};
        {
            u32x4 raw[16];
#pragma unroll
            for (int j = 1; j <= 16; ++j) { const int jj = (j <= w && j <= s0) ? j : 0; raw[j - 1] = *(const u32x4*)(zc + (size_t)(t0 - jj) * 512); }
#pragma unroll
            for (int j = 1; j <= 16; ++j) {
                const u32x4 w4 = raw[j - 1]; const float mk = (j <= w && j <= s0) ? 1.f : 0.f;
                a0[0] += mk * bf2f(w4.x & 0xffffu); a0[1] += mk * bf2f(w4.x >> 16); a0[2] += mk * bf2f(w4.y & 0xffffu); a0[3] += mk * bf2f(w4.y >> 16);
                a1[0] += mk * bf2f(w4.z & 0xffffu); a1[1] += mk * bf2f(w4.z >> 16); a1[2] += mk * bf2f(w4.w & 0xffffu); a1[3] += mk * bf2f(w4.w >> 16);
            }
        }
        u32x4 nw[16], od[16];
#pragma unroll
        for (int i = 0; i < 16; ++i) { nw[i] = *(const u32x4*)(zc + (size_t)(t0 + i) * 512);
            const int lv = (s0 + i >= w) ? (t0 + i - w) : t0;
            od[i] = *(const u32x4*)(zc + (size_t)lv * 512); }
#pragma unroll
        for (int i = 0; i < 16; ++i) {
            f32x4 z0, z1, o0, o1;
            z0[0] = bf2f(nw[i].x & 0xffffu); z0[1] = bf2f(nw[i].x >> 16); z0[2] = bf2f(nw[i].y & 0xffffu); z0[3] = bf2f(nw[i].y >> 16);
            z1[0] = bf2f(nw[i].z & 0xffffu); z1[1] = bf2f(nw[i].z >> 16); z1[2] = bf2f(nw[i].w & 0xffffu); z1[3] = bf2f(nw[i].w >> 16);
            o0[0] = bf2f(od[i].x & 0xffffu); o0[1] = bf2f(od[i].x >> 16); o0[2] = bf2f(od[i].y & 0xffffu); o0[3] = bf2f(od[i].y >> 16);
            o1[0] = bf2f(od[i].z & 0xffffu); o1[1] = bf2f(od[i].z >> 16); o1[2] = bf2f(od[i].w & 0xffffu); o1[3] = bf2f(od[i].w >> 16);
            const float mk = (s0 + i >= w) ? 1.f : 0.f;
            a0 += z0 - o0 * mk; a1 += z1 - o1 * mk;
            const int cnt = (s0 + i + 1 < w) ? s0 + i + 1 : w; const float inv = 1.f / (float)cnt;
            store8bf(yp + (size_t)(t0 + i) * 512 + ch, a0 * inv - z0, a1 * inv - z1);
        }
    }
}
DI void p2_ssm_naive(const Args& a, Frame& F) {
    if (F.wave != 0) return;
    const bf16_t* vs = (const bf16_t*)(F.ws + WS_VS); bf16_t* yg = (bf16_t*)(F.ws + WS_YG);
    const int n = F.lane;
    for (int item = F.vcu; item < BATCH * NSG; item += F.G) {
        const int b = item >> 5, g = item & 31;
        const float dt = expf(a.in[I_LOGDT][g]), ar = a.in[I_ARE][g * 64 + n], ai = a.in[I_AIM][g * 64 + n];
        const float mag = expf(ar * dt); float sn, cs; sincosf(ai * dt, &sn, &cs);
        const float lr = mag * cs, li = mag * sn, den = ar * ar + ai * ai, nr = lr - 1.f, ni = li;
        const float fre = (nr * ar + ni * ai) / den, fim = (ni * ar - nr * ai) / den;
        float bbr[16], bbi[16], cr[16], ci[16], dsk[16];
#pragma unroll
        for (int c = 0; c < 16; ++c) {
            const float br = a.in[I_BRE][(size_t)(g * 64 + n) * 16 + c], bi = a.in[I_BIM][(size_t)(g * 64 + n) * 16 + c];
            bbr[c] = fre * br - fim * bi; bbi[c] = fre * bi + fim * br;
            cr[c] = a.in[I_CRE][(size_t)(g * 16 + c) * 64 + n]; ci[c] = a.in[I_CIM][(size_t)(g * 16 + c) * 64 + n];
            dsk[c] = (n == 0) ? a.in[I_SD][g * 16 + c] : 0.f;
        }
        float hr = 0.f, hi = 0.f;
        const int myc = (((n >> 5) & 1) << 3) | (((n >> 4) & 1) << 2) | (((n >> 3) & 1) << 1) | ((n >> 2) & 1);
        for (int s = 0; s < SEQ; ++s) {
            const size_t t = (size_t)b * SEQ + s;
            f32x4 va, vb, vc, vd; load8bf(vs + ((size_t)g * T + t) * 16, va, vb); load8bf(vs + ((size_t)g * T + t) * 16 + 8, vc, vd);
            float v[16];
#pragma unroll
            for (int j = 0; j < 4; ++j) { v[j] = va[j]; v[4 + j] = vb[j]; v[8 + j] = vc[j]; v[12 + j] = vd[j]; }
            float ur = 0.f, ui = 0.f;
#pragma unroll
            for (int c = 0; c < 16; ++c) { ur += bbr[c] * v[c]; ui += bbi[c] * v[c]; }
            const float nhr = lr * hr - li * hi + ur, nhi = lr * hi + li * hr + ui; hr = nhr; hi = nhi;
            float p[16];
#pragma unroll
            for (int c = 0; c < 16; ++c) p[c] = cr[c] * hr - ci[c] * hi + dsk[c] * v[c];
#pragma unroll
            for (int i = 0; i < 8; ++i) { const bool up = (n & 32) != 0; const float keep = up ? p[i + 8] : p[i], send = up ? p[i] : p[i + 8]; p[i] = keep + __shfl_xor(send, 32); }
#pragma unroll
            for (int i = 0; i < 4; ++i) { const bool up = (n & 16) != 0; const float keep = up ? p[i + 4] : p[i], send = up ? p[i] : p[i + 4]; p[i] = keep + __shfl_xor(send, 16); }
#pragma unroll
            for (int i = 0; i < 2; ++i) { const bool up = (n & 8) != 0; const float keep = up ? p[i + 2] : p[i], send = up ? p[i] : p[i + 2]; p[i] = keep + __shfl_xor(send, 8); }
            { const bool up = (n & 4) != 0; const float keep = up ? p[1] : p[0], send = up ? p[0] : p[1]; p[0] = keep + __shfl_xor(send, 4); }
            float y = p[0]; y += __shfl_xor(y, 1); y += __shfl_xor(y, 2);
            if ((n & 3) == 0) yg[t * 512 + g * 16 + myc] = (bf16_t)f2bf(gelu_tanh(y));
        }
    }
}


typedef float f32x16 __attribute__((ext_vector_type(16)));
DI void build_vf(Frame& F) {
    const bf16_t* vrm = (const bf16_t*)(F.ws + WS_VRM); bf16_t* vf = (bf16_t*)(F.ws + WS_VT);
    for (int it = F.vcu * 512 + F.tid; it < 16 * 8 * 16 * 64; it += F.G * 512) {
        const int l = it & 63, kk = (it >> 6) & 15, dt = (it >> 10) & 7, bh = it >> 13, b = bh >> 2, h = bh & 3, d = 32 * dt + (l & 31), hh = l >> 5;
        unsigned short e[8];
#pragma unroll
        for (int jj = 0; jj < 8; ++jj) { const int key = 16 * kk + 8 * (jj >> 2) + 4 * hh + (jj & 3); e[jj] = vrm[(size_t)(b * 256 + key) * 1024 + h * 256 + d]; }
        u32x4 w; w.x = e[0] | ((unsigned)e[1] << 16); w.y = e[2] | ((unsigned)e[3] << 16); w.z = e[4] | ((unsigned)e[5] << 16); w.w = e[6] | ((unsigned)e[7] << 16);
        *(u32x4*)(vf + (size_t)it * 8) = w;
    }
}
DI void attn_unit(Frame& F, const int L) {
    bf16_t* qo = (bf16_t*)(F.ws + WS_Q); const float* ssq8 = (const float*)(F.ws + WS_SSQ8);
    {
        int lane = F.lane; asm volatile("" : "+v"(lane));
        const int c = lane & 31, h2 = lane >> 5;
        const int bh = L >> 5, tq = L & 31, b = bh >> 2, h = bh & 3;
        const size_t trow = (size_t)(b * 32 + tq) * 256 + F.wave * 32 + c;
        __syncthreads();
        stage_lds(F.lds, F.ws + WS_KC + (size_t)bh * 131072, 131072, F.wave, lane);
        float ss = 0.f;
        { const f32x4* sp = (const f32x4*)(ssq8 + trow * 32 + h2 * 16);
#pragma unroll
          for (int i = 0; i < 4; ++i) { const f32x4 t = sp[i]; ss += (t.x + t.y) + (t.z + t.w); } }
        ss += __shfl_xor(ss, 32);
        const float qscale = 0.0625f / sqrtf(ss * (1.f / 1024.f) + EPS);
        const bf16_t* qp = qo + trow * 1024 + h * 256 + 8 * h2;
        bf16x8 Qa[8];
#pragma unroll
        for (int ds = 0; ds < 8; ++ds) Qa[ds] = *(const bf16x8*)(qp + ds * 16);
        VM_WAIT(); __syncthreads();
        f32x16 st[8];
#pragma unroll
        for (int kt = 0; kt < 8; ++kt)
#pragma unroll
            for (int r = 0; r < 16; ++r) st[kt][r] = 0.f;
#pragma unroll
        for (int ds = 0; ds < 16; ++ds) {
            const bf16x8 qv = Qa[ds & 7];
            if (ds < 8) Qa[ds & 7] = *(const bf16x8*)(qp + (ds + 8) * 16);
#pragma unroll
            for (int kt = 0; kt < 8; ++kt)
                st[kt] = __builtin_amdgcn_mfma_f32_32x32x16_bf16(*(const LAS bf16x8*)(F.lds + ((kt * 16 + ds) * 64 + lane) * 16), qv, st[kt], 0, 0, 0);
            __builtin_amdgcn_sched_barrier(0);
        }
        __syncthreads();
        stage_lds(F.lds, F.ws + WS_VT + (size_t)bh * 131072, 131072, F.wave, lane);
        float m = -3.0e38f;
#pragma unroll
        for (int kt = 0; kt < 8; ++kt)
#pragma unroll
            for (int r = 0; r < 16; ++r) { st[kt][r] *= qscale; m = fmaxf(m, st[kt][r]); }
        m = fmaxf(m, __shfl_xor(m, 32));
        float l = 0.f;
#pragma unroll
        for (int kt = 0; kt < 8; ++kt)
#pragma unroll
            for (int r = 0; r < 16; ++r) { const float p = __expf(st[kt][r] - m); st[kt][r] = p; l += p; }
        l += __shfl_xor(l, 32);
        const float il = 1.f / l;
        bf16x8 Pb[16];
#pragma unroll
        for (int kt = 0; kt < 8; ++kt)
#pragma unroll
            for (int s = 0; s < 2; ++s) {
                u32x4 w; w.x = pk2(st[kt][8 * s + 0], st[kt][8 * s + 1]); w.y = pk2(st[kt][8 * s + 2], st[kt][8 * s + 3]); w.z = pk2(st[kt][8 * s + 4], st[kt][8 * s + 5]); w.w = pk2(st[kt][8 * s + 6], st[kt][8 * s + 7]);
                Pb[kt * 2 + s] = __builtin_bit_cast(bf16x8, w);
            }
        VM_WAIT(); __syncthreads();
#pragma unroll
        for (int half = 0; half < 2; ++half) {
            f32x16 oacc[4];
#pragma unroll
            for (int d4 = 0; d4 < 4; ++d4) {
                const int dt = 4 * half + d4;
#pragma unroll
                for (int r = 0; r < 16; ++r) oacc[d4][r] = 0.f;
#pragma unroll
                for (int kk = 0; kk < 16; ++kk)
                    oacc[d4] = __builtin_amdgcn_mfma_f32_32x32x16_bf16(*(const LAS bf16x8*)(F.lds + ((dt * 16 + kk) * 64 + lane) * 16), Pb[kk], oacc[d4], 0, 0, 0);
            }
            __syncthreads();
            LAS unsigned char* ob = F.lds + half * 65536 + F.wave * 8192;
#pragma unroll
            for (int d4 = 0; d4 < 4; ++d4)
#pragma unroll
                for (int g4 = 0; g4 < 4; ++g4) {
                    u32x2 w; w.x = pk2(oacc[d4][4 * g4 + 0] * il, oacc[d4][4 * g4 + 1] * il); w.y = pk2(oacc[d4][4 * g4 + 2] * il, oacc[d4][4 * g4 + 3] * il);
                    *(LAS u32x2*)(ob + c * 256 + (((4 * d4 + g4) ^ (c & 7)) << 4) + 8 * h2) = w;
                }
            LDS_WAIT(); __builtin_amdgcn_wave_barrier();
            bf16_t* op = qo + ((size_t)(b * 32 + tq) * 256 + F.wave * 32 + (lane >> 4)) * 1024 + h * 256 + half * 128 + (lane & 15) * 8;
            asm volatile("" : "+v"(op));
#pragma unroll 4
            for (int j = 0; j < 8; ++j) {
                const int row = 4 * j + (lane >> 4), ch = lane & 15;
                const u32x4 w = *(const LAS u32x4*)(ob + row * 256 + ((ch ^ (row & 7)) << 4));
                *(u32x4*)(op + (size_t)j * 4096) = w;
            }
        }
    }
}

DI void p9_router(const Args& a, Frame& F) {
    const bf16_t* hb = (const bf16_t*)(F.ws + WS_A);
    int* ptok = (int*)(F.ws + WS_PTOK); float* pscale = (float*)(F.ws + WS_PSCALE); int* tslot = (int*)(F.ws + WS_TSLOT); float* tcomb = (float*)(F.ws + WS_TCOMB);
    LAS float* lgw = (LAS float*)(F.lds + 131072 + F.wave * 2048);
    LAS int* rec_e = (LAS int*)(F.lds + 147456);
    LAS float* rec_w = (LAS float*)(F.lds + 147456 + 1024);
    LAS float* rec_s = (LAS float*)(F.lds + 147456 + 2048);
    LAS int* wc = (LAS int*)(F.lds + 147456 + 2560);
    const int lane = F.lane, r = lane & 15, q = lane >> 4;
    __syncthreads();
    stage_lds(F.lds, F.ws + WS_RT, 131072, F.wave, lane);
    VM_WAIT(); __syncthreads();
    for (int chunk = F.vcu; chunk < T / 128; chunk += F.G) {
        {
            const int t0 = chunk * 128 + F.wave * 16;
            const bf16_t* hp = hb + (size_t)(t0 + r) * 1024 + 16 * q;
            f32x4 acc0 = {0.f, 0.f, 0.f, 0.f}, acc1 = {0.f, 0.f, 0.f, 0.f}; float ss = 0.f;
            u32x4 hraw[16][2];
#pragma unroll
            for (int cc = 0; cc < 16; ++cc) { hraw[cc][0] = __builtin_nontemporal_load((const u32x4*)(hp + cc * 64)); hraw[cc][1] = __builtin_nontemporal_load((const u32x4*)(hp + cc * 64 + 8)); }
#pragma unroll
            for (int cc = 0; cc < 16; ++cc) {
                f32x4 av[4];
#pragma unroll
                for (int hh = 0; hh < 2; ++hh) { const u32x4 w4 = hraw[cc][hh];
                    av[2 * hh][0] = bf2f(w4.x & 0xffffu); av[2 * hh][1] = bf2f(w4.x >> 16); av[2 * hh][2] = bf2f(w4.y & 0xffffu); av[2 * hh][3] = bf2f(w4.y >> 16);
                    av[2 * hh + 1][0] = bf2f(w4.z & 0xffffu); av[2 * hh + 1][1] = bf2f(w4.z >> 16); av[2 * hh + 1][2] = bf2f(w4.w & 0xffffu); av[2 * hh + 1][3] = bf2f(w4.w >> 16); }
#pragma unroll
                for (int i = 0; i < 4; ++i) ss += (av[i].x * av[i].x + av[i].y * av[i].y) + (av[i].z * av[i].z + av[i].w * av[i].w);
#pragma unroll
                for (int i = 0; i < 4; ++i) {
                    const f32x4 b0 = *(const LAS f32x4*)(F.lds + (((cc * 4 + i) * 2 + 0) * 64 + lane) * 16), b1 = *(const LAS f32x4*)(F.lds + (((cc * 4 + i) * 2 + 1) * 64 + lane) * 16);
#pragma unroll
                    for (int j = 0; j < 4; ++j) { acc0 = __builtin_amdgcn_mfma_f32_16x16x4f32(av[i][j], b0[j], acc0, 0, 0, 0); acc1 = __builtin_amdgcn_mfma_f32_16x16x4f32(av[i][j], b1[j], acc1, 0, 0, 0); }
                }
            }
            ss += __shfl_xor(ss, 16); ss += __shfl_xor(ss, 32);
            const float inv = 1.f / sqrtf(ss * (1.f / 1024.f) + EPS);
#pragma unroll
            for (int g2 = 0; g2 < 4; ++g2) { lgw[(4 * q + g2) * 32 + r] = acc0[g2]; lgw[(4 * q + g2) * 32 + 16 + r] = acc1[g2]; }
            LDS_WAIT(); __builtin_amdgcn_wave_barrier();
            if (lane < 16) {
                const int lt = F.wave * 16 + lane;
                float lg[20];
#pragma unroll
                for (int o = 0; o < 20; ++o) lg[o] = lgw[lane * 32 + o] * inv;
                float rgb[4], reb[16];
#pragma unroll
                for (int j = 0; j < 4; ++j) rgb[j] = a.in[I_RGB][j];
#pragma unroll
                for (int j = 0; j < 16; ++j) reb[j] = a.in[I_REB][j];
#pragma unroll
                for (int j = 0; j < 16; ++j) asm volatile("" : "+v"(reb[j]));
                float gl[4]; int gi = 0;
#pragma unroll
                for (int j = 0; j < 4; ++j) gl[j] = lg[j] + rgb[j];
                float gm = gl[0];
#pragma unroll
                for (int j = 1; j < 4; ++j) if (gl[j] > gm) { gm = gl[j]; gi = j; }
                float gs = 0.f;
#pragma unroll
                for (int j = 0; j < 4; ++j) gs += __expf(gl[j] - gm);
                const float gate = 1.f / gs;
                float el[4];
#pragma unroll
                for (int j = 0; j < 4; ++j) {
                    float x = 0.f;
#pragma unroll
                    for (int g2 = 0; g2 < 4; ++g2) x = (gi == g2) ? lg[4 + g2 * 4 + j] + reb[g2 * 4 + j] : x;
                    el[j] = x;
                }
                int i1 = 0; float v1 = el[0];
#pragma unroll
                for (int j = 1; j < 4; ++j) if (el[j] > v1) { v1 = el[j]; i1 = j; }
                int i2 = -1; float v2 = -3.0e38f;
#pragma unroll
                for (int j = 0; j < 4; ++j) if (j != i1 && el[j] > v2) { v2 = el[j]; i2 = j; }
                const float ex = __expf(v2 - v1), w1 = 1.f / (1.f + ex), w2 = ex * w1;
                rec_e[lt * 2 + 0] = gi * 4 + i1; rec_e[lt * 2 + 1] = gi * 4 + i2;
                rec_w[lt * 2 + 0] = w1 * gate; rec_w[lt * 2 + 1] = w2 * gate; rec_s[lt] = inv;
            }
        }
        __syncthreads();
        const int p = F.tid, ep = (p < 256) ? rec_e[p] : -1;
        int myrank = 0;
        {
            const unsigned long long ltmask = (lane == 0) ? 0ull : (~0ull >> (64 - lane));
#pragma unroll
            for (int e = 0; e < 16; ++e) {
                const unsigned long long mk = __ballot(ep == e);
                if (ep == e) myrank = __popcll(mk & ltmask);
                if (lane == e && F.wave < 4) wc[F.wave * 16 + e] = __popcll(mk);
            }
        }
        __syncthreads();
        if (F.tid < 16) {
            const int e = F.tid; const int c0 = wc[e], c1 = wc[16 + e], c2 = wc[32 + e], c3 = wc[48 + e], n = c0 + c1 + c2 + c3;
            int base = 0;
            if (n > 0) base = (int)__hip_atomic_fetch_add((unsigned*)(F.ctl + CW_CNT + 64 * e), (unsigned)n, RLX_AGENT);
            wc[e] = base; wc[16 + e] = base + c0; wc[32 + e] = base + c0 + c1; wc[48 + e] = base + c0 + c1 + c2;
        }
        __syncthreads();
        if (p < 256) {
            const int slot = wc[F.wave * 16 + ep] + myrank, t = chunk * 128 + (p >> 1);
            ptok[ep * T + slot] = t; pscale[ep * T + slot] = rec_s[p >> 1];
            tslot[chunk * 256 + p] = (ep << 16) | slot; tcomb[chunk * 256 + p] = rec_w[p];
        }
        __syncthreads();
    }
}
DI void moe_prefix(Frame& F) {
    volatile LAS int* tp = (volatile LAS int*)(F.lds + XTAB_OFF);
    __syncthreads();
    if (F.tid < 64) {
        const int e = F.tid & 15;
        const int c = (int)__hip_atomic_load((unsigned*)(F.ctl + CW_CNT + 64 * e), RLX_AGENT);
        const int t = (c + 255) >> 8;
        int inc = t;
#pragma unroll
        for (int d = 1; d < 16; d <<= 1) { const int o = __shfl_up(inc, d, 16); if ((F.tid & 15) >= d) inc += o; }
        if (F.tid < 16) { tp[e] = inc - t; tp[32 + e] = c; if (e == 15) tp[16] = inc; }
    }
    __syncthreads();
}
DI void p12_final(const Args& a, Frame& F) {
    const bf16_t* pkr = (const bf16_t*)(F.ws + WS_PKR); const float* nf = a.in[I_NFIN];
    const bf16_t* hb = (const bf16_t*)(F.ws + WS_A); const int* tslot = (const int*)(F.ws + WS_TSLOT); const float* tcomb = (const float*)(F.ws + WS_TCOMB);
    const volatile LAS int* tp = (const volatile LAS int*)(F.lds + XTAB_OFF);
    const int lane = F.lane, gw = F.vcu * NWAVES + F.wave, NGW = F.G * NWAVES;
    f32x4 gn[4];
#pragma unroll
    for (int j = 0; j < 4; ++j) gn[j] = *((const f32x4*)nf + lane + 64 * j);
    for (int m0 = 4 * gw; m0 < T; m0 += 4 * NGW) {
        int sl[8]; float cw[8];
        { const int4 s0 = *(const int4*)(tslot + 2 * m0), s1 = *(const int4*)(tslot + 2 * m0 + 4); const f32x4 c0 = *(const f32x4*)(tcomb + 2 * m0), c1 = *(const f32x4*)(tcomb + 2 * m0 + 4);
          sl[0] = s0.x; sl[1] = s0.y; sl[2] = s0.z; sl[3] = s0.w; sl[4] = s1.x; sl[5] = s1.y; sl[6] = s1.z; sl[7] = s1.w;
          cw[0] = c0[0]; cw[1] = c0[1]; cw[2] = c0[2]; cw[3] = c0[3]; cw[4] = c1[0]; cw[5] = c1[1]; cw[6] = c1[2]; cw[7] = c1[3]; }
        u32x2 hq[4][4], p[4][4], r[4][4];
#pragma unroll
        for (int u = 0; u < 4; ++u) {
            const size_t m = (size_t)(m0 + u);
            const size_t r0 = (size_t)(tp[sl[2 * u] >> 16] * 256 + (sl[2 * u] & 0xffff)), r1 = (size_t)(tp[sl[2 * u + 1] >> 16] * 256 + (sl[2 * u + 1] & 0xffff));
#pragma unroll
            for (int j = 0; j < 4; ++j) { hq[u][j] = __builtin_nontemporal_load((const u32x2*)(hb + m * 1024) + lane + 64 * j);
                p[u][j] = __builtin_nontemporal_load((const u32x2*)(pkr + r0 * 1024) + lane + 64 * j); r[u][j] = __builtin_nontemporal_load((const u32x2*)(pkr + r1 * 1024) + lane + 64 * j); }
        }
#pragma unroll
        for (int u = 0; u < 4; ++u) {
            const float c0 = cw[2 * u], c1 = cw[2 * u + 1];
            f32x4 v[4]; float ss = 0.f;
#pragma unroll
            for (int j = 0; j < 4; ++j) {
                v[j].x = bf2f(hq[u][j].x & 0xffffu) + c0 * bf2f(p[u][j].x & 0xffffu) + c1 * bf2f(r[u][j].x & 0xffffu); v[j].y = bf2f(hq[u][j].x >> 16) + c0 * bf2f(p[u][j].x >> 16) + c1 * bf2f(r[u][j].x >> 16);
                v[j].z = bf2f(hq[u][j].y & 0xffffu) + c0 * bf2f(p[u][j].y & 0xffffu) + c1 * bf2f(r[u][j].y & 0xffffu); v[j].w = bf2f(hq[u][j].y >> 16) + c0 * bf2f(p[u][j].y >> 16) + c1 * bf2f(r[u][j].y >> 16);
                ss += (v[j].x * v[j].x + v[j].y * v[j].y) + (v[j].z * v[j].z + v[j].w * v[j].w);
            }
            const float inv = 1.f / sqrtf(wave_sum(ss) * (1.f / 1024.f) + EPS);
            f32x4* hr = (f32x4*)(a.out + (size_t)(m0 + u) * 1024) + lane;
#pragma unroll
            for (int j = 0; j < 4; ++j) __builtin_nontemporal_store(v[j] * inv * gn[j], hr + 64 * j);
        }
    }
#if PROBE_ON
    if (F.bid == 0 && F.tid == 0) {
        unsigned long long* ts = (unsigned long long*)(F.ws + WS_TS);
        asm volatile("s_waitcnt vmcnt(0)" ::: "memory"); ts[15] = __builtin_amdgcn_s_memrealtime();
#if PROBE_HI == 998
        const unsigned long long d = 4ull * ts[512 + PROBE_LO], t0 = __builtin_amdgcn_s_memrealtime();
#elif PROBE_HI == 999
        unsigned long long mx = 0ull, mn = ~0ull; for (int i = 0; i < F.G; ++i) { const unsigned long long v = ts[128 + i]; mx = v > mx ? v : mx; mn = v < mn ? v : mn; }
        const unsigned long long d = 4ull * (PROBE_LO == 0 ? mx : mn), t0 = __builtin_amdgcn_s_memrealtime();
#else
        const unsigned long long d = 4ull * (ts[PROBE_HI] - ts[PROBE_LO]), t0 = __builtin_amdgcn_s_memrealtime();
#endif
        while (__builtin_amdgcn_s_memrealtime() - t0 < d) __builtin_amdgcn_s_sleep(8);
    }
#endif
}

DI void late_ssm_tables(const Args& a, Frame& F) {
    const int skip = (F.G > 64) ? 32 : 0;
    if (F.bid < skip) return;
    for (int it = F.bid - skip; it < 256; it += F.G - skip) ssm_tables_item(a, F, it >> 3, it & 7);
}
constexpr int W13_EARLY = 1792;
DI void w13_item(const Args& a, Frame& F, int it, LAS float* scr) {
    unsigned char* ws = F.ws; const int r = it & 2047, e = r >> 7;
    if (it < 2048) tr_item(a.in[I_W1] + (size_t)e * 1024 * 512, 1024, 512, 8, (bf16_t*)(ws + WS_W13) + (size_t)e * 1024 * 1024, a.in[I_NFFN], RmIl{0}, scr, r & 127, F.lane);
    else tr_item(a.in[I_W3] + (size_t)e * 1024 * 512, 1024, 512, 8, (bf16_t*)(ws + WS_W13) + (size_t)e * 1024 * 1024, a.in[I_NFFN], RmIl{4}, scr, r & 127, F.lane);
}
DI void early_w13(const Args& a, Frame& F) {
    const int skip = (F.G > 64) ? 32 : 0;
    if (F.bid < skip) return;
    LAS float* scr = (LAS float*)(F.lds + F.wave * 16640);
    __syncthreads();
    for (int it = (F.bid - skip) * NWAVES + F.wave; it < W13_EARLY; it += (F.G - skip) * NWAVES) w13_item(a, F, it, scr);
}
DI void late_w13(const Args& a, Frame& F) {
    LAS float* scr = (LAS float*)(F.lds + F.wave * 16640);
    __syncthreads();
    for (int it = W13_EARLY + F.vcu * NWAVES + F.wave; it < 2 * 2048; it += F.G * NWAVES) w13_item(a, F, it, scr);
}
DI void late_w2(const Args& a, Frame& F) {
    const volatile LAS int* tp = (const volatile LAS int*)(F.lds + XTAB_OFF);
    const int rem = (tp[16] * 4) % F.G, first = (rem > 0 && rem < F.G - 8) ? rem : 0, nw = F.G - first;
    if (F.vcu < first) return;
    unsigned char* ws = F.ws; LAS float* scr = (LAS float*)(F.lds + F.wave * 16640);
    const int gw = (F.vcu - first) * NWAVES + F.wave, NGW = nw * NWAVES, lane = F.lane;
    __syncthreads();
    for (int it = gw; it < 2048; it += NGW) { const int e = it >> 7;
        tr_item(a.in[I_W2] + (size_t)e * 512 * 1024, 512, 1024, 16, (bf16_t*)(ws + WS_W2T) + (size_t)e * 1024 * 512, nullptr, RmId{0}, scr, it & 127, lane); }
}
constexpr int N_STEPS = 15;
constexpr int GEMM_STEPS = 0x35E6;
#ifndef SKIPMASK
#define SKIPMASK 0
#endif
#ifndef SSM_NAIVE
#define SSM_NAIVE 0
#endif
#ifndef MFMA_MASK
#define MFMA_MASK 0x35E6
#endif
DI bool use_mfma(int s) { return ((MFMA_MASK >> s) & 1) != 0; }
DI bool seam_after(int s) { return s != 1 && s != 9 && s != N_STEPS - 1; }
DI void grid_bar(CArgs* ap, int wave0) {
    const Args a = phase_args(ap);
    extern __shared__ __attribute__((aligned(16))) unsigned char lds[];
    XcdBarrier b; b.bar = (unsigned*)(a.ws + WS_CTL) + CW_BAR; b.x = xb_xcc_id(); b.st = (volatile LAS unsigned*)((LAS unsigned char*)lds + MISC_OFF) + 8;
    xcd_barrier(b, wave0 == 0, lane_id());
}
DI void gemm_step(int s, const Args& a, Frame& F, pg8::Gemm& g, pg8::USched& S, UEpi& E) {
    unsigned char* ws = a.ws;
    const volatile LAS int* tp = (const volatile LAS int*)(F.lds + XTAB_OFF);
    size_t oA = WS_A, oB = WS_W1T, oA2 = 0, oB2 = 0, bstride = 0; int K = 1024, M = T, N = 1024, mode = 0, id = E_PROJ;
    if (s == 1)       { N = INW; }
    else if (s == 2)  { oA = WS_MEMN; oB = WS_WKV; M = MROWS; N = 2048; id = E_KV; }
    else if (s == 5)  { oA = WS_YG; oB = WS_WGLU; K = 512; N = 512; id = E_GLU; }
    else if (s == 6)  { oA = WS_YP; oB = WS_WBRP; oA2 = WS_YS2; oB2 = WS_WBRS; K = 512; mode = 1; id = use_mfma(6) ? E_BR : E_BRN; }
    else if (s == 7)  { oA = WS_MG; oB = WS_WOUT; id = E_WOUT; }
    else if (s == 8)  { oB = WS_WQ; id = E_Q; }
    else if (s == 10) { oA = WS_Q; oB = WS_WO; id = E_WO; }
    else if (s == 12) { oB = WS_W13; bstride = (size_t)1024 * 1024; mode = 2; id = E_UP; }
    else              { oA = WS_HID; oB = WS_W2T; K = 512; bstride = (size_t)1024 * 512; mode = 3; id = E_DOWN; }
    g.pts = (PROBE_ON && s == PROBE_GEMMSTEP && F.bid == 0 && F.tid == 0) ? (unsigned long long*)(ws + 512 * 1024) : nullptr;
    g.A = (const bf16_t*)(ws + oA); g.Bt = (const bf16_t*)(ws + oB); g.K = K; g.A2 = (const bf16_t*)(ws + oA2); g.Bt2 = (const bf16_t*)(ws + oB2); g.bstride = bstride;
    S.mode = mode; S.tp = tp; S.ptok = (const int*)(ws + WS_PTOK); S.nN = 4; S.one_pm = 0; S.one_pn = 0;
    S.so.init(M, N, F.G, mode >= 2 ? F.vcu : F.bid);
    E.id = id; E.tp = tp; E.ws = ws; E.x = a.in[I_X]; E.out = a.out; E.glub = a.in[I_GLUB];
}
DI bool is_gemm_step(int s) { return ((GEMM_STEPS >> s) & 1) != 0; }

template <int S_>
DI void run_step(CArgs* ap, int wave0) {
    const Args a = phase_args(ap); Frame F = make_frame(a, wave0);
    constexpr int s = S_;
    if constexpr (((GEMM_STEPS >> S_) & 1) != 0) {
        if constexpr (S_ >= 12) moe_prefix(F);
        pg8::Gemm g; pg8::USched S; UEpi E;
        gemm_step(s, a, F, g, S, E);
        if constexpr (((MFMA_MASK >> S_) & 1) != 0) {
            unsigned char* ws = a.ws; const volatile LAS int* tp = E.tp; LAS unsigned char* ring = F.lds + RING_OFF; (void)tp;
            if constexpr (S_ == 1)  pg8::gemm_phase<false>(ring, g, S, FProj{(bf16_t*)(ws + WS_ZW), (bf16_t*)(ws + WS_VS), (bf16_t*)(ws + WS_G)}, F.tid);
            if constexpr (S_ == 2)  { pg8::gemm_phase<false>(ring, g, S, FKV{(bf16_t*)(ws + WS_KC), (bf16_t*)(ws + WS_VRM)}, F.tid); late_ssm_tables(a, F); early_w13(a, F); }
            if constexpr (S_ == 5)  pg8::gemm_phase<false>(ring, g, S, FGlu{(const bf16_t*)(ws + WS_YG), a.in[I_GLUB], (bf16_t*)(ws + WS_YS2)}, F.tid);
            if constexpr (S_ == 6)  pg8::gemm_phase<false>(ring, g, S, FBr{(const bf16_t*)(ws + WS_G), (bf16_t*)(ws + WS_MG)}, F.tid);
            if constexpr (S_ == 7)  pg8::gemm_phase<false>(ring, g, S, FWout{(const float*)(ws + WS_RMSX), (bf16_t*)(ws + WS_A), (float*)(ws + WS_SSQ8)}, F.tid);
            if constexpr (S_ == 8) {
                for (int L = F.vcu; L < (T / 256) * XH; L += F.G) {
                    const int bh = L >> 5, tq = L & 31;
                    S.mode = 4; S.one_pm = (bh >> 2) * 32 + tq; S.one_pn = bh & 3;
                    pg8::gemm_phase<false>(ring, g, S, FStoreBf{(bf16_t*)(ws + WS_Q)}, F.tid);
                    attn_unit(F, L);
                }
                __syncthreads();
            }
            if constexpr (S_ == 10) pg8::gemm_phase<false>(ring, g, S, FWo{(bf16_t*)(ws + WS_A)}, F.tid);
            if constexpr (S_ == 12) { pg8::gemm_phase<true>(ring, g, S, FUp{tp, (const float*)(ws + WS_PSCALE), (bf16_t*)(ws + WS_HID)}, F.tid); late_w2(a, F); }
            if constexpr (S_ == 13) pg8::gemm_phase<false>(ring, g, S, FDown{(bf16_t*)(ws + WS_PKR)}, F.tid);
        } else pg8::ngemm_phase(F.lds + RING_OFF, g, S, E, F.tid);
    } else if constexpr (S_ == 0) p0_prologue(a, F);
    else if constexpr (S_ == 3) { build_vf(F); p2_pool(F); if constexpr (SSM_NAIVE) p2_ssm_naive(a, F); else ssm_pass<false>(F); }
    else if constexpr (S_ == 4) { if constexpr (!SSM_NAIVE) ssm_pass<true>(F); }
    else if constexpr (S_ == 9) { }
    else if constexpr (S_ == 11) { p9_router(a, F); late_w13(a, F); }
    else { moe_prefix(F); p12_final(a, F); }
}

__global__ void __launch_bounds__(NWAVES * 64, 2) mk_fwd(Args args) {
    extern __shared__ __attribute__((aligned(16))) unsigned char lds[];
    CArgs* ap = (CArgs*)__builtin_amdgcn_kernarg_segment_ptr();
    const int lo = args.ph_lo, hi = args.ph_hi;
    const int wave0 = __builtin_amdgcn_readfirstlane((int)threadIdx.x >> 6);
    {
        LAS unsigned char* l = (LAS unsigned char*)lds;
        for (int u = wave0 * 64 + lane_id(); u < (LDS_BYTES - LDSCTL_OFF) / 4; u += NWAVES * 64) ((LAS unsigned*)(l + LDSCTL_OFF))[u] = 0u;
        __syncthreads();
        if (!MK_PER_PHASE) (void)xcd_barrier_post((unsigned*)(args.ws + WS_CTL) + CW_BAR, (volatile LAS unsigned*)(l + MISC_OFF) + 8, wave0 == 0 && lane_id() == 0);
    }
#if PROBE_ON
#define STAMP(k) do { if (blockIdx.x == 0 && wave0 == 0 && lane_id() == 0) ((unsigned long long*)(args.ws + WS_TS))[k] = __builtin_amdgcn_s_memrealtime(); } while (0)
#else
#define STAMP(k) do { } while (0)
#endif
#define STEP(k) do { if (lo <= (k) && (k) < hi) { STAMP(k); if (PROBE_ON && (k) == 14) { asm volatile("s_waitcnt vmcnt(0)" ::: "memory"); grid_bar(ap, wave0); } run_step<k>(ap, wave0); if (!MK_PER_PHASE && (k) + 1 < hi && seam_after(k)) { if (PROBE_ON && (k) == PROBE_BARSTEP) { const unsigned long long _b0 = __builtin_amdgcn_s_memrealtime(); grid_bar(ap, wave0); if (wave0 == 0 && lane_id() == 0) ((unsigned long long*)(args.ws + WS_TS))[128 + blockIdx.x] = __builtin_amdgcn_s_memrealtime() - _b0; } else grid_bar(ap, wave0); } } } while (0)
    STEP(0); STEP(1); STEP(2); STEP(3); STEP(4); STEP(5); STEP(6); STEP(7); STEP(8); STEP(9); STEP(10); STEP(11); STEP(12); STEP(13); STEP(14);
#undef STEP
}

extern "C" void kernel_launch(void* const* d_in, const int* in_sizes, int n_in, void* d_out, int out_size, void* d_ws, size_t ws_size, hipStream_t stream) {
    static int grid = 0;
    if (grid == 0) {
        if (n_in != 33 || in_sizes[0] != T * D || out_size != T * D || ws_size < WS_END) {
            fprintf(stderr, "kernel_launch: shape/workspace mismatch (n_in %d, in0 %d, out %d, ws %zu, need %zu); nothing launched\n", n_in, n_in > 0 ? in_sizes[0] : -1, out_size, ws_size, (size_t)WS_END); grid = -1; return; }
        int dev = 0, cus = 0, per_cu = 0;
        if (hipGetDevice(&dev) != hipSuccess || hipDeviceGetAttribute(&cus, hipDeviceAttributeMultiprocessorCount, dev) != hipSuccess) { fprintf(stderr, "kernel_launch: device query failed\n"); grid = -1; return; }
        if (hipFuncSetAttribute((const void*)mk_fwd, hipFuncAttributeMaxDynamicSharedMemorySize, LDS_BYTES) != hipSuccess) { fprintf(stderr, "kernel_launch: hipFuncSetAttribute failed\n"); grid = -1; return; }
        if (hipOccupancyMaxActiveBlocksPerMultiprocessor(&per_cu, (const void*)mk_fwd, NWAVES * 64, LDS_BYTES) != hipSuccess || per_cu < 1) {
            fprintf(stderr, "kernel_launch: occupancy query reports %d workgroups per CU; nothing launched\n", per_cu); (void)hipGetLastError(); grid = -1; return; }
        grid = cus;
    }
    if (grid < 0) return;
    if (hipMemsetAsync((char*)d_ws + WS_CTL, 0, CTL_ZERO_BYTES, stream) != hipSuccess) { fprintf(stderr, "kernel_launch: memset failed\n"); return; }
    Args a{};
    for (int i = 0; i < 33; ++i) a.in[i] = (const float*)d_in[i];
    a.out = (float*)d_out; a.ws = (unsigned char*)d_ws;
    const int cuts[] = {0, 1, 3, 4, 5, 6, 7, 8, 9, 10, 11, 12, 13, 14, 15};
    const int nl = MK_PER_PHASE ? 14 : 1;
    for (int li = 0; li < nl; ++li) {
        a.ph_lo = MK_PER_PHASE ? cuts[li] : 0; a.ph_hi = MK_PER_PHASE ? cuts[li + 1] : N_STEPS; a.li = li;
        hipLaunchKernelGGL(mk_fwd, dim3(grid), dim3(NWAVES * 64), LDS_BYTES, stream, a);
        const hipError_t le = hipPeekAtLastError();
        if (le != hipSuccess) { fprintf(stderr, "kernel_launch: launch %d failed: %s\n", li, hipGetErrorName(le)); break; }
    }
}
```

```cpp
#include <hip/hip_runtime.h>
#include <cstdio>
#include <cstdint>

#define GAS __attribute__((address_space(1)))
#define LAS __attribute__((address_space(3)))
typedef unsigned short bf16_t;
typedef float f32x4 __attribute__((ext_vector_type(4)));
typedef float f32x2 __attribute__((ext_vector_type(2)));
typedef unsigned u32x4 __attribute__((ext_vector_type(4)));
typedef unsigned u32x2 __attribute__((ext_vector_type(2)));
typedef short bf16x8 __attribute__((ext_vector_type(8)));
typedef GAS unsigned gu32;
#define RLX_AGENT __ATOMIC_RELAXED, __HIP_MEMORY_SCOPE_AGENT
#define LDS_WAIT() asm volatile("s_waitcnt lgkmcnt(0)" ::: "memory")
#define VM_WAIT() asm volatile("s_waitcnt vmcnt(0)" ::: "memory")
#define DI __device__ __forceinline__

#ifndef MK_PER_PHASE
#define MK_PER_PHASE 0
#endif

#ifndef PROBE_LO
#define PROBE_LO -1
#endif
#ifndef PROBE_HI
#define PROBE_HI -1
#endif
#define PROBE_ON (PROBE_LO >= 0)
#ifndef PROBE_BARSTEP
#define PROBE_BARSTEP -1
#endif
#ifndef PROBE_GEMMSTEP
#define PROBE_GEMMSTEP -1
#endif
#if PROBE_LO >= 0
#define PACC_T0(F) unsigned long long _pt0 = ((F).bid == 0 && (F).tid == 0) ? __builtin_amdgcn_s_memrealtime() : 0ull
#define PACC(F, k) do { if ((F).bid == 0 && (F).tid == 0) { const unsigned long long _n = __builtin_amdgcn_s_memrealtime(); ((unsigned long long*)((F).ws + 512 * 1024))[33 + 2 * (k)] += _n - _pt0; _pt0 = _n; } } while (0)
#else
#define PACC_T0(F) do { } while (0)
#define PACC(F, k) do { } while (0)
#endif
constexpr size_t WS_TS = 512 * 1024;

constexpr int BATCH = 4, SEQ = 8192, D = 1024, T = BATCH * SEQ;
constexpr int PW = 512, SW = 512, NSG = 32, GD = 16, NS = 64, INW = 3072;
constexpr int MEM = 256, XH = 4, XHD = 256, MROWS = BATCH * MEM;
constexpr int NE = 16, DE = 512;
constexpr float EPS = 1e-6f;
constexpr int NWAVES = 8;

constexpr size_t MiB = 1u << 20;
constexpr size_t WS_CTL = 0, CTL_ZERO_BYTES = 1 * MiB;
constexpr size_t WS_W1T = 1 * MiB;
constexpr size_t WS_WGLU = 7 * MiB;
constexpr size_t WS_WBRP = WS_WGLU + MiB / 2;
constexpr size_t WS_WBRS = WS_WBRP + MiB;
constexpr size_t WS_WOUT = WS_WBRS + MiB;
constexpr size_t WS_WQ = WS_WOUT + 2 * MiB;
constexpr size_t WS_WKV = WS_WQ + 2 * MiB;
constexpr size_t WS_WO = WS_WKV + 4 * MiB;
constexpr size_t WS_W13 = 20 * MiB;
constexpr size_t WS_W2T = 52 * MiB;
constexpr size_t WS_MEMN = 68 * MiB;
constexpr size_t WS_KC = 70 * MiB;
constexpr size_t WS_VT = 72 * MiB;
constexpr size_t WS_SSMT = 74 * MiB;
constexpr size_t WS_WSA = WS_SSMT;
constexpr size_t WS_TDA = WS_SSMT + 2 * MiB;
constexpr size_t WS_WOA = WS_TDA + MiB / 2;
constexpr size_t WS_MU = WS_WOA + 2 * MiB;
constexpr size_t WS_NU = WS_MU + 16384;
constexpr size_t WS_MUP = WS_NU + 16384;
constexpr size_t WS_RT = 84 * MiB;
constexpr size_t WS_SSQ8 = 85 * MiB;
constexpr size_t WS_PTOK = 101 * MiB;
constexpr size_t WS_PCOMB = 103 * MiB;
constexpr size_t WS_PSCALE = 105 * MiB;
constexpr size_t WS_SLOC = 107 * MiB;
constexpr size_t WS_VRM = 109 * MiB;
constexpr size_t WS_A = 112 * MiB;
constexpr size_t WS_ZW = 176 * MiB;
constexpr size_t WS_VS = 208 * MiB;
constexpr size_t WS_MG = 176 * MiB;
constexpr size_t WS_Q = 176 * MiB;
constexpr size_t WS_G = 240 * MiB;
constexpr size_t WS_PKR = 176 * MiB;
constexpr size_t WS_RMSX = 103 * MiB + 512 * 1024;
constexpr size_t WS_TSLOT = 103 * MiB;
constexpr size_t WS_TCOMB = 104 * MiB;
constexpr size_t WS_YP = 368 * MiB, WS_YG = 400 * MiB, WS_YS2 = 432 * MiB;
constexpr size_t WS_HID = 368 * MiB;
constexpr size_t WS_END = 464 * MiB;
constexpr int CW_TMO = 0, CW_CODE = 1;
constexpr int CW_BAR = 4096;
constexpr int CW_CNT = 16384;

constexpr int RING_OFF = 0, RING_BYTES = 131072;
constexpr int LDS_BYTES = 163840;
constexpr int LDSCTL_OFF = LDS_BYTES - 2048, MISC_OFF = LDSCTL_OFF + 320;
constexpr int XTAB_OFF = LDSCTL_OFF + 512;
constexpr int SSM_WS = 0, SSM_TD = 65536, SSM_WO = 81920, SSM_SCR = 147456;

DI float bf2f(unsigned b) { return __uint_as_float(b << 16); }
DI unsigned f2bf(float f) { unsigned u = __float_as_uint(f); return (u + 0x7fffu + ((u >> 16) & 1u)) >> 16; }
typedef __bf16 bf16x2_t __attribute__((ext_vector_type(2)));
DI unsigned pk2(float lo, float hi) { const f32x2 v = {lo, hi}; const bf16x2_t b = __builtin_convertvector(v, bf16x2_t); return __builtin_bit_cast(unsigned, b); }
DI float sigm(float x) { return __builtin_amdgcn_rcpf(1.f + __expf(-x)); }
DI float gelu_tanh(float x) { return x * sigm(1.5957691216057308f * (x + 0.044715f * x * x * x)); }
DI int lane_id() { int l; asm volatile("v_mbcnt_lo_u32_b32 %0, -1, 0\n\tv_mbcnt_hi_u32_b32 %0, -1, %0" : "=&v"(l)); return l; }
DI float wave_sum(float v) {
#pragma unroll
    for (int o = 1; o < 64; o <<= 1) v += __shfl_xor(v, o);
    return v;
}
DI float wave_max(float v) {
#pragma unroll
    for (int o = 1; o < 64; o <<= 1) v = fmaxf(v, __shfl_xor(v, o));
    return v;
}
DI void store8bf(bf16_t* p, const f32x4& a, const f32x4& b) {
    u32x4 w; w.x = pk2(a[0], a[1]); w.y = pk2(a[2], a[3]); w.z = pk2(b[0], b[1]); w.w = pk2(b[2], b[3]);
    *(u32x4*)p = w;
}
DI void load8bf(const bf16_t* p, f32x4& a, f32x4& b) {
    const u32x4 w = *(const u32x4*)p;
    a[0] = bf2f(w.x & 0xffffu); a[1] = bf2f(w.x >> 16); a[2] = bf2f(w.y & 0xffffu); a[3] = bf2f(w.y >> 16);
    b[0] = bf2f(w.z & 0xffffu); b[1] = bf2f(w.z >> 16); b[2] = bf2f(w.w & 0xffffu); b[3] = bf2f(w.w >> 16);
}

#define XB_TMO      128
#define XB_XCNT(j)  (256  + 64 * (j))
#define XB_XSUB(j)  (1280 + 64 * (j))
#define XB_XGEN(j)  (2304 + 64 * (j))
#define XB_TOP      3328
#define XB_TOPGEN   3392
#define XB_LSUB(j)  (3456 + 64 * (j))
#define XB_LGEN(j)  (4480 + 64 * (j))
#define XB_VOTE     5504
#define XB_W2CNT    5568
#define XCD_BAR_WORDS 5632
#define XB_PAN      16384
#define XB_SPIN_CAP (1u << 18)
DI unsigned xb_ld(unsigned* p)              { return __hip_atomic_load(p, __ATOMIC_RELAXED, __HIP_MEMORY_SCOPE_AGENT); }
DI unsigned xb_add(unsigned* p, unsigned v) { return __hip_atomic_fetch_add(p, v, __ATOMIC_RELAXED, __HIP_MEMORY_SCOPE_AGENT); }
DI unsigned xb_xcc_id() { return (unsigned)__builtin_amdgcn_s_getreg((3 << 11) | 20) & 0xFu; }
#define XB_SPIN(cond, bar) do { unsigned _sp = 0; while (cond) { __builtin_amdgcn_s_sleep(1); \
    if ((++_sp & 255u) == 0u) { if (xb_ld(&(bar)[XB_TMO])) break; if (_sp > XB_SPIN_CAP) { atomicAdd(&(bar)[XB_TMO], 1u); break; } } } } while (0)
struct XcdBarrier { unsigned* bar; unsigned x; volatile LAS unsigned* st; };
DI XcdBarrier xcd_barrier_post(unsigned* bar, volatile LAS unsigned* st, bool t0) {
    XcdBarrier b; b.bar = bar; b.x = xb_xcc_id(); b.st = st;
    if (t0) { if (b.x != (blockIdx.x & 7u) || gridDim.x != 256u) (void)xb_add(&bar[XB_VOTE], 1u); (void)xb_add(&bar[XB_XCNT(b.x)], 1u); }
    return b;
}
DI void xcd_barrier_complete(unsigned* bar, unsigned x, unsigned& nloc, unsigned& nx, int lane) {
    const unsigned G = gridDim.x * gridDim.y * gridDim.z;
    unsigned sum, cnt, mine, sp = 0u;
    for (;;) {
        const unsigned c = xb_ld(&bar[XB_XCNT(lane & 15)]);
        sum = c; cnt = (c > 0u) ? 1u : 0u;
#pragma unroll
        for (int o = 1; o < 16; o <<= 1) { sum += __shfl_xor(sum, o); cnt += __shfl_xor(cnt, o); }
        mine = __shfl(c, (int)x);
        if (sum == G) break;
        __builtin_amdgcn_s_sleep(1);
        if ((++sp & 255u) == 0u) { if (xb_ld(&bar[XB_TMO])) break; if (sp > XB_SPIN_CAP) { if (lane == 0) atomicAdd(&bar[XB_TMO], 1u); break; } }
    }
    nloc = mine > 0u ? mine : 1u; nx = cnt > 0u ? cnt : 1u;
}
DI void xcd_barrier(const XcdBarrier& b, bool w0, int lane, bool local = false, int k = -1) {
    asm volatile("s_waitcnt vmcnt(0)" ::: "memory");
    __syncthreads();
    if (w0) {
        unsigned* bar = b.bar;
        unsigned nloc = b.st[0], nx = b.st[1];
        if (nloc == 0u) { xcd_barrier_complete(bar, b.x, nloc, nx, lane); if (lane == 0) { b.st[0] = nloc; b.st[1] = nx; } }
        if (lane == 0 && local && b.st[2] == 2u && (k == 5 || k == 6 || k == 7 || k == 8 || k == 10)) {
            __builtin_amdgcn_s_waitcnt(0);
            const unsigned bid = blockIdx.x, x = bid & 7u, y = bid >> 3;
            const unsigned pA = 16u * x + (y & 7u), pB = pA + 8u, p5 = 16u * x + 8u * (y >> 4) + (y & 7u), p8 = 16u * x + (y & 15u), p11 = 16u * x + (y >> 1);
            unsigned* pc = bar + XB_PAN + (k == 5 ? 0 : k == 6 ? 1 : k == 7 ? 2 : k == 8 ? 3 : 4) * 128 * 16;
            __builtin_amdgcn_fence(__ATOMIC_ACQUIRE, "agent");
            if (k == 5) (void)xb_add(&pc[p5 * 16], 1u);
            else if (k == 8) (void)xb_add(&pc[p8 * 16], 2u);
            else { (void)xb_add(&pc[pA * 16], 1u); (void)xb_add(&pc[pB * 16], 1u); }
            if (k == 5)       XB_SPIN(xb_ld(&pc[pA * 16]) < 2u || xb_ld(&pc[pB * 16]) < 2u, bar);
            else if (k == 7)  XB_SPIN(xb_ld(&pc[p8 * 16]) < 4u, bar);
            else if (k == 10) XB_SPIN(xb_ld(&pc[p11 * 16]) < 4u, bar);
            else              XB_SPIN(xb_ld(&pc[pA * 16]) < 4u || xb_ld(&pc[pB * 16]) < 4u, bar);
            asm volatile("s_waitcnt vmcnt(0)" ::: "memory");
        } else if (lane == 0 && local && b.st[2] == 2u) {
            __builtin_amdgcn_s_waitcnt(0);
            const unsigned old = xb_add(&bar[XB_LSUB(b.x)], 1u);
            const unsigned gen = old >> 5;
            if ((old & 31u) == 31u) (void)xb_add(&bar[XB_LGEN(b.x)], 1u);
            __builtin_amdgcn_fence(__ATOMIC_ACQUIRE, "agent");
            if ((old & 31u) != 31u) XB_SPIN(xb_ld(&bar[XB_LGEN(b.x)]) == gen, bar);
            asm volatile("s_waitcnt vmcnt(0)" ::: "memory");
        } else if (lane == 0) {
            __builtin_amdgcn_s_waitcnt(0);
            const unsigned old = xb_add(&bar[XB_XSUB(b.x)], 1u);
            const unsigned gen = old / nloc;
            if (old == gen * nloc) asm volatile("buffer_wbl2 sc1" ::: "memory");
            if (old + 1u == (gen + 1u) * nloc) {
                __builtin_amdgcn_fence(__ATOMIC_RELEASE, "agent");
                asm volatile("s_waitcnt vmcnt(0)" ::: "memory");
                const unsigned og = xb_add(&bar[XB_TOP], 1u);
                const unsigned tg = og / nx;
                if (og + 1u == (tg + 1u) * nx) xb_add(&bar[XB_TOPGEN], 1u);
                else XB_SPIN(xb_ld(&bar[XB_TOPGEN]) == tg, bar);
                xb_add(&bar[XB_XGEN(b.x)], 1u);
                __builtin_amdgcn_fence(__ATOMIC_ACQUIRE, "agent");
                asm volatile("s_waitcnt vmcnt(0)" ::: "memory");
            } else {
                XB_SPIN(xb_ld(&bar[XB_XGEN(b.x)]) == gen, bar);
                __builtin_amdgcn_fence(__ATOMIC_ACQUIRE, "agent");
                asm volatile("s_waitcnt vmcnt(0)" ::: "memory");
            }
            if (b.st[2] == 0u) b.st[2] = xb_ld(&bar[XB_VOTE]) ? 1u : 2u;
        }
    }
    __syncthreads();
}

DI void stage_lds(LAS unsigned char* dst, const unsigned char* src, int bytes, int wave, int lane) {
    for (int p = wave; p < (bytes >> 10); p += NWAVES)
        __builtin_amdgcn_global_load_lds((const unsigned*)(src + (size_t)p * 1024 + lane * 16), (LAS unsigned*)(dst + p * 1024), 16, 0, 0);
}
namespace pg8 {
constexpr int BM = 256, BK = 64, HALF = 128, NXCD = 8, WGM = 8;
struct Unit { int pm, pn, e, h; };
struct Gemm { const bf16_t* A; const bf16_t* Bt; int K; const bf16_t* A2; const bf16_t* Bt2; size_t bstride; unsigned long long* pts; };

struct StaticOrder {
    int nM, nN, nwg, G, c;
    DI void init(int M, int N, int G_, int c_) { nM = M / BM; nN = N / BM; nwg = nM * nN; G = G_; c = c_; }
    DI bool tile(int L, Unit& u) const {
        if (L >= nwg) return false;
        int wgid = L; { const int q = nwg / NXCD, r = nwg % NXCD, xcd = wgid % NXCD, off = wgid / NXCD; wgid = (xcd < r ? xcd * (q + 1) : r * (q + 1) + (xcd - r) * q) + off; }
        const int nig = WGM * nN, gid = wgid / nig, fm = gid * WGM, gsz = (nM - fm) < WGM ? (nM - fm) : WGM;
        u.pm = fm + ((wgid % nig) % gsz); u.pn = (wgid % nig) / gsz; u.e = 0; u.h = 0; return true;
    }
    DI bool next(int i, Unit& u) const { return tile(i * G + c, u); }
    DI const bf16_t* a_base(const Gemm& g, const Unit&) const { return g.A; }
    DI const bf16_t* a_row(const Gemm& g, const Unit& u, int r) const { return g.A + (size_t)(u.pm * BM + r) * g.K; }
    DI const bf16_t* b_row(const Gemm& g, const Unit& u, int n) const { return g.Bt + (size_t)(u.pn * BM + n) * g.K; }
};
struct USched {
    int mode; StaticOrder so; const volatile LAS int* tp; const int* ptok; int nN; int one_pm, one_pn;
    int split;
    DI bool next(int i, Unit& u) const {
        if (mode == 4) { if (i != 0) return false; u.pm = one_pm; u.pn = one_pn; u.e = 0; u.h = 0; return true; }
        if (mode == 0) {
            if (split) { if (i != 0 || so.c >= 2 * so.nwg || !so.tile(so.c >> 1, u)) return false; u.h = 1 + (so.c & 1); return true; }
            return so.tile(i * so.G + so.c, u);
        }
        if (mode == 1) { if (!so.tile((i >> 1) * so.G + so.c, u)) return false; u.e = i & 1; return true; }
        const int total = tp[16] * nN, R = total / so.G, rem = total - R * so.G;
        int L, h = 0;
        if (i < R) L = i * so.G + so.c;
        else { if (i > R) return false;
               if (2 * rem <= so.G) { if (so.c >= 2 * rem) return false; L = R * so.G + (so.c >> 1); h = 1 + (so.c & 1); }
               else { if (so.c >= rem) return false; L = R * so.G + so.c; } }
        const int mt = L / nN; int e = 0;
#pragma unroll
        for (int j = 1; j < 16; ++j) e += (mt >= tp[j]) ? 1 : 0;
        u.pm = __builtin_amdgcn_readfirstlane(mt); u.pn = __builtin_amdgcn_readfirstlane(L % nN); u.e = __builtin_amdgcn_readfirstlane(e); u.h = __builtin_amdgcn_readfirstlane(h); return true;
    }
    DI const bf16_t* a_base(const Gemm& g, const Unit& u) const { return (mode == 1 && u.e) ? g.A2 : g.A; }
    DI const bf16_t* a_row(const Gemm& g, const Unit& u, int r) const {
        if (mode == 2) {
            const int slot = (u.pm - tp[u.e]) * BM + r; const int cnt = tp[32 + u.e];
            const int tok = ptok[u.e * T + (slot < cnt ? slot : 0)] & 0x7fffffff;
            return g.A + (size_t)tok * g.K;
        }
        return a_base(g, u) + (size_t)(u.pm * BM + r) * g.K;
    }
    DI const bf16_t* b_row(const Gemm& g, const Unit& u, int n) const {
        const bf16_t* b = (mode == 1 && u.e) ? g.Bt2 : g.Bt;
        if (mode >= 2) b += (size_t)u.e * g.bstride;
        return b + (size_t)(u.pn * BM + n) * g.K;
    }
};


template <class Epi, class Sched>
DI void ngemm_phase(LAS unsigned char* lds, const Gemm g, const Sched& S, const Epi& E, const int tid) {
    LAS float* As = (LAS float*)lds;
    LAS float* Bs = As + 16 * 132;
    const int lr = tid >> 2, kq = tid & 3, tx = tid & 15, ty = tid >> 4;
    Unit u;
    for (int i = 0; S.next(i, u); ++i) {
        for (int sub = 0; sub < 4; ++sub) {
            const int sm = (sub >> 1) * 128, sn = (sub & 1) * 128;
            float acc[4][8];
#pragma unroll
            for (int r = 0; r < 4; ++r)
#pragma unroll
                for (int c = 0; c < 8; ++c) acc[r][c] = 0.f;
            const bf16_t* arow = S.a_row(g, u, sm + lr) + kq * 4;
            const bf16_t* brow = S.b_row(g, u, sn + lr) + kq * 4;
            for (int k0 = 0; k0 < g.K; k0 += 16) {
                __syncthreads();
                const u32x2 av = *(const u32x2*)(arow + k0), bv = *(const u32x2*)(brow + k0);
                As[(kq * 4 + 0) * 132 + lr] = bf2f(av.x & 0xffffu); As[(kq * 4 + 1) * 132 + lr] = bf2f(av.x >> 16);
                As[(kq * 4 + 2) * 132 + lr] = bf2f(av.y & 0xffffu); As[(kq * 4 + 3) * 132 + lr] = bf2f(av.y >> 16);
                Bs[(kq * 4 + 0) * 132 + lr] = bf2f(bv.x & 0xffffu); Bs[(kq * 4 + 1) * 132 + lr] = bf2f(bv.x >> 16);
                Bs[(kq * 4 + 2) * 132 + lr] = bf2f(bv.y & 0xffffu); Bs[(kq * 4 + 3) * 132 + lr] = bf2f(bv.y >> 16);
                __syncthreads();
#pragma unroll
                for (int k = 0; k < 16; ++k) {
                    const f32x4 a4 = *(const LAS f32x4*)(As + k * 132 + ty * 4);
                    const f32x4 b0 = *(const LAS f32x4*)(Bs + k * 132 + tx * 8), b1 = *(const LAS f32x4*)(Bs + k * 132 + tx * 8 + 4);
#pragma unroll
                    for (int r = 0; r < 4; ++r) {
#pragma unroll
                        for (int c = 0; c < 4; ++c) { acc[r][c] += a4[r] * b0[c]; acc[r][4 + c] += a4[r] * b1[c]; }
                    }
                }
            }
#pragma unroll
            for (int r = 0; r < 4; ++r) {
                f32x4 v0 = {acc[r][0], acc[r][1], acc[r][2], acc[r][3]}, v1 = {acc[r][4], acc[r][5], acc[r][6], acc[r][7]};
                E(u, u.pm * BM + sm + ty * 4 + r, u.pn * BM + sn + tx * 8, v0, v1);
            }
        }
    }
    __syncthreads();
}

template <class F> DI void epi_drive(const F& f, const Unit& u, f32x4 (&acc)[2][2][4][2], int wr, int wc, int fr, int fq) {
#pragma unroll
    for (int ai = 0; ai < 2; ++ai) {
#pragma unroll
        for (int m = 0; m < 4; ++m) { const int row = u.pm * 256 + ai * 128 + wr * 64 + m * 16 + fr;
#pragma unroll
            for (int bj = 0; bj < 2; ++bj) f(u, row, u.pn * 256 + bj * 128 + wc * 32 + 8 * fq, acc[ai][bj][m][0], acc[ai][bj][m][1]); }
    }
}
template <class F> DI void epi_drive2(const F& f, const Unit& u, f32x4 (&acc)[2][2][4][2], int wr, int wc, int fr, int fq) {
#pragma unroll
    for (int ai = 0; ai < 2; ++ai) {
        typename F::Opnd op[4][2];
#pragma unroll
        for (int m = 0; m < 4; ++m)
#pragma unroll
            for (int bj = 0; bj < 2; ++bj) op[m][bj] = f.load(u, u.pm * 256 + ai * 128 + wr * 64 + m * 16 + fr, u.pn * 256 + bj * 128 + wc * 32 + 8 * fq);
#pragma unroll
        for (int m = 0; m < 4; ++m)
#pragma unroll
            for (int bj = 0; bj < 2; ++bj) f.apply(u, u.pm * 256 + ai * 128 + wr * 64 + m * 16 + fr, u.pn * 256 + bj * 128 + wc * 32 + 8 * fq, op[m][bj], acc[ai][bj][m][0], acc[ai][bj][m][1]);
    }
}
DI int lds_byte(int r, int c) { const int st = (r >> 4) * 2 + (c >> 5), rr = r & 15, cc = c & 31, ob = rr * 64 + cc * 2; return st * 1024 + (ob ^ (((ob >> 9) & 1) << 5)); }
DI void stage_rc(int b, int& R, int& C) { const int st = b / 1024, sb = b % 1024, swz = sb ^ (((sb >> 9) & 1) << 5); R = (st >> 1) * 16 + swz / 64; C = (st & 1) * 32 + (swz % 64) / 2; }
DI int perm32(int rho) { const int n = rho >> 4, i = rho & 15; return 8 * (i >> 2) + 4 * n + (i & 3); }
constexpr int HTB = HALF * BK * 2;
template <bool GATHER, bool HALVES = false, class F, class Sched>
DI void gemm_phase(LAS unsigned char* lds, const Gemm g, const Sched& S, const F& E, const int tid) {
    const int wid = __builtin_amdgcn_readfirstlane(tid >> 6), lane = tid & 63, wr = wid >> 2, wc = wid & 3, fr = lane & 15, fq = lane >> 4;
    const int K = g.K, nt = K / BK;
    int Rr[2], Cc[2]; unsigned voffB[2];
#pragma unroll
    for (int i = 0; i < 2; ++i) { int R, C; stage_rc(tid * 16 + i * 8192, R, C); Rr[i] = R; Cc[i] = C; const int Rb = (R & ~31) + perm32(R & 31); voffB[i] = (unsigned)(Rb * K + C) * 2u; }
    const size_t kstep = (size_t)(BK * 2);
    const size_t hstep = (size_t)HALF * K * 2;
    const unsigned ldsw = (unsigned)wid * 1024u;
    const int aoff = lds_byte(wr * 64 + fr, fq * 8), boff = lds_byte(wc * 32 + fr, fq * 8);
#define PG8_SA(b, h) (((b) * 2 + (h)) * HTB)
#define PG8_SB(b, h) ((4 + (b) * 2 + (h)) * HTB)
#define PG8_STAGE2(bufoff, gbase, v0_, v1_) do { \
        __builtin_amdgcn_global_load_lds((const unsigned*)((const char*)(gbase) + (v0_)), (LAS unsigned*)(lds + (bufoff) + ldsw), 16, 0, 0); \
        __builtin_amdgcn_global_load_lds((const unsigned*)((const char*)(gbase) + (v1_)), (LAS unsigned*)(lds + (bufoff) + ldsw + 8192), 16, 0, 0); } while (0)
#define PG8_STAGEB(bufoff, gbase) PG8_STAGE2(bufoff, gbase, voffB[0], voffB[1])
#define PG8_LDA(dst, b, h) do { _Pragma("unroll") for (int m = 0; m < 4; ++m) _Pragma("unroll") for (int k = 0; k < 2; ++k) dst[m][k] = *(const LAS bf16x8*)(lds + PG8_SA(b, h) + aoff + m * 2048 + k * 1024); } while (0)
#define PG8_LDB(dst, b, h) do { _Pragma("unroll") for (int n = 0; n < 2; ++n) _Pragma("unroll") for (int k = 0; k < 2; ++k) dst[n][k] = *(const LAS bf16x8*)(lds + PG8_SB(b, h) + boff + n * 2048 + k * 1024); } while (0)
#define PG8_MMA(ai, bj, At, Bt) do { __builtin_amdgcn_s_setprio(1); _Pragma("unroll") for (int m = 0; m < 4; ++m) _Pragma("unroll") for (int n = 0; n < 2; ++n) _Pragma("unroll") for (int k = 0; k < 2; ++k) \
        acc[ai][bj][m][n] = __builtin_amdgcn_mfma_f32_16x16x32_bf16(Bt[n][k], At[m][k], acc[ai][bj][m][n], 0, 0, 0); __builtin_amdgcn_s_setprio(0); } while (0)
#define PG8_WAIT_V(n) asm volatile("s_waitcnt vmcnt(" #n ")" ::: "memory")
#define PG8_WAIT_L(n) asm volatile("s_waitcnt lgkmcnt(" #n ")" ::: "memory")
#define PG8_BAR __builtin_amdgcn_s_barrier()
#define PG8_SCHED __builtin_amdgcn_sched_barrier(0)
    Unit cur, nxt; int ui = 0;
    if (!S.next(0, cur)) return;
    f32x4 acc[2][2][4][2];
#pragma unroll
    for (int a = 0; a < 2; ++a)
#pragma unroll
        for (int b = 0; b < 2; ++b)
#pragma unroll
            for (int m = 0; m < 4; ++m)
#pragma unroll
                for (int n = 0; n < 2; ++n) acc[a][b][m][n] = (f32x4){0.f, 0.f, 0.f, 0.f};
    bf16x8 At[4][2], B0[2][2], B1[2][2];
    const char* cA = GATHER ? (const char*)S.a_base(g, cur) : (const char*)S.a_row(g, cur, 0); const char* cB = (const char*)S.b_row(g, cur, 0);
    unsigned vc00, vc01, vc10, vc11;
    if constexpr (GATHER) {
        vc00 = (unsigned)((const char*)S.a_row(g, cur, Rr[0]) - cA) + (unsigned)Cc[0] * 2u; vc01 = (unsigned)((const char*)S.a_row(g, cur, Rr[1]) - cA) + (unsigned)Cc[1] * 2u;
        vc10 = (unsigned)((const char*)S.a_row(g, cur, HALF + Rr[0]) - cA) + (unsigned)Cc[0] * 2u; vc11 = (unsigned)((const char*)S.a_row(g, cur, HALF + Rr[1]) - cA) + (unsigned)Cc[1] * 2u;
    } else {
        vc00 = (unsigned)(Rr[0] * K + Cc[0]) * 2u; vc01 = (unsigned)(Rr[1] * K + Cc[1]) * 2u; vc10 = vc00 + (unsigned)hstep; vc11 = vc01 + (unsigned)hstep;
    }
    PG8_STAGEB(PG8_SB(0, 0), cB); PG8_STAGEB(PG8_SB(0, 1), cB + hstep); PG8_STAGE2(PG8_SA(0, 0), cA, vc00, vc01); PG8_STAGE2(PG8_SA(0, 1), cA, vc10, vc11);
    if (wr == 1) PG8_BAR;
    PG8_WAIT_V(2); PG8_BAR;
    PG8_STAGEB(PG8_SB(1, 0), cB + kstep); PG8_STAGE2(PG8_SA(1, 0), cA + kstep, vc00, vc01); PG8_STAGEB(PG8_SB(1, 1), cB + hstep + kstep);
    PG8_WAIT_V(6); PG8_BAR;
    unsigned long long _gt = g.pts ? __builtin_amdgcn_s_memrealtime() : 0ull;
    for (;;) {
        const bool has_next = S.next(ui + 1, nxt);
        const char* nA = cA; const char* nB = cB; unsigned vn00 = vc00, vn01 = vc01, vn10 = vc10, vn11 = vc11;
        if (has_next) {
            nB = (const char*)S.b_row(g, nxt, 0);
            if constexpr (GATHER) {
                nA = (const char*)S.a_base(g, nxt);
                vn00 = (unsigned)((const char*)S.a_row(g, nxt, Rr[0]) - nA) + (unsigned)Cc[0] * 2u; vn01 = (unsigned)((const char*)S.a_row(g, nxt, Rr[1]) - nA) + (unsigned)Cc[1] * 2u;
                vn10 = (unsigned)((const char*)S.a_row(g, nxt, HALF + Rr[0]) - nA) + (unsigned)Cc[0] * 2u; vn11 = (unsigned)((const char*)S.a_row(g, nxt, HALF + Rr[1]) - nA) + (unsigned)Cc[1] * 2u;
            } else nA = (const char*)S.a_row(g, nxt, 0);
        }
        const bool do0 = !HALVES || cur.h != 2, do1 = !HALVES || cur.h != 1;
        for (int t = 0; t < nt; t += 2) {
            const bool last = (t == nt - 2);
            const char* a1 = cA + (size_t)(t + 1) * kstep;
            const char* a2 = last ? nA : cA + (size_t)(t + 2) * kstep; const char* b2 = last ? nB : cB + (size_t)(t + 2) * kstep;
            const char* a3 = a2 + kstep; const char* b3 = b2 + kstep;
            const unsigned w00 = (GATHER && last) ? vn00 : vc00, w01 = (GATHER && last) ? vn01 : vc01, w10 = (GATHER && last) ? vn10 : vc10, w11 = (GATHER && last) ? vn11 : vc11;
            PG8_LDB(B0, 0, 0); PG8_LDB(B1, 0, 1); PG8_SCHED; PG8_LDA(At, 0, 0); PG8_STAGE2(PG8_SA(1, 1), a1, vc10, vc11);
            PG8_WAIT_V(8); PG8_WAIT_L(0); PG8_BAR; if (do0) { PG8_MMA(0, 0, At, B0); PG8_MMA(0, 1, At, B1); } PG8_BAR; PG8_SCHED;
            PG8_LDA(At, 0, 1); PG8_STAGEB(PG8_SB(0, 0), b2); PG8_STAGEB(PG8_SB(0, 1), b2 + hstep); PG8_STAGE2(PG8_SA(0, 0), a2, w00, w01);
            PG8_WAIT_V(8); PG8_WAIT_L(0); PG8_BAR; if (do1) { PG8_MMA(1, 0, At, B0); PG8_MMA(1, 1, At, B1); } PG8_BAR; PG8_SCHED;
            PG8_LDB(B0, 1, 0); PG8_LDB(B1, 1, 1); PG8_SCHED; PG8_LDA(At, 1, 0); PG8_STAGE2(PG8_SA(0, 1), a2, w10, w11);
            PG8_WAIT_V(8); PG8_WAIT_L(0); PG8_BAR; if (do0) { PG8_MMA(0, 0, At, B0); PG8_MMA(0, 1, At, B1); } PG8_BAR; PG8_SCHED;
            PG8_LDA(At, 1, 1); PG8_STAGEB(PG8_SB(1, 0), b3); PG8_STAGEB(PG8_SB(1, 1), b3 + hstep); PG8_STAGE2(PG8_SA(1, 0), a3, w00, w01);
            PG8_WAIT_V(8); PG8_WAIT_L(0); PG8_BAR; if (do1) { PG8_MMA(1, 0, At, B0); PG8_MMA(1, 1, At, B1); } PG8_BAR; PG8_SCHED;
        }
        if (wr == 0) PG8_BAR;
        if (g.pts) { const unsigned long long _n = __builtin_amdgcn_s_memrealtime(); g.pts[33 + 16] += _n - _gt; _gt = _n; }
        E.epilogue(cur, acc, wr, wc, fr, fq);
        const bool keep = E.keep(cur);
        if (g.pts) { const unsigned long long _n = __builtin_amdgcn_s_memrealtime(); g.pts[33 + 18] += _n - _gt; _gt = _n; }
        if (!has_next) break;
        if (!keep) {
#pragma unroll
            for (int a = 0; a < 2; ++a)
#pragma unroll
                for (int b = 0; b < 2; ++b)
#pragma unroll
                    for (int m = 0; m < 4; ++m)
#pragma unroll
                        for (int n = 0; n < 2; ++n) acc[a][b][m][n] = (f32x4){0.f, 0.f, 0.f, 0.f};
        }
        cur = nxt; cA = nA; cB = nB; vc00 = vn00; vc01 = vn01; vc10 = vn10; vc11 = vn11; ++ui;
        if (wr == 1) PG8_BAR;
    }
    PG8_WAIT_V(0);
    PG8_BAR;
#undef PG8_SA
#undef PG8_SB
#undef PG8_STAGE2
#undef PG8_STAGEB
#undef PG8_LDA
#undef PG8_LDB
#undef PG8_MMA
#undef PG8_WAIT_V
#undef PG8_WAIT_L
#undef PG8_BAR
#undef PG8_SCHED
}
}

#define EPI_DEFAULT DI void epilogue(const pg8::Unit& u, f32x4 (&acc)[2][2][4][2], int wr, int wc, int fr, int fq) const { pg8::epi_drive(*this, u, acc, wr, wc, fr, fq); }
struct FProj {
    DI bool keep(const pg8::Unit&) const { return false; }
    EPI_DEFAULT
    bf16_t* zw; bf16_t* vs; bf16_t* g;
    DI void operator()(const pg8::Unit&, int row, int col, f32x4& v0, f32x4& v1) const {
        if (col < 512) store8bf(zw + (size_t)row * 512 + col, v0, v1);
        else if (col < 1024) { const int c0 = col - 512; store8bf(vs + ((size_t)(c0 >> 4) * T + row) * 16 + (c0 & 15), v0, v1); }
        else {
            const int ch = (col - 1024) >> 1; float r[4], g2[4];
#pragma unroll
            for (int j = 0; j < 4; ++j) { const float ea = fminf(__expf(-v0[j]), 1e18f), eb = fminf(__expf(-v1[j]), 1e18f); g2[j] = __builtin_amdgcn_rcpf(1.f + eb); r[j] = (1.f + eb) * __builtin_amdgcn_rcpf(1.f + ea); }
            u32x2 wr_, wg; wr_.x = pk2(r[0], r[1]); wr_.y = pk2(r[2], r[3]); wg.x = pk2(g2[0], g2[1]); wg.y = pk2(g2[2], g2[3]);
            *(u32x2*)(g + (size_t)row * 1024 + ch) = wr_; *(u32x2*)(g + (size_t)T * 1024 + (size_t)row * 1024 + ch) = wg;
        }
    }
};
struct FKV {
    DI bool keep(const pg8::Unit&) const { return false; }
    DI void epilogue(const pg8::Unit& u, f32x4 (&acc)[2][2][4][2], int wr, int wc, int fr, int fq) const {
#pragma unroll
        for (int ai = 0; ai < 2; ++ai) {
            if (u.h == 2 - ai) continue;
#pragma unroll
            for (int m = 0; m < 4; ++m) { const int row = u.pm * 256 + ai * 128 + wr * 64 + m * 16 + fr;
#pragma unroll
                for (int bj = 0; bj < 2; ++bj) (*this)(u, row, u.pn * 256 + bj * 128 + wc * 32 + 8 * fq, acc[ai][bj][m][0], acc[ai][bj][m][1]); }
        }
    }
    bf16_t* kf; bf16_t* vf;
    DI void operator()(const pg8::Unit&, int row, int col, f32x4& v0, f32x4& v1) const {
        const int b = row >> 8, key = row & 255;
        if (col < 1024) {
            const int h = col >> 8, dim = col & 255;
            store8bf(kf + ((size_t)((((b * 4 + h) * 8 + (key >> 5)) * 16 + (dim >> 4)) * 64 + ((dim >> 3) & 1) * 32 + (key & 31))) * 8, v0, v1);
        } else store8bf(vf + (size_t)row * 1024 + (col - 1024), v0, v1);
    }
};
struct FGlu {
    DI bool keep(const pg8::Unit&) const { return false; }
    const bf16_t* yg; const float* bias; bf16_t* ys2;
    typedef u32x4 Opnd;
    DI Opnd load(const pg8::Unit&, int row, int col) const { return *(const u32x4*)(yg + (size_t)row * 512 + col); }
    DI void apply(const pg8::Unit&, int row, int col, const Opnd& o, f32x4& v0, f32x4& v1) const {
        f32x4 a, b; a[0] = bf2f(o.x & 0xffffu); a[1] = bf2f(o.x >> 16); a[2] = bf2f(o.y & 0xffffu); a[3] = bf2f(o.y >> 16); b[0] = bf2f(o.z & 0xffffu); b[1] = bf2f(o.z >> 16); b[2] = bf2f(o.w & 0xffffu); b[3] = bf2f(o.w >> 16);
        const f32x4 b0 = *(const f32x4*)(bias + col), b1 = *(const f32x4*)(bias + col + 4);
        f32x4 p, q;
#pragma unroll
        for (int j = 0; j < 4; ++j) { p[j] = a[j] * sigm(v0[j] + b0[j]); q[j] = b[j] * sigm(v1[j] + b1[j]); }
        store8bf(ys2 + (size_t)row * 512 + col, p, q);
    }
    DI void epilogue(const pg8::Unit& u, f32x4 (&acc)[2][2][4][2], int wr, int wc, int fr, int fq) const { pg8::epi_drive2(*this, u, acc, wr, wc, fr, fq); }
    DI void operator()(const pg8::Unit& u, int row, int col, f32x4& v0, f32x4& v1) const { apply(u, row, col, load(u, row, col), v0, v1); }
};
struct FBrNaive {
    DI bool keep(const pg8::Unit&) const { return false; }
    const bf16_t* g; float* tmp; bf16_t* mg;
    DI void operator()(const pg8::Unit& u, int row, int col, f32x4& v0, f32x4& v1) const {
        f32x4 g0, g1; load8bf(g + (size_t)row * 2048 + (u.e ? 1024 : 0) + col, g0, g1);
        float* tp = tmp + (size_t)row * 1024 + col;
        if (u.e == 0) { *(f32x4*)tp = g0 * v0; *(f32x4*)(tp + 4) = g1 * v1; }
        else { const f32x4 t0 = *(const f32x4*)tp, t1 = *(const f32x4*)(tp + 4); store8bf(mg + (size_t)row * 1024 + col, t0 + g0 * v0, t1 + g1 * v1); }
    }
};
struct FBrMid { const bf16_t* g;
    DI void operator()(const pg8::Unit&, int row, int col, f32x4& v0, f32x4& v1) const { f32x4 a0, a1; load8bf(g + (size_t)row * 1024 + col, a0, a1); v0 *= a0; v1 *= a1; } };
struct FBrFin { const bf16_t* g; bf16_t* mg;
    typedef u32x4 Opnd;
    DI Opnd load(const pg8::Unit&, int row, int col) const { return *(const u32x4*)(g + (size_t)T * 1024 + (size_t)row * 1024 + col); }
    DI void apply(const pg8::Unit&, int row, int col, const Opnd& o, f32x4& v0, f32x4& v1) const { f32x4 a, b; a[0] = bf2f(o.x & 0xffffu); a[1] = bf2f(o.x >> 16); a[2] = bf2f(o.y & 0xffffu); a[3] = bf2f(o.y >> 16); b[0] = bf2f(o.z & 0xffffu); b[1] = bf2f(o.z >> 16); b[2] = bf2f(o.w & 0xffffu); b[3] = bf2f(o.w >> 16); store8bf(mg + (size_t)row * 1024 + col, v0 * a, v1 * b); }
    DI void operator()(const pg8::Unit& u, int row, int col, f32x4& v0, f32x4& v1) const { apply(u, row, col, load(u, row, col), v0, v1); } };
struct FBr {
    DI bool keep(const pg8::Unit& u) const { return u.e == 0; }
    const bf16_t* g; bf16_t* mg;
    DI void epilogue(const pg8::Unit& u, f32x4 (&acc)[2][2][4][2], int wr, int wc, int fr, int fq) const {
        if (u.e == 0) pg8::epi_drive(FBrMid{g}, u, acc, wr, wc, fr, fq); else pg8::epi_drive2(FBrFin{g, mg}, u, acc, wr, wc, fr, fq);
    }
    DI void operator()(const pg8::Unit& u, int row, int col, f32x4& v0, f32x4& v1) const { if (u.e == 0) FBrMid{g}(u, row, col, v0, v1); else FBrFin{g, mg}(u, row, col, v0, v1); }
};
struct FWout {
    DI bool keep(const pg8::Unit&) const { return false; }
    const float* rmsx; bf16_t* hb; float* ssq8;
    struct Opnd { u32x4 h; float rm; };
    DI Opnd load(const pg8::Unit&, int row, int col) const { Opnd o; o.h = *(const u32x4*)(hb + (size_t)row * 1024 + col); o.rm = rmsx[row]; return o; }
    DI void apply(const pg8::Unit&, int row, int col, const Opnd& o, f32x4& v0, f32x4& v1) const {
        f32x4 a, b; a[0] = bf2f(o.h.x & 0xffffu); a[1] = bf2f(o.h.x >> 16); a[2] = bf2f(o.h.y & 0xffffu); a[3] = bf2f(o.h.y >> 16); b[0] = bf2f(o.h.z & 0xffffu); b[1] = bf2f(o.h.z >> 16); b[2] = bf2f(o.h.w & 0xffffu); b[3] = bf2f(o.h.w >> 16);
        const f32x4 h0 = a * o.rm + v0, h1 = b * o.rm + v1;
        store8bf(hb + (size_t)row * 1024 + col, h0, h1);
        float s = (h0[0] * h0[0] + h0[1] * h0[1]) + (h0[2] * h0[2] + h0[3] * h0[3]) + (h1[0] * h1[0] + h1[1] * h1[1]) + (h1[2] * h1[2] + h1[3] * h1[3]);
        s += __shfl_xor(s, 16); s += __shfl_xor(s, 32);
        ssq8[(size_t)row * 32 + (col >> 5)] = s;
    }
    DI void epilogue(const pg8::Unit& u, f32x4 (&acc)[2][2][4][2], int wr, int wc, int fr, int fq) const { pg8::epi_drive2(*this, u, acc, wr, wc, fr, fq); }
    DI void operator()(const pg8::Unit& u, int row, int col, f32x4& v0, f32x4& v1) const { apply(u, row, col, load(u, row, col), v0, v1); }
};
struct FStoreBf {
    DI bool keep(const pg8::Unit&) const { return false; }
    EPI_DEFAULT
    bf16_t* o;
    DI void operator()(const pg8::Unit&, int row, int col, f32x4& v0, f32x4& v1) const { store8bf(o + (size_t)row * 1024 + col, v0, v1); }
};
struct FWo {
    DI bool keep(const pg8::Unit&) const { return false; }
    EPI_DEFAULT
    bf16_t* hb;
    DI void operator()(const pg8::Unit&, int row, int col, f32x4& v0, f32x4& v1) const {
        const size_t o = (size_t)row * 1024 + col;
        f32x4 a, b; load8bf(hb + o, a, b);
        store8bf(hb + o, a + v0, b + v1);
    }
};
struct FUp {
    DI bool keep(const pg8::Unit&) const { return false; }
    const volatile LAS int* tp; const float* pscale; bf16_t* hid;
    DI void epilogue(const pg8::Unit& u, f32x4 (&acc)[2][2][4][2], int wr, int wc, int fr, int fq) const {
        const int t0 = tp[u.e] * 256, cnt = tp[32 + u.e];
        float sc[2][4];
#pragma unroll
        for (int ai = 0; ai < 2; ++ai)
#pragma unroll
            for (int m = 0; m < 4; ++m) { const int slot = u.pm * 256 + ai * 128 + wr * 64 + m * 16 + fr - t0; sc[ai][m] = pscale[u.e * T + (slot < cnt ? slot : 0)]; }
#pragma unroll
        for (int ai = 0; ai < 2; ++ai) {
            if (u.h == 2 - ai) continue;
#pragma unroll
            for (int m = 0; m < 4; ++m) { const int row = u.pm * 256 + ai * 128 + wr * 64 + m * 16 + fr; const bool ok = (row - t0) < cnt; const float s = sc[ai][m];
#pragma unroll
                for (int bj = 0; bj < 2; ++bj) { const int col = u.pn * 256 + bj * 128 + wc * 32 + 8 * fq; const f32x4 v0 = acc[ai][bj][m][0], v1 = acc[ai][bj][m][1];
                    float h[4];
#pragma unroll
                    for (int j = 0; j < 4; ++j) { const float a = v0[j] * s, b = v1[j] * s; h[j] = a * sigm(a) * b; }
                    u32x2 w; w.x = pk2(h[0], h[1]); w.y = pk2(h[2], h[3]);
                    if (ok) *(u32x2*)(hid + (size_t)row * 512 + (col >> 1)) = w; } } }
    }
    DI void operator()(const pg8::Unit& u, int row, int col, f32x4& v0, f32x4& v1) const {
        const int slot = row - tp[u.e] * 256, cnt = tp[32 + u.e]; const float s = pscale[u.e * T + (slot < cnt ? slot : 0)];
        float h[4];
#pragma unroll
        for (int j = 0; j < 4; ++j) { const float a = v0[j] * s, b = v1[j] * s; h[j] = a * sigm(a) * b; }
        u32x2 w; w.x = pk2(h[0], h[1]); w.y = pk2(h[2], h[3]);
        if (slot < cnt) *(u32x2*)(hid + (size_t)row * 512 + (col >> 1)) = w;
    }
};
struct FDown {
    DI bool keep(const pg8::Unit&) const { return false; }
    DI void epilogue(const pg8::Unit& u, f32x4 (&acc)[2][2][4][2], int wr, int wc, int fr, int fq) const {
#pragma unroll
        for (int ai = 0; ai < 2; ++ai) {
            if (u.h == 2 - ai) continue;
#pragma unroll
            for (int m = 0; m < 4; ++m) { const int row = u.pm * 256 + ai * 128 + wr * 64 + m * 16 + fr;
#pragma unroll
                for (int bj = 0; bj < 2; ++bj) (*this)(u, row, u.pn * 256 + bj * 128 + wc * 32 + 8 * fq, acc[ai][bj][m][0], acc[ai][bj][m][1]); }
        }
    }
    bf16_t* pkr;
    DI void operator()(const pg8::Unit&, int row, int col, f32x4& v0, f32x4& v1) const { store8bf(pkr + (size_t)row * 1024 + col, v0, v1); }
};
enum { E_PROJ = 0, E_KV, E_GLU, E_BR, E_WOUT, E_Q, E_WO, E_UP, E_DOWN, E_BRN };
struct UEpi {
    int id; const volatile LAS int* tp; unsigned char* ws; const float* x; float* out; const float* glub;
    DI void operator()(const pg8::Unit& u, int row, int col, f32x4& v0, f32x4& v1) const {
        switch (id) {
        case E_PROJ: FProj{(bf16_t*)(ws + WS_ZW), (bf16_t*)(ws + WS_VS), (bf16_t*)(ws + WS_G)}(u, row, col, v0, v1); break;
        case E_KV:   FKV{(bf16_t*)(ws + WS_KC), (bf16_t*)(ws + WS_VRM)}(u, row, col, v0, v1); break;
        case E_GLU:  FGlu{(const bf16_t*)(ws + WS_YG), glub, (bf16_t*)(ws + WS_YS2)}(u, row, col, v0, v1); break;
        case E_BR:   FBr{(const bf16_t*)(ws + WS_G), (bf16_t*)(ws + WS_MG)}(u, row, col, v0, v1); break;
        case E_BRN:  FBrNaive{(const bf16_t*)(ws + WS_G), out, (bf16_t*)(ws + WS_MG)}(u, row, col, v0, v1); break;
        case E_WOUT: FWout{(const float*)(ws + WS_RMSX), (bf16_t*)(ws + WS_A), (float*)(ws + WS_SSQ8)}(u, row, col, v0, v1); break;
        case E_Q:    FStoreBf{(bf16_t*)(ws + WS_Q)}(u, row, col, v0, v1); break;
        case E_WO:   FWo{(bf16_t*)(ws + WS_A)}(u, row, col, v0, v1); break;
        case E_UP:   FUp{tp, (const float*)(ws + WS_PSCALE), (bf16_t*)(ws + WS_HID)}(u, row, col, v0, v1); break;
        case E_DOWN: default: FDown{(bf16_t*)(ws + WS_PKR)}(u, row, col, v0, v1); break;
        }
    }
    DI bool keep(const pg8::Unit& u) const { return id == E_BR && u.e == 0; }
    DI UEpi fresh() const { UEpi e = *this; asm volatile("" : "+s"(e.ws), "+s"(e.x), "+s"(e.out), "+s"(e.glub), "+s"(e.id)); return e; }
};

struct Args { const float* in[33]; float* out; unsigned char* ws; int ph_lo, ph_hi, li, pad; };
struct Frame {
    LAS unsigned char* lds; volatile LAS unsigned* MISC; gu32* ctl;
    int tid, lane, wave, vcu, G, bid; unsigned char* ws;
};
typedef __attribute__((address_space(4))) const Args CArgs;
#if defined(__HIP_DEVICE_COMPILE__)
DI Args phase_args(CArgs* p) { asm volatile("" : "+s"(p)); return *p; }
#else
DI Args phase_args(CArgs* p) { return Args{}; }
#endif
DI Frame make_frame(const Args& a, int wave0) {
    Frame F;
    extern __shared__ __attribute__((aligned(16))) unsigned char lds[];
    F.lds = (LAS unsigned char*)lds;
    F.MISC = (volatile LAS unsigned*)(F.lds + MISC_OFF);
    { int w = wave0; asm volatile("" : "+s"(w)); F.tid = w * 64 + lane_id(); }
    F.lane = F.tid & 63; F.wave = __builtin_amdgcn_readfirstlane(F.tid >> 6);
    int bx = blockIdx.x, gx = gridDim.x; asm volatile("" : "+s"(bx), "+s"(gx));
    F.G = gx; F.bid = bx; F.vcu = (F.G % 8 == 0) ? (bx % 8) * (F.G / 8) + bx / 8 : bx;
    F.ws = a.ws; F.ctl = (gu32*)(a.ws + WS_CTL);
    return F;
}
enum { I_X = 0, I_MEM, I_NMIX, I_WIN, I_POOLW, I_POOLS, I_ARE, I_AIM, I_LOGDT, I_BRE, I_BIM, I_CRE, I_CIM, I_SD, I_GLUW, I_GLUB, I_BRP, I_BRS,
       I_WOUT, I_NX, I_NMEM, I_WQ, I_WKV, I_WO, I_NFFN, I_RGW, I_RGB, I_REW, I_REB, I_W1, I_W3, I_W2, I_NFIN };

DI void ssm_tables_item(const Args& a, Frame& F, int g, int p0, int np = 1) {
    LAS float* lamr = (LAS float*)(F.lds);
    LAS float* lami = lamr + 17 * 64;
    LAS float* Bbr = lami + 17 * 64;
    LAS float* Bbi = Bbr + 1024;
    LAS float* Cr = Bbi + 1024;
    LAS float* Ci = Cr + 1024;
    const int tid = F.tid;
    __syncthreads();
    {
        const int n = tid & 63, mg = tid >> 6;
        const float dt = expf(a.in[I_LOGDT][g]), ar = a.in[I_ARE][g * 64 + n], ai = a.in[I_AIM][g * 64 + n];
        for (int m = mg; m <= 16; m += 8) { const float mag = expf((float)m * ar * dt); float sn, cs; sincosf((float)m * ai * dt, &sn, &cs); lamr[m * 64 + n] = mag * cs; lami[m * 64 + n] = mag * sn; }
        if (mg < 2) for (int p = p0; p < p0 + np; ++p) {
            const int jj = 2 * p + mg; const float e = 16.f * (float)(jj + 1);
            float* mup = (float*)(F.ws + WS_MUP) + ((size_t)g * 16 + jj) * 128;
            const float mag = expf(e * ar * dt); float sn, cs; sincosf(e * ai * dt, &sn, &cs); mup[n] = mag * cs; mup[64 + n] = mag * sn;
        }
        if (p0 == 0 && mg == 7) {
            float* nu = (float*)(F.ws + WS_NU) + g * 128;
            const float mag = expf(256.f * ar * dt); float sn, cs; sincosf(256.f * ai * dt, &sn, &cs); nu[n] = mag * cs; nu[64 + n] = mag * sn;
        }
    }
    __syncthreads();
    if (tid < 64) {
        const int n = tid;
        const float ar = a.in[I_ARE][g * 64 + n], ai = a.in[I_AIM][g * 64 + n];
        const float lr = lamr[64 + n], li = lami[64 + n], den = ar * ar + ai * ai, nr = lr - 1.f, ni = li;
        const float fre = (nr * ar + ni * ai) / den, fim = (ni * ar - nr * ai) / den;
        for (int c = 0; c < 16; ++c) {
            const float br = a.in[I_BRE][(size_t)(g * 64 + n) * 16 + c], bi = a.in[I_BIM][(size_t)(g * 64 + n) * 16 + c];
            Bbr[n * 16 + c] = fre * br - fim * bi; Bbi[n * 16 + c] = fre * bi + fim * br;
        }
        if (p0 == 0) { float* mu = (float*)(F.ws + WS_MU) + g * 128; mu[n] = lamr[16 * 64 + n]; mu[64 + n] = lami[16 * 64 + n]; }
    }
    for (int e = tid; e < 1024; e += 512) { Cr[e] = a.in[I_CRE][(size_t)g * 1024 + e]; Ci[e] = a.in[I_CIM][(size_t)g * 1024 + e]; }
    __syncthreads();
    bf16_t* wsa = (bf16_t*)(F.ws + WS_WSA); bf16_t* tda = (bf16_t*)(F.ws + WS_TDA); bf16_t* woa = (bf16_t*)(F.ws + WS_WOA);
    for (int p = p0; p < p0 + np; ++p) {
    {
        const int nt = p;
        for (int e = tid; e < 4096; e += 512) {
            const int ks = e >> 9, l = (e >> 3) & 63, jj = e & 7, r = l & 15, q = l >> 4, npr = 16 * nt + r, n = npr & 63, i = 2 * ks + (q >> 1), cp = 8 * (q & 1) + jj, m = 15 - i;
            const float zr = lamr[m * 64 + n] * Bbr[n * 16 + cp] - lami[m * 64 + n] * Bbi[n * 16 + cp], zi = lamr[m * 64 + n] * Bbi[n * 16 + cp] + lami[m * 64 + n] * Bbr[n * 16 + cp];
            wsa[((size_t)(g * 8 + nt) * 8 + ks) * 512 + l * 8 + jj] = (bf16_t)f2bf(npr < 64 ? zr : zi);
        }
    }
    {
        for (int e = tid; e < 4096; e += 512) {
            const int i = 2 * p + (e >> 11), s = (e >> 9) & 3, l = (e >> 3) & 63, jj = e & 7, cc = l & 15, q = l >> 4;
            const int npr = 32 * s + (jj < 4 ? 4 * q + jj : 16 + 4 * q + jj - 4), n = npr & 63, m = i + 1;
            const float zr = Cr[cc * 64 + n] * lamr[m * 64 + n] - Ci[cc * 64 + n] * lami[m * 64 + n], zi = Cr[cc * 64 + n] * lami[m * 64 + n] + Ci[cc * 64 + n] * lamr[m * 64 + n];
            woa[((size_t)(g * 16 + i) * 4 + s) * 512 + l * 8 + jj] = (bf16_t)f2bf(npr < 64 ? zr : -zi);
        }
    }
    {
        for (int e = tid; e < 1024; e += 512) {
            const int d = 2 * p + (e >> 9), l = (e >> 3) & 63, jj = e & 7, cc = l & 15, q = l >> 4, kk = q >> 1, cp = 8 * (q & 1) + jj, m = d - kk;
            float acc = 0.f;
            if (m >= 0) {
                for (int n = 0; n < 64; ++n) {
                    const float tr = lamr[m * 64 + n] * Bbr[n * 16 + cp] - lami[m * 64 + n] * Bbi[n * 16 + cp], ti = lamr[m * 64 + n] * Bbi[n * 16 + cp] + lami[m * 64 + n] * Bbr[n * 16 + cp];
                    acc += Cr[cc * 64 + n] * tr - Ci[cc * 64 + n] * ti;
                }
                if (m == 0 && cc == cp) acc += a.in[I_SD][g * 16 + cc];
            }
            tda[((size_t)g * 16 + d) * 512 + l * 8 + jj] = (bf16_t)f2bf(acc);
        }
    }
    }
}
template <int D_> DI float row_shr(float x) { return __int_as_float(__builtin_amdgcn_update_dpp(0, __float_as_int(x), 0x110 + D_, 0xf, 0xf, true)); }
template <int D_> DI void ssm_scan_step(f32x4 (&zr)[4], f32x4 (&zi)[4], f32x4 (&mr)[4], f32x4 (&mi)[4]) {
#pragma unroll
    for (int nt = 0; nt < 4; ++nt)
#pragma unroll
        for (int r = 0; r < 4; ++r) {
            const float sr = row_shr<D_>(zr[nt][r]), si = row_shr<D_>(zi[nt][r]);
            zr[nt][r] += mr[nt][r] * sr - mi[nt][r] * si; zi[nt][r] += mr[nt][r] * si + mi[nt][r] * sr;
            const float a2 = mr[nt][r] * mr[nt][r] - mi[nt][r] * mi[nt][r], b2 = 2.f * mr[nt][r] * mi[nt][r]; mr[nt][r] = a2; mi[nt][r] = b2;
        }
}
DI bf16x8 pack8(const f32x4& a, const f32x4& b) { u32x4 w; w.x = pk2(a[0], a[1]); w.y = pk2(a[2], a[3]); w.z = pk2(b[0], b[1]); w.w = pk2(b[2], b[3]); return __builtin_bit_cast(bf16x8, w); }
DI void ssm_seq(Frame& F) {
    const bf16_t* vs = (const bf16_t*)(F.ws + WS_VS); bf16_t* yg = (bf16_t*)(F.ws + WS_YG);
    const float* MU = (const float*)(F.ws + WS_MU); const float* NU = (const float*)(F.ws + WS_NU); const float* MUP = (const float*)(F.ws + WS_MUP);
    const int lane = F.lane, j = lane & 15, q = lane >> 4;
    LAS float* exch = (LAS float*)(F.lds + SSM_SCR + 4096);
    LAS float* sc = (LAS float*)(F.lds + SSM_SCR + F.wave * 512);
    for (int item = F.vcu; item < BATCH * NSG; item += F.G) {
        const int b = item >> 5, g = item & 31;
        __syncthreads();
        stage_lds(F.lds + SSM_WS, F.ws + WS_WSA + (size_t)g * 65536, 65536, F.wave, lane);
        stage_lds(F.lds + SSM_TD, F.ws + WS_TDA + (size_t)g * 16384, 16384, F.wave, lane);
        stage_lds(F.lds + SSM_WO, F.ws + WS_WOA + (size_t)g * 65536, 65536, F.wave, lane);
        const float nr = NU[g * 128 + lane], ni = NU[g * 128 + 64 + lane];
        float Hr = 0.f, Hi = 0.f;
        VM_WAIT();
        for (int k = 0; k < 4; ++k) {
            const int tile = b * 32 + k * 8 + F.wave;
            bf16x8 Bv[8];
            {
                const bf16_t* vb = vs + ((size_t)g * T + (size_t)tile * 256 + 16 * j + (q >> 1)) * 16 + 8 * (q & 1);
#pragma unroll
                for (int ks = 0; ks < 8; ++ks) Bv[ks] = *(const bf16x8*)(vb + ks * 32);
            }
            f32x4 mr[4], mi[4];
#pragma unroll
            for (int nt = 0; nt < 4; ++nt) { mr[nt] = *(const f32x4*)(MU + g * 128 + 16 * nt + 4 * q); mi[nt] = *(const f32x4*)(MU + g * 128 + 64 + 16 * nt + 4 * q); }
            __syncthreads();
            f32x4 zr[4], zi[4];
#pragma unroll
            for (int nt = 0; nt < 4; ++nt) { zr[nt] = (f32x4){0.f, 0.f, 0.f, 0.f}; zi[nt] = (f32x4){0.f, 0.f, 0.f, 0.f}; }
#pragma unroll
            for (int nt = 0; nt < 4; ++nt)
#pragma unroll
                for (int ks = 0; ks < 8; ++ks) {
                    const bf16x8 ar = *(const LAS bf16x8*)(F.lds + SSM_WS + ((nt * 8 + ks) * 64 + lane) * 16);
                    const bf16x8 ai = *(const LAS bf16x8*)(F.lds + SSM_WS + (((nt + 4) * 8 + ks) * 64 + lane) * 16);
                    zr[nt] = __builtin_amdgcn_mfma_f32_16x16x32_bf16(ar, Bv[ks], zr[nt], 0, 0, 0);
                    zi[nt] = __builtin_amdgcn_mfma_f32_16x16x32_bf16(ai, Bv[ks], zi[nt], 0, 0, 0);
                }
            ssm_scan_step<1>(zr, zi, mr, mi); ssm_scan_step<2>(zr, zi, mr, mi); ssm_scan_step<4>(zr, zi, mr, mi); ssm_scan_step<8>(zr, zi, mr, mi);
            if (j == 15) {
                LAS float* e = exch + F.wave * 128;
#pragma unroll
                for (int nt = 0; nt < 4; ++nt) { *(LAS f32x4*)(e + 16 * nt + 4 * q) = zr[nt]; *(LAS f32x4*)(e + 64 + 16 * nt + 4 * q) = zi[nt]; }
            }
            __syncthreads();
            float hr = Hr, hi = Hi, myr = 0.f, myi = 0.f;
#pragma unroll
            for (int w = 0; w < 8; ++w) {
                if (w == F.wave) { myr = hr; myi = hi; }
                const float er = exch[w * 128 + lane], ei = exch[w * 128 + 64 + lane];
                const float a2 = nr * hr - ni * hi + er, b2 = nr * hi + ni * hr + ei; hr = a2; hi = b2;
            }
            Hr = hr; Hi = hi;
            sc[lane] = myr; sc[64 + lane] = myi;
            LDS_WAIT(); __builtin_amdgcn_wave_barrier();
            f32x4 hpr[4], hpi[4];
#pragma unroll
            for (int nt = 0; nt < 4; ++nt) { hpr[nt] = *(const LAS f32x4*)(sc + 16 * nt + 4 * q); hpi[nt] = *(const LAS f32x4*)(sc + 64 + 16 * nt + 4 * q); }
            f32x4 mpr[4], mpi[4];
#pragma unroll
            for (int nt = 0; nt < 4; ++nt) { mpr[nt] = *(const f32x4*)(MUP + ((size_t)g * 16 + j) * 128 + 16 * nt + 4 * q); mpi[nt] = *(const f32x4*)(MUP + ((size_t)g * 16 + j) * 128 + 64 + 16 * nt + 4 * q); }
#pragma unroll
            for (int nt = 0; nt < 4; ++nt)
#pragma unroll
                for (int r = 0; r < 4; ++r) { zr[nt][r] += mpr[nt][r] * hpr[nt][r] - mpi[nt][r] * hpi[nt][r]; zi[nt][r] += mpr[nt][r] * hpi[nt][r] + mpi[nt][r] * hpr[nt][r]; }
            f32x4 h8[8];
#pragma unroll
            for (int nt = 0; nt < 4; ++nt)
#pragma unroll
                for (int r = 0; r < 4; ++r) { const float sr = row_shr<1>(zr[nt][r]), si = row_shr<1>(zi[nt][r]); h8[nt][r] = (j == 0) ? hpr[nt][r] : sr; h8[4 + nt][r] = (j == 0) ? hpi[nt][r] : si; }
            bf16x8 Hb[4];
#pragma unroll
            for (int s = 0; s < 4; ++s) Hb[s] = pack8(h8[2 * s], h8[2 * s + 1]);
            bf16_t* yo = yg + ((size_t)tile * 256 + 16 * j) * 512 + 16 * g + 4 * q;
#pragma unroll
            for (int i = 0; i < 16; ++i) {
                f32x4 c = (f32x4){0.f, 0.f, 0.f, 0.f};
#pragma unroll
                for (int ks = 0; ks <= i / 2; ++ks) c = __builtin_amdgcn_mfma_f32_16x16x32_bf16(*(const LAS bf16x8*)(F.lds + SSM_TD + ((i - 2 * ks) * 64 + lane) * 16), Bv[ks], c, 0, 0, 0);
#pragma unroll
                for (int s = 0; s < 4; ++s) c = __builtin_amdgcn_mfma_f32_16x16x32_bf16(*(const LAS bf16x8*)(F.lds + SSM_WO + ((i * 4 + s) * 64 + lane) * 16), Hb[s], c, 0, 0, 0);
                u32x2 w; w.x = pk2(gelu_tanh(c[0]), gelu_tanh(c[1])); w.y = pk2(gelu_tanh(c[2]), gelu_tanh(c[3]));
                *(u32x2*)(yo + (size_t)i * 512) = w;
            }
        }
    }
    __syncthreads();
}
template <bool OUT>
DI void ssm_pass(Frame& F) {
    const bf16_t* vs = (const bf16_t*)(F.ws + WS_VS); bf16_t* yg = (bf16_t*)(F.ws + WS_YG);
    float* E = (float*)(F.ws + WS_SLOC); const float* MU = (const float*)(F.ws + WS_MU); const float* NU = (const float*)(F.ws + WS_NU);
    const int lane = F.lane, j = lane & 15, q = lane >> 4;
    int staged_g = -1;
    for (int batch = F.vcu; batch < 512; batch += F.G) {
        const int g = batch & 31, tb = batch >> 5, tile = tb * 8 + F.wave;
        PACC_T0(F);
        __syncthreads();
        if (g != staged_g) {
            stage_lds(F.lds + SSM_WS, F.ws + WS_WSA + (size_t)g * 65536, 65536, F.wave, lane);
            if (OUT) { stage_lds(F.lds + SSM_TD, F.ws + WS_TDA + (size_t)g * 16384, 16384, F.wave, lane); stage_lds(F.lds + SSM_WO, F.ws + WS_WOA + (size_t)g * 65536, 65536, F.wave, lane); }
            staged_g = g;
        }
        bf16x8 Bv[8];
        {
            const bf16_t* vb = vs + ((size_t)g * T + (size_t)tile * 256 + 16 * j + (q >> 1)) * 16 + 8 * (q & 1);
#pragma unroll
            for (int ks = 0; ks < 8; ++ks) Bv[ks] = *(const bf16x8*)(vb + ks * 32);
        }
        f32x4 hpr[4], hpi[4];
        if (OUT) {
            const int tq = tile & 31, t0 = tile - tq;
            const float nr = NU[g * 128 + lane], ni = NU[g * 128 + 64 + lane];
            float hr = 0.f, hi = 0.f, pr = 1.f, pi = 0.f;
            float er[31], ei[31];
#pragma unroll
            for (int i = 0; i < 31; ++i) { const int tt = (i < tq) ? (tile - 1 - i) : t0; const float* e = E + ((size_t)tt * 32 + g) * 128; er[i] = e[lane]; ei[i] = e[64 + lane]; }
#pragma unroll
            for (int i = 0; i < 31; ++i) { const float mk = (i < tq) ? 1.f : 0.f; hr += mk * (pr * er[i] - pi * ei[i]); hi += mk * (pr * ei[i] + pi * er[i]); const float a2 = pr * nr - pi * ni, b2 = pr * ni + pi * nr; pr = a2; pi = b2; }
            LAS float* sc = (LAS float*)(F.lds + SSM_SCR + F.wave * 512);
            sc[lane] = hr; sc[64 + lane] = hi;
            LDS_WAIT(); __builtin_amdgcn_wave_barrier();
#pragma unroll
            for (int nt = 0; nt < 4; ++nt) { hpr[nt] = *(const LAS f32x4*)(sc + 16 * nt + 4 * q); hpi[nt] = *(const LAS f32x4*)(sc + 64 + 16 * nt + 4 * q); }
        }
        f32x4 mr[4], mi[4];
#pragma unroll
        for (int nt = 0; nt < 4; ++nt) { mr[nt] = *(const f32x4*)(MU + g * 128 + 16 * nt + 4 * q); mi[nt] = *(const f32x4*)(MU + g * 128 + 64 + 16 * nt + 4 * q); }
        VM_WAIT(); __syncthreads();
        if (OUT) PACC(F, 4);
        f32x4 zr[4], zi[4];
#pragma unroll
        for (int nt = 0; nt < 4; ++nt) { zr[nt] = (f32x4){0.f, 0.f, 0.f, 0.f}; zi[nt] = (f32x4){0.f, 0.f, 0.f, 0.f}; }
#pragma unroll
        for (int nt = 0; nt < 4; ++nt)
#pragma unroll
            for (int ks = 0; ks < 8; ++ks) {
                const bf16x8 ar = *(const LAS bf16x8*)(F.lds + SSM_WS + ((nt * 8 + ks) * 64 + lane) * 16);
                const bf16x8 ai = *(const LAS bf16x8*)(F.lds + SSM_WS + (((nt + 4) * 8 + ks) * 64 + lane) * 16);
                zr[nt] = __builtin_amdgcn_mfma_f32_16x16x32_bf16(ar, Bv[ks], zr[nt], 0, 0, 0);
                zi[nt] = __builtin_amdgcn_mfma_f32_16x16x32_bf16(ai, Bv[ks], zi[nt], 0, 0, 0);
            }
        if (OUT) {
            if (j == 0) {
#pragma unroll
                for (int nt = 0; nt < 4; ++nt)
#pragma unroll
                    for (int r = 0; r < 4; ++r) { zr[nt][r] += mr[nt][r] * hpr[nt][r] - mi[nt][r] * hpi[nt][r]; zi[nt][r] += mr[nt][r] * hpi[nt][r] + mi[nt][r] * hpr[nt][r]; }
            }
        }
        ssm_scan_step<1>(zr, zi, mr, mi); ssm_scan_step<2>(zr, zi, mr, mi); ssm_scan_step<4>(zr, zi, mr, mi); ssm_scan_step<8>(zr, zi, mr, mi);
        if (OUT) PACC(F, 5);
        if (!OUT) {
            if (j == 15) {
                float* e = E + ((size_t)tile * 32 + g) * 128;
#pragma unroll
                for (int nt = 0; nt < 4; ++nt) { *(f32x4*)(e + 16 * nt + 4 * q) = zr[nt]; *(f32x4*)(e + 64 + 16 * nt + 4 * q) = zi[nt]; }
            }
        } else {
            f32x4 h8[8];
#pragma unroll
            for (int nt = 0; nt < 4; ++nt)
#pragma unroll
                for (int r = 0; r < 4; ++r) { const float sr = row_shr<1>(zr[nt][r]), si = row_shr<1>(zi[nt][r]); h8[nt][r] = (j == 0) ? hpr[nt][r] : sr; h8[4 + nt][r] = (j == 0) ? hpi[nt][r] : si; }
            bf16x8 Hb[4];
#pragma unroll
            for (int s = 0; s < 4; ++s) Hb[s] = pack8(h8[2 * s], h8[2 * s + 1]);
            bf16_t* yo = yg + ((size_t)tile * 256 + 16 * j) * 512 + 16 * g + 4 * q;
#pragma unroll
            for (int i = 0; i < 16; ++i) {
                f32x4 c = (f32x4){0.f, 0.f, 0.f, 0.f};
#pragma unroll
                for (int ks = 0; ks <= i / 2; ++ks) c = __builtin_amdgcn_mfma_f32_16x16x32_bf16(*(const LAS bf16x8*)(F.lds + SSM_TD + ((i - 2 * ks) * 64 + lane) * 16), Bv[ks], c, 0, 0, 0);
#pragma unroll
                for (int s = 0; s < 4; ++s) c = __builtin_amdgcn_mfma_f32_16x16x32_bf16(*(const LAS bf16x8*)(F.lds + SSM_WO + ((i * 4 + s) * 64 + lane) * 16), Hb[s], c, 0, 0, 0);
                u32x2 w; w.x = pk2(gelu_tanh(c[0]), gelu_tanh(c[1])); w.y = pk2(gelu_tanh(c[2]), gelu_tanh(c[3]));
                *(u32x2*)(yo + (size_t)i * 512) = w;
            }
            PACC(F, 6);
        }
    }
    __syncthreads();
}

template <class RM>
DI void tr_item(const float* W, int K, int ld, int nblk, bf16_t* WT, const float* kscale, RM rm, LAS float* scr, int item, int lane) {
    const int kb = item / nblk, nb = item % nblk, k0 = 64 * kb, n0 = 64 * nb;
    f32x4 v[16];
#pragma unroll
    for (int i = 0; i < 16; ++i) v[i] = *(const f32x4*)(W + (size_t)(k0 + 4 * i + (lane >> 4)) * ld + n0 + 4 * (lane & 15));
#pragma unroll
    for (int i = 0; i < 16; ++i) { const int kk = 4 * i + (lane >> 4); const float s = kscale ? kscale[k0 + kk] : 1.f; LAS float* d = scr + kk * 65 + 4 * (lane & 15);
        d[0] = v[i].x * s; d[1] = v[i].y * s; d[2] = v[i].z * s; d[3] = v[i].w * s; }
    LDS_WAIT(); asm volatile("" ::: "memory");
    const int c = lane & 7;
#pragma unroll
    for (int j = 0; j < 8; ++j) { const int n = (lane >> 3) + 8 * j; const LAS float* s = scr + (8 * c) * 65 + n;
        u32x4 o; o.x = pk2(s[0 * 65], s[1 * 65]); o.y = pk2(s[2 * 65], s[3 * 65]); o.z = pk2(s[4 * 65], s[5 * 65]); o.w = pk2(s[6 * 65], s[7 * 65]);
        *(u32x4*)(WT + (size_t)rm(n0 + n) * K + k0 + 8 * c) = o; }
    LDS_WAIT(); asm volatile("" ::: "memory");
}
struct RmId { int off; DI int operator()(int n) const { return off + n; } };
struct RmIl { int off; DI int operator()(int n) const { return 8 * (n >> 2) + (n & 3) + off; } };
DI void rms_rows4_to_bf16(const float* x, bf16_t* o, int lane, float* rms0) {
    f32x4 v[4][4]; float s[4];
#pragma unroll
    for (int u = 0; u < 4; ++u)
#pragma unroll
        for (int j = 0; j < 4; ++j) v[u][j] = __builtin_nontemporal_load((const f32x4*)(x + (size_t)u * 1024) + lane + 64 * j);
#pragma unroll
    for (int u = 0; u < 4; ++u) { float t = 0.f;
#pragma unroll
        for (int j = 0; j < 4; ++j) t += (v[u][j].x * v[u][j].x + v[u][j].y * v[u][j].y) + (v[u][j].z * v[u][j].z + v[u][j].w * v[u][j].w);
        s[u] = sqrtf(wave_sum(t) * (1.f / 1024.f) + EPS); }
    if (rms0 && lane == 0) { rms0[0] = s[0]; rms0[1] = s[1]; rms0[2] = s[2]; rms0[3] = s[3]; }
#pragma unroll
    for (int u = 0; u < 4; ++u) { const float r = 1.f / s[u]; u32x2* p = (u32x2*)(o + (size_t)u * 1024) + lane;
#pragma unroll
        for (int j = 0; j < 4; ++j) { u32x2 a; a.x = pk2(v[u][j].x * r, v[u][j].y * r); a.y = pk2(v[u][j].z * r, v[u][j].w * r); p[64 * j] = a; } }
}
DI void fold_item(const Args& a, Frame& F, int g, int kb) {
    LAS float* pwl = (LAS float*)(F.lds); LAS float* wl = pwl + 128 * 128;
    const float* win = a.in[I_WIN]; const float* pw = a.in[I_POOLW] + (size_t)g * 16384;
    __syncthreads();
    for (int i = F.tid; i < 4096; i += 512) *(LAS f32x4*)(pwl + 4 * i) = *(const f32x4*)(pw + 4 * i);
    for (int i = F.tid; i < 2048; i += 512) { const int k = i >> 5, c4 = (i & 31) * 4; *(LAS f32x4*)(wl + k * 128 + c4) = *(const f32x4*)(win + (size_t)(64 * kb + k) * 3072 + g * 128 + c4); }
    __syncthreads();
    const int d = F.tid & 127, kq = F.tid >> 7;
    float acc[16];
#pragma unroll
    for (int j = 0; j < 16; ++j) acc[j] = 0.f;
    for (int c = 0; c < 128; c += 4) {
        const float p0 = pwl[c * 128 + d], p1 = pwl[(c + 1) * 128 + d], p2 = pwl[(c + 2) * 128 + d], p3 = pwl[(c + 3) * 128 + d];
#pragma unroll
        for (int j = 0; j < 16; ++j) { const f32x4 w = *(const LAS f32x4*)(wl + (kq * 16 + j) * 128 + c); acc[j] += (w.x * p0 + w.y * p1) + (w.z * p2 + w.w * p3); }
    }
    const int n = g * 128 + d, k0 = 64 * kb + kq * 16; const float sc = a.in[I_POOLS][n]; const float* nm = a.in[I_NMIX] + k0;
    bf16_t* o = (bf16_t*)(F.ws + WS_W1T) + (size_t)n * 1024 + k0;
    u32x4 w0, w1;
    w0.x = pk2(acc[0] * sc * nm[0], acc[1] * sc * nm[1]); w0.y = pk2(acc[2] * sc * nm[2], acc[3] * sc * nm[3]); w0.z = pk2(acc[4] * sc * nm[4], acc[5] * sc * nm[5]); w0.w = pk2(acc[6] * sc * nm[6], acc[7] * sc * nm[7]);
    w1.x = pk2(acc[8] * sc * nm[8], acc[9] * sc * nm[9]); w1.y = pk2(acc[10] * sc * nm[10], acc[11] * sc * nm[11]); w1.z = pk2(acc[12] * sc * nm[12], acc[13] * sc * nm[13]); w1.w = pk2(acc[14] * sc * nm[14], acc[15] * sc * nm[15]);
    *(u32x4*)o = w0; *(u32x4*)(o + 8) = w1;
}
DI void p0_prologue(const Args& a, Frame& F) {
    unsigned char* ws = F.ws;
    const int gw = F.vcu * NWAVES + F.wave, NGW = F.G * NWAVES, lane = F.lane;
    for (int it = F.vcu; it < 64; it += F.G) fold_item(a, F, it >> 4, it & 15);
    __syncthreads();
    LAS float* scr = (LAS float*)(F.lds + F.wave * 16640);
    constexpr int IA = 16 * 8;
    constexpr int IB = IA + 16 * 16;
    constexpr int I0 = IB + 16 * 16;
    constexpr int I1 = I0 + 8 * 8;
    constexpr int I2 = I1 + 8 * 16;
    constexpr int I3 = I2 + 8 * 16;
    constexpr int I4 = I3 + 16 * 16;
    constexpr int I5 = I4 + 16 * 16;
    constexpr int I6 = I5 + 16 * 32;
    constexpr int I7 = I6 + 16 * 16;
    constexpr int I8 = I7 + 16 * 128;
    constexpr int I9 = I8 + 16 * 128;
    constexpr int I10 = I9 + 16 * 128;
    constexpr int NE_ = I0 + 16 * 32;
    const int toff = (F.G == 256) ? 112 * NWAVES : 0, moff = 0;
    for (int it = gw - toff; it < NE_; it += NGW) {
        if (it < 0) continue;
        if (it < IA) tr_item(a.in[I_WIN] + 512, 1024, 3072, 8, (bf16_t*)(ws + WS_W1T), a.in[I_NMIX], RmId{512}, scr, it, lane);
        else if (it < IB) tr_item(a.in[I_WIN] + 1024, 1024, 3072, 16, (bf16_t*)(ws + WS_W1T), a.in[I_NMIX], RmIl{1024}, scr, it - IA, lane);
        else if (it < I0) tr_item(a.in[I_WIN] + 2048, 1024, 3072, 16, (bf16_t*)(ws + WS_W1T), a.in[I_NMIX], RmIl{1028}, scr, it - IB, lane);
        else tr_item(a.in[I_WKV], 1024, 2048, 32, (bf16_t*)(ws + WS_WKV), a.in[I_NMEM], RmId{0}, scr, it - I0, lane);
    }
    (void)I1; (void)I2; (void)I3; (void)I4; (void)I5; (void)I6; (void)I7;
    (void)I8; (void)I9; (void)I10;
    {
        bf16_t* rt = (bf16_t*)(ws + WS_RT); const float* nf = a.in[I_NFFN];
        for (int it = F.vcu * 512 + F.tid; it < 32768; it += F.G * 512) {
            const int j = it & 7, l = (it >> 3) & 63, nt = (it >> 9) & 1, b = it >> 10, o = 16 * nt + (l & 15), k = 64 * (b >> 1) + 16 * (l >> 4) + 8 * (b & 1) + j;
            const float w = o < 20 ? nf[k] * (o < 4 ? a.in[I_RGW][k * 4 + o] : a.in[I_REW][k * 16 + (o - 4)]) : 0.f;
            const unsigned hi = pk2(w, 0.f) & 0xffffu, lo = pk2(w - bf2f(hi), 0.f) & 0xffffu;
            rt[(((b * 2 + nt) * 2 + 0) * 64 + l) * 8 + j] = (bf16_t)hi; rt[(((b * 2 + nt) * 2 + 1) * 64 + l) * 8 + j] = (bf16_t)lo;
        }
    }
    if (F.G == 256) {
        if (F.vcu >= 112) { const int wb = (F.vcu - 112) * NWAVES + F.wave;
            for (int q = 5 * wb; q < 5 * wb + 5; ++q) rms_rows4_to_bf16(a.in[I_X] + (size_t)q * 4 * D, (bf16_t*)(ws + WS_A) + (size_t)q * 4 * D, lane, (float*)(ws + WS_RMSX) + 4 * q); }
        else if (F.vcu >= 64) { const int wc = (F.vcu - 64) * NWAVES + F.wave;
            for (int q = 5760 + wc; q < T / 4; q += 48 * NWAVES) rms_rows4_to_bf16(a.in[I_X] + (size_t)q * 4 * D, (bf16_t*)(ws + WS_A) + (size_t)q * 4 * D, lane, (float*)(ws + WS_RMSX) + 4 * q); }
    } else
    for (int m = 4 * gw; m < T; m += 4 * NGW) rms_rows4_to_bf16(a.in[I_X] + (size_t)m * D, (bf16_t*)(ws + WS_A) + (size_t)m * D, lane, (float*)(ws + WS_RMSX) + m);
    for (int m = 4 * (gw - moff); m < MROWS; m += 4 * NGW) if (m >= 0) rms_rows4_to_bf16(a.in[I_MEM] + (size_t)m * D, (bf16_t*)(ws + WS_MEMN) + (size_t)m * D, lane, nullptr);
}

DI void p2_pool(Frame& F, int first, int count) {
    const bf16_t* zw = (const bf16_t*)(F.ws + WS_ZW); bf16_t* yp = (bf16_t*)(F.ws + WS_YP);
    for (int it = (F.vcu - first) * 512 + F.tid; it < (T / 16) * 64; it += count * 512) {
        const int t0 = (it >> 6) * 16, ch = (it & 63) * 8, s0 = t0 & (SEQ - 1), w = 2 << (ch >> 7);
        const bf16_t* zc = zw + ch;
        f32x4 a0 = {0.f, 0.f, 0.f, 0.f}, a1 = {0.f, 0.f, 0.f, 0.f};
        {
            u32x4 raw[16];
#pragma unroll
            for (int j = 1; j <= 16; ++j) { const int jj = (j <= w && j <= s0) ? j : 0; raw[j - 1] = *(const u32x4*)(zc + (size_t)(t0 - jj) * 512); }
#pragma unroll
            for (int j = 1; j <= 16; ++j) {
                const u32x4 w4 = raw[j - 1]; const float mk = (j <= w && j <= s0) ? 1.f : 0.f;
                a0[0] += mk * bf2f(w4.x & 0xffffu); a0[1] += mk * bf2f(w4.x >> 16); a0[2] += mk * bf2f(w4.y & 0xffffu); a0[3] += mk * bf2f(w4.y >> 16);
                a1[0] += mk * bf2f(w4.z & 0xffffu); a1[1] += mk * bf2f(w4.z >> 16); a1[2] += mk * bf2f(w4.w & 0xffffu); a1[3] += mk * bf2f(w4.w >> 16);
            }
        }
        u32x4 nw[16], od[16];
#pragma unroll
        for (int i = 0; i < 16; ++i) { nw[i] = *(const u32x4*)(zc + (size_t)(t0 + i) * 512);
            const int lv = (s0 + i >= w) ? (t0 + i - w) : t0;
            od[i] = *(const u32x4*)(zc + (size_t)lv * 512); }
#pragma unroll
        for (int i = 0; i < 16; ++i) {
            f32x4 z0, z1, o0, o1;
            z0[0] = bf2f(nw[i].x & 0xffffu); z0[1] = bf2f(nw[i].x >> 16); z0[2] = bf2f(nw[i].y & 0xffffu); z0[3] = bf2f(nw[i].y >> 16);
            z1[0] = bf2f(nw[i].z & 0xffffu); z1[1] = bf2f(nw[i].z >> 16); z1[2] = bf2f(nw[i].w & 0xffffu); z1[3] = bf2f(nw[i].w >> 16);
            o0[0] = bf2f(od[i].x & 0xffffu); o0[1] = bf2f(od[i].x >> 16); o0[2] = bf2f(od[i].y & 0xffffu); o0[3] = bf2f(od[i].y >> 16);
            o1[0] = bf2f(od[i].z & 0xffffu); o1[1] = bf2f(od[i].z >> 16); o1[2] = bf2f(od[i].w & 0xffffu); o1[3] = bf2f(od[i].w >> 16);
            const float mk = (s0 + i >= w) ? 1.f : 0.f;
            a0 += z0 - o0 * mk; a1 += z1 - o1 * mk;
            const int cnt = (s0 + i + 1 < w) ? s0 + i + 1 : w; const float inv = 1.f / (float)cnt;
            store8bf(yp + (size_t)(t0 + i) * 512 + ch, a0 * inv - z0, a1 * inv - z1);
        }
    }
}
DI void p2_ssm_naive(const Args& a, Frame& F) {
    if (F.wave != 0) return;
    const bf16_t* vs = (const bf16_t*)(F.ws + WS_VS); bf16_t* yg = (bf16_t*)(F.ws + WS_YG);
    const int n = F.lane;
    for (int item = F.vcu; item < BATCH * NSG; item += F.G) {
        const int b = item >> 5, g = item & 31;
        const float dt = expf(a.in[I_LOGDT][g]), ar = a.in[I_ARE][g * 64 + n], ai = a.in[I_AIM][g * 64 + n];
        const float mag = expf(ar * dt); float sn, cs; sincosf(ai * dt, &sn, &cs);
        const float lr = mag * cs, li = mag * sn, den = ar * ar + ai * ai, nr = lr - 1.f, ni = li;
        const float fre = (nr * ar + ni * ai) / den, fim = (ni * ar - nr * ai) / den;
        float bbr[16], bbi[16], cr[16], ci[16], dsk[16];
#pragma unroll
        for (int c = 0; c < 16; ++c) {
            const float br = a.in[I_BRE][(size_t)(g * 64 + n) * 16 + c], bi = a.in[I_BIM][(size_t)(g * 64 + n) * 16 + c];
            bbr[c] = fre * br - fim * bi; bbi[c] = fre * bi + fim * br;
            cr[c] = a.in[I_CRE][(size_t)(g * 16 + c) * 64 + n]; ci[c] = a.in[I_CIM][(size_t)(g * 16 + c) * 64 + n];
            dsk[c] = (n == 0) ? a.in[I_SD][g * 16 + c] : 0.f;
        }
        float hr = 0.f, hi = 0.f;
        const int myc = (((n >> 5) & 1) << 3) | (((n >> 4) & 1) << 2) | (((n >> 3) & 1) << 1) | ((n >> 2) & 1);
        for (int s = 0; s < SEQ; ++s) {
            const size_t t = (size_t)b * SEQ + s;
            f32x4 va, vb, vc, vd; load8bf(vs + ((size_t)g * T + t) * 16, va, vb); load8bf(vs + ((size_t)g * T + t) * 16 + 8, vc, vd);
            float v[16];
#pragma unroll
            for (int j = 0; j < 4; ++j) { v[j] = va[j]; v[4 + j] = vb[j]; v[8 + j] = vc[j]; v[12 + j] = vd[j]; }
            float ur = 0.f, ui = 0.f;
#pragma unroll
            for (int c = 0; c < 16; ++c) { ur += bbr[c] * v[c]; ui += bbi[c] * v[c]; }
            const float nhr = lr * hr - li * hi + ur, nhi = lr * hi + li * hr + ui; hr = nhr; hi = nhi;
            float p[16];
#pragma unroll
            for (int c = 0; c < 16; ++c) p[c] = cr[c] * hr - ci[c] * hi + dsk[c] * v[c];
#pragma unroll
            for (int i = 0; i < 8; ++i) { const bool up = (n & 32) != 0; const float keep = up ? p[i + 8] : p[i], send = up ? p[i] : p[i + 8]; p[i] = keep + __shfl_xor(send, 32); }
#pragma unroll
            for (int i = 0; i < 4; ++i) { const bool up = (n & 16) != 0; const float keep = up ? p[i + 4] : p[i], send = up ? p[i] : p[i + 4]; p[i] = keep + __shfl_xor(send, 16); }
#pragma unroll
            for (int i = 0; i < 2; ++i) { const bool up = (n & 8) != 0; const float keep = up ? p[i + 2] : p[i], send = up ? p[i] : p[i + 2]; p[i] = keep + __shfl_xor(send, 8); }
            { const bool up = (n & 4) != 0; const float keep = up ? p[1] : p[0], send = up ? p[0] : p[1]; p[0] = keep + __shfl_xor(send, 4); }
            float y = p[0]; y += __shfl_xor(y, 1); y += __shfl_xor(y, 2);
            if ((n & 3) == 0) yg[t * 512 + g * 16 + myc] = (bf16_t)f2bf(gelu_tanh(y));
        }
    }
}


typedef float f32x16 __attribute__((ext_vector_type(16)));
DI void build_vf(Frame& F, int first, int count) {
    const bf16_t* vrm = (const bf16_t*)(F.ws + WS_VRM); bf16_t* vf = (bf16_t*)(F.ws + WS_VT);
    for (int it = (F.vcu - first) * 512 + F.tid; it < 16 * 8 * 16 * 64; it += count * 512) {
        const int l = it & 63, kk = (it >> 6) & 15, dt = (it >> 10) & 7, bh = it >> 13, b = bh >> 2, h = bh & 3, d = 32 * dt + (l & 31), hh = l >> 5;
        unsigned short e[8];
#pragma unroll
        for (int jj = 0; jj < 8; ++jj) { const int key = 16 * kk + 8 * (jj >> 2) + 4 * hh + (jj & 3); e[jj] = vrm[(size_t)(b * 256 + key) * 1024 + h * 256 + d]; }
        u32x4 w; w.x = e[0] | ((unsigned)e[1] << 16); w.y = e[2] | ((unsigned)e[3] << 16); w.z = e[4] | ((unsigned)e[5] << 16); w.w = e[6] | ((unsigned)e[7] << 16);
        *(u32x4*)(vf + (size_t)it * 8) = w;
    }
}
DI void attn_unit(Frame& F, const int L) {
    bf16_t* qo = (bf16_t*)(F.ws + WS_Q); const float* ssq8 = (const float*)(F.ws + WS_SSQ8);
    {
        int lane = F.lane; asm volatile("" : "+v"(lane));
        const int c = lane & 31, h2 = lane >> 5;
        const int bh = L >> 5, tq = L & 31, b = bh >> 2, h = bh & 3;
        const size_t trow = (size_t)(b * 32 + tq) * 256 + F.wave * 32 + c;
        __syncthreads();
        stage_lds(F.lds, F.ws + WS_KC + (size_t)bh * 131072, 131072, F.wave, lane);
        float ss = 0.f;
        { const f32x4* sp = (const f32x4*)(ssq8 + trow * 32 + h2 * 16);
#pragma unroll
          for (int i = 0; i < 4; ++i) { const f32x4 t = sp[i]; ss += (t.x + t.y) + (t.z + t.w); } }
        ss += __shfl_xor(ss, 32);
        const float qscale = 0.0625f / sqrtf(ss * (1.f / 1024.f) + EPS);
        const bf16_t* qp = qo + trow * 1024 + h * 256 + 8 * h2;
        bf16x8 Qa[8];
#pragma unroll
        for (int ds = 0; ds < 8; ++ds) Qa[ds] = *(const bf16x8*)(qp + ds * 16);
        VM_WAIT(); __syncthreads();
        f32x16 st[8];
#pragma unroll
        for (int kt = 0; kt < 8; ++kt)
#pragma unroll
            for (int r = 0; r < 16; ++r) st[kt][r] = 0.f;
#pragma unroll
        for (int ds = 0; ds < 16; ++ds) {
            const bf16x8 qv = Qa[ds & 7];
            if (ds < 8) Qa[ds & 7] = *(const bf16x8*)(qp + (ds + 8) * 16);
#pragma unroll
            for (int kt = 0; kt < 8; ++kt)
                st[kt] = __builtin_amdgcn_mfma_f32_32x32x16_bf16(*(const LAS bf16x8*)(F.lds + ((kt * 16 + ds) * 64 + lane) * 16), qv, st[kt], 0, 0, 0);
            __builtin_amdgcn_sched_barrier(0);
        }
        __syncthreads();
        stage_lds(F.lds, F.ws + WS_VT + (size_t)bh * 131072, 131072, F.wave, lane);
        float m = -3.0e38f;
#pragma unroll
        for (int kt = 0; kt < 8; ++kt)
#pragma unroll
            for (int r = 0; r < 16; ++r) m = fmaxf(m, st[kt][r]);
        m = fmaxf(m, __shfl_xor(m, 32));
        const float cs = qscale * 1.4426950408889634f, mc = -m * cs;
        float l = 0.f;
#pragma unroll
        for (int kt = 0; kt < 8; ++kt)
#pragma unroll
            for (int r = 0; r < 16; ++r) { const float p = __builtin_amdgcn_exp2f(__builtin_fmaf(st[kt][r], cs, mc)); st[kt][r] = p; l += p; }
        l += __shfl_xor(l, 32);
        const float il = 1.f / l;
        bf16x8 Pb[16];
#pragma unroll
        for (int kt = 0; kt < 8; ++kt)
#pragma unroll
            for (int s = 0; s < 2; ++s) {
                u32x4 w; w.x = pk2(st[kt][8 * s + 0], st[kt][8 * s + 1]); w.y = pk2(st[kt][8 * s + 2], st[kt][8 * s + 3]); w.z = pk2(st[kt][8 * s + 4], st[kt][8 * s + 5]); w.w = pk2(st[kt][8 * s + 6], st[kt][8 * s + 7]);
                Pb[kt * 2 + s] = __builtin_bit_cast(bf16x8, w);
            }
        VM_WAIT(); __syncthreads();
#pragma unroll
        for (int half = 0; half < 2; ++half) {
            f32x16 oacc[4];
#pragma unroll
            for (int d4 = 0; d4 < 4; ++d4) {
                const int dt = 4 * half + d4;
#pragma unroll
                for (int r = 0; r < 16; ++r) oacc[d4][r] = 0.f;
#pragma unroll
                for (int kk = 0; kk < 16; ++kk)
                    oacc[d4] = __builtin_amdgcn_mfma_f32_32x32x16_bf16(*(const LAS bf16x8*)(F.lds + ((dt * 16 + kk) * 64 + lane) * 16), Pb[kk], oacc[d4], 0, 0, 0);
            }
            __syncthreads();
            LAS unsigned char* ob = F.lds + half * 65536 + F.wave * 8192;
#pragma unroll
            for (int d4 = 0; d4 < 4; ++d4)
#pragma unroll
                for (int g4 = 0; g4 < 4; ++g4) {
                    u32x2 w; w.x = pk2(oacc[d4][4 * g4 + 0] * il, oacc[d4][4 * g4 + 1] * il); w.y = pk2(oacc[d4][4 * g4 + 2] * il, oacc[d4][4 * g4 + 3] * il);
                    *(LAS u32x2*)(ob + c * 256 + (((4 * d4 + g4) ^ (c & 7)) << 4) + 8 * h2) = w;
                }
            LDS_WAIT(); __builtin_amdgcn_wave_barrier();
            bf16_t* op = qo + ((size_t)(b * 32 + tq) * 256 + F.wave * 32 + (lane >> 4)) * 1024 + h * 256 + half * 128 + (lane & 15) * 8;
            asm volatile("" : "+v"(op));
#pragma unroll 4
            for (int j = 0; j < 8; ++j) {
                const int row = 4 * j + (lane >> 4), ch = lane & 15;
                const u32x4 w = *(const LAS u32x4*)(ob + row * 256 + ((ch ^ (row & 7)) << 4));
                *(u32x4*)(op + (size_t)j * 4096) = w;
            }
        }
    }
}

DI void p9_router(const Args& a, Frame& F) {
    const bf16_t* hb = (const bf16_t*)(F.ws + WS_A);
    int* ptok = (int*)(F.ws + WS_PTOK); float* pscale = (float*)(F.ws + WS_PSCALE); int* tslot = (int*)(F.ws + WS_TSLOT); float* tcomb = (float*)(F.ws + WS_TCOMB);
    LAS float* lgw = (LAS float*)(F.lds + 131072 + F.wave * 2048);
    LAS int* rec_e = (LAS int*)(F.lds + 147456);
    LAS float* rec_w = (LAS float*)(F.lds + 147456 + 1024);
    LAS float* rec_s = (LAS float*)(F.lds + 147456 + 2048);
    LAS int* wc = (LAS int*)(F.lds + 147456 + 2560);
    const int lane = F.lane, r = lane & 15, q = lane >> 4;
    __syncthreads();
    stage_lds(F.lds, F.ws + WS_RT, 131072, F.wave, lane);
    VM_WAIT(); __syncthreads();
    for (int chunk = F.vcu; chunk < T / 128; chunk += F.G) {
        {
            const int t0 = chunk * 128 + F.wave * 16;
            const bf16_t* hp = hb + (size_t)(t0 + r) * 1024 + 16 * q;
            f32x4 ac[2][2]; float ss = 0.f;
#pragma unroll
            for (int i = 0; i < 4; ++i) ac[i >> 1][i & 1] = f32x4{0.f, 0.f, 0.f, 0.f};
            u32x4 hraw[16][2];
#pragma unroll
            for (int cc = 0; cc < 16; ++cc) { hraw[cc][0] = __builtin_nontemporal_load((const u32x4*)(hp + cc * 64)); hraw[cc][1] = __builtin_nontemporal_load((const u32x4*)(hp + cc * 64 + 8)); }
#pragma unroll
            for (int cc = 0; cc < 16; ++cc) {
#pragma unroll
                for (int hh = 0; hh < 2; ++hh) { const u32x4 w4 = hraw[cc][hh];
#pragma unroll
                    for (int i = 0; i < 4; ++i) { const float lo = __uint_as_float(w4[i] << 16), hi = __uint_as_float(w4[i] & 0xffff0000u); ss += lo * lo + hi * hi; }
                    const bf16x8 av = __builtin_bit_cast(bf16x8, w4);
#pragma unroll
                    for (int i = 0; i < 4; ++i)
                        ac[i >> 1][i & 1] = __builtin_amdgcn_mfma_f32_16x16x32_bf16(av, *(const LAS bf16x8*)(F.lds + ((((cc * 2 + hh) * 2 + (i >> 1)) * 2 + (i & 1)) * 64 + lane) * 16), ac[i >> 1][i & 1], 0, 0, 0);
                }
            }
            const f32x4 acc0 = ac[0][0] + ac[0][1], acc1 = ac[1][0] + ac[1][1];
            ss += __shfl_xor(ss, 16); ss += __shfl_xor(ss, 32);
            const float inv = 1.f / sqrtf(ss * (1.f / 1024.f) + EPS);
#pragma unroll
            for (int g2 = 0; g2 < 4; ++g2) { lgw[(4 * q + g2) * 32 + r] = acc0[g2]; lgw[(4 * q + g2) * 32 + 16 + r] = acc1[g2]; }
            LDS_WAIT(); __builtin_amdgcn_wave_barrier();
            if (lane < 16) {
                const int lt = F.wave * 16 + lane;
                float lg[20];
#pragma unroll
                for (int o = 0; o < 20; ++o) lg[o] = lgw[lane * 32 + o] * inv;
                float rgb[4], reb[16];
#pragma unroll
                for (int j = 0; j < 4; ++j) rgb[j] = a.in[I_RGB][j];
#pragma unroll
                for (int j = 0; j < 16; ++j) reb[j] = a.in[I_REB][j];
#pragma unroll
                for (int j = 0; j < 16; ++j) asm volatile("" : "+v"(reb[j]));
                float gl[4]; int gi = 0;
#pragma unroll
                for (int j = 0; j < 4; ++j) gl[j] = lg[j] + rgb[j];
                float gm = gl[0];
#pragma unroll
                for (int j = 1; j < 4; ++j) if (gl[j] > gm) { gm = gl[j]; gi = j; }
                float gs = 0.f;
#pragma unroll
                for (int j = 0; j < 4; ++j) gs += __expf(gl[j] - gm);
                const float gate = 1.f / gs;
                float el[4];
#pragma unroll
                for (int j = 0; j < 4; ++j) {
                    float x = 0.f;
#pragma unroll
                    for (int g2 = 0; g2 < 4; ++g2) x = (gi == g2) ? lg[4 + g2 * 4 + j] + reb[g2 * 4 + j] : x;
                    el[j] = x;
                }
                int i1 = 0; float v1 = el[0];
#pragma unroll
                for (int j = 1; j < 4; ++j) if (el[j] > v1) { v1 = el[j]; i1 = j; }
                int i2 = -1; float v2 = -3.0e38f;
#pragma unroll
                for (int j = 0; j < 4; ++j) if (j != i1 && el[j] > v2) { v2 = el[j]; i2 = j; }
                const float ex = __expf(v2 - v1), w1 = 1.f / (1.f + ex), w2 = ex * w1;
                rec_e[lt * 2 + 0] = gi * 4 + i1; rec_e[lt * 2 + 1] = gi * 4 + i2;
                rec_w[lt * 2 + 0] = w1 * gate; rec_w[lt * 2 + 1] = w2 * gate; rec_s[lt] = inv;
            }
        }
        __syncthreads();
        const int p = F.tid, ep = (p < 256) ? rec_e[p] : -1;
        int myrank = 0;
        {
            const unsigned long long ltmask = (lane == 0) ? 0ull : (~0ull >> (64 - lane));
#pragma unroll
            for (int e = 0; e < 16; ++e) {
                const unsigned long long mk = __ballot(ep == e);
                if (ep == e) myrank = __popcll(mk & ltmask);
                if (lane == e && F.wave < 4) wc[F.wave * 16 + e] = __popcll(mk);
            }
        }
        __syncthreads();
        if (F.tid < 16) {
            const int e = F.tid; const int c0 = wc[e], c1 = wc[16 + e], c2 = wc[32 + e], c3 = wc[48 + e], n = c0 + c1 + c2 + c3;
            int base = 0;
            if (n > 0) base = (int)__hip_atomic_fetch_add((unsigned*)(F.ctl + CW_CNT + 64 * e), (unsigned)n, RLX_AGENT);
            wc[e] = base; wc[16 + e] = base + c0; wc[32 + e] = base + c0 + c1; wc[48 + e] = base + c0 + c1 + c2;
        }
        __syncthreads();
        if (p < 256) {
            const int slot = wc[F.wave * 16 + ep] + myrank, t = chunk * 128 + (p >> 1);
            ptok[ep * T + slot] = t; pscale[ep * T + slot] = rec_s[p >> 1];
            tslot[chunk * 256 + p] = (ep << 16) | slot; tcomb[chunk * 256 + p] = rec_w[p];
        }
        __syncthreads();
    }
}
DI void moe_prefix(Frame& F) {
    volatile LAS int* tp = (volatile LAS int*)(F.lds + XTAB_OFF);
    __syncthreads();
    if (F.tid < 64) {
        const int e = F.tid & 15;
        const int c = (int)__hip_atomic_load((unsigned*)(F.ctl + CW_CNT + 64 * e), RLX_AGENT);
        const int t = (c + 255) >> 8;
        int inc = t;
#pragma unroll
        for (int d = 1; d < 16; d <<= 1) { const int o = __shfl_up(inc, d, 16); if ((F.tid & 15) >= d) inc += o; }
        if (F.tid < 16) { tp[e] = inc - t; tp[32 + e] = c; if (e == 15) tp[16] = inc; }
    }
    __syncthreads();
}
DI void p12_final(const Args& a, Frame& F) {
    const bf16_t* pkr = (const bf16_t*)(F.ws + WS_PKR); const float* nf = a.in[I_NFIN];
    const bf16_t* hb = (const bf16_t*)(F.ws + WS_A); const int* tslot = (const int*)(F.ws + WS_TSLOT); const float* tcomb = (const float*)(F.ws + WS_TCOMB);
    const volatile LAS int* tp = (const volatile LAS int*)(F.lds + XTAB_OFF);
    const int lane = F.lane, gw = F.vcu * NWAVES + F.wave, NGW = F.G * NWAVES;
    f32x4 gn[4];
#pragma unroll
    for (int j = 0; j < 4; ++j) gn[j] = *((const f32x4*)nf + lane + 64 * j);
    for (int m0 = 4 * gw; m0 < T; m0 += 4 * NGW) {
        int sl[8]; float cw[8];
        { const int4 s0 = *(const int4*)(tslot + 2 * m0), s1 = *(const int4*)(tslot + 2 * m0 + 4); const f32x4 c0 = *(const f32x4*)(tcomb + 2 * m0), c1 = *(const f32x4*)(tcomb + 2 * m0 + 4);
          sl[0] = s0.x; sl[1] = s0.y; sl[2] = s0.z; sl[3] = s0.w; sl[4] = s1.x; sl[5] = s1.y; sl[6] = s1.z; sl[7] = s1.w;
          cw[0] = c0[0]; cw[1] = c0[1]; cw[2] = c0[2]; cw[3] = c0[3]; cw[4] = c1[0]; cw[5] = c1[1]; cw[6] = c1[2]; cw[7] = c1[3]; }
        u32x2 hq[4][4], p[4][4], r[4][4];
#pragma unroll
        for (int u = 0; u < 4; ++u) {
            const size_t m = (size_t)(m0 + u);
            const size_t r0 = (size_t)(tp[sl[2 * u] >> 16] * 256 + (sl[2 * u] & 0xffff)), r1 = (size_t)(tp[sl[2 * u + 1] >> 16] * 256 + (sl[2 * u + 1] & 0xffff));
#pragma unroll
            for (int j = 0; j < 4; ++j) { hq[u][j] = __builtin_nontemporal_load((const u32x2*)(hb + m * 1024) + lane + 64 * j);
                p[u][j] = __builtin_nontemporal_load((const u32x2*)(pkr + r0 * 1024) + lane + 64 * j); r[u][j] = __builtin_nontemporal_load((const u32x2*)(pkr + r1 * 1024) + lane + 64 * j); }
        }
#pragma unroll
        for (int u = 0; u < 4; ++u) {
            const float c0 = cw[2 * u], c1 = cw[2 * u + 1];
            f32x4 v[4]; float ss = 0.f;
#pragma unroll
            for (int j = 0; j < 4; ++j) {
                v[j].x = bf2f(hq[u][j].x & 0xffffu) + c0 * bf2f(p[u][j].x & 0xffffu) + c1 * bf2f(r[u][j].x & 0xffffu); v[j].y = bf2f(hq[u][j].x >> 16) + c0 * bf2f(p[u][j].x >> 16) + c1 * bf2f(r[u][j].x >> 16);
                v[j].z = bf2f(hq[u][j].y & 0xffffu) + c0 * bf2f(p[u][j].y & 0xffffu) + c1 * bf2f(r[u][j].y & 0xffffu); v[j].w = bf2f(hq[u][j].y >> 16) + c0 * bf2f(p[u][j].y >> 16) + c1 * bf2f(r[u][j].y >> 16);
                ss += (v[j].x * v[j].x + v[j].y * v[j].y) + (v[j].z * v[j].z + v[j].w * v[j].w);
            }
            const float inv = 1.f / sqrtf(wave_sum(ss) * (1.f / 1024.f) + EPS);
            f32x4* hr = (f32x4*)(a.out + (size_t)(m0 + u) * 1024) + lane;
#pragma unroll
            for (int j = 0; j < 4; ++j) __builtin_nontemporal_store(v[j] * inv * gn[j], hr + 64 * j);
        }
    }
#if PROBE_ON
    if (F.bid == 0 && F.tid == 0) {
        unsigned long long* ts = (unsigned long long*)(F.ws + WS_TS);
        asm volatile("s_waitcnt vmcnt(0)" ::: "memory"); ts[15] = __builtin_amdgcn_s_memrealtime();
#if PROBE_HI == 998
        const unsigned long long d = 4ull * ts[512 + PROBE_LO], t0 = __builtin_amdgcn_s_memrealtime();
#elif PROBE_HI == 999
        unsigned long long mx = 0ull, mn = ~0ull; for (int i = 0; i < F.G; ++i) { const unsigned long long v = ts[128 + i]; mx = v > mx ? v : mx; mn = v < mn ? v : mn; }
        const unsigned long long d = 4ull * (PROBE_LO == 0 ? mx : mn), t0 = __builtin_amdgcn_s_memrealtime();
#else
        const unsigned long long d = 4ull * (ts[PROBE_HI] - ts[PROBE_LO]), t0 = __builtin_amdgcn_s_memrealtime();
#endif
        while (__builtin_amdgcn_s_memrealtime() - t0 < d) __builtin_amdgcn_s_sleep(8);
    }
#endif
}

DI void late_ssm_tables(const Args& a, Frame& F) {
    const int skip = (F.G >= 128) ? 64 : ((F.G > 64) ? 32 : 0);
    if (F.bid < skip) return;
    if (F.G == 256) {
        const int w = F.bid - 64, g = w / 6, r = w - 6 * g;
        ssm_tables_item(a, F, g, r < 2 ? 2 * r : r + 2, r < 2 ? 2 : 1);
        return;
    }
    for (int it = F.bid - skip; it < 256; it += F.G - skip) ssm_tables_item(a, F, it >> 3, it & 7);
}
constexpr int W13_EARLY = 1024;
DI void w13_item(const Args& a, Frame& F, int it, LAS float* scr) {
    unsigned char* ws = F.ws; const int r = it & 2047, e = r >> 7;
    if (it < 2048) tr_item(a.in[I_W1] + (size_t)e * 1024 * 512, 1024, 512, 8, (bf16_t*)(ws + WS_W13) + (size_t)e * 1024 * 1024, a.in[I_NFFN], RmIl{0}, scr, r & 127, F.lane);
    else tr_item(a.in[I_W3] + (size_t)e * 1024 * 512, 1024, 512, 8, (bf16_t*)(ws + WS_W13) + (size_t)e * 1024 * 1024, a.in[I_NFFN], RmIl{4}, scr, r & 127, F.lane);
}
DI void early_w13(const Args& a, Frame& F) {
    const int skip = (F.G >= 128) ? 64 : ((F.G > 64) ? 32 : 0);
    if (F.bid < skip) return;
    LAS float* scr = (LAS float*)(F.lds + F.wave * 16640);
    __syncthreads();
    if (F.G == 256) {
        const int w = F.bid - 64, g = w / 6, r = w - 6 * g;
        if (r >= 2) w13_item(a, F, (g * 4 + (r - 2)) * NWAVES + F.wave, scr);
        return;
    }
    for (int it = (F.bid - skip) * NWAVES + F.wave; it < W13_EARLY; it += (F.G - skip) * NWAVES) w13_item(a, F, it, scr);
}
DI void late_w13(const Args& a, Frame& F, int first, int count) {
    LAS float* scr = (LAS float*)(F.lds + F.wave * 16640);
    __syncthreads();
    for (int it = W13_EARLY + (F.vcu - first) * NWAVES + F.wave; it < 2 * 2048; it += count * NWAVES) w13_item(a, F, it, scr);
}
DI void late_dense(const Args& a, Frame& F, int first, int count) {
    unsigned char* ws = F.ws; LAS float* scr = (LAS float*)(F.lds + F.wave * 16640); const int lane = F.lane;
    constexpr int J1 = 8 * 8, J2 = J1 + 8 * 16, J3 = J2 + 8 * 16, J4 = J3 + 16 * 16, J5 = J4 + 16 * 16, J6 = J5 + 16 * 16;
    __syncthreads();
    for (int it = (F.vcu - first) * NWAVES + F.wave; it < J6; it += count * NWAVES) {
        if (it < J1) tr_item(a.in[I_GLUW], 512, 512, 8, (bf16_t*)(ws + WS_WGLU), nullptr, RmId{0}, scr, it, lane);
        else if (it < J2) tr_item(a.in[I_BRP], 512, 1024, 16, (bf16_t*)(ws + WS_WBRP), nullptr, RmId{0}, scr, it - J1, lane);
        else if (it < J3) tr_item(a.in[I_BRS], 512, 1024, 16, (bf16_t*)(ws + WS_WBRS), nullptr, RmId{0}, scr, it - J2, lane);
        else if (it < J4) tr_item(a.in[I_WOUT], 1024, 1024, 16, (bf16_t*)(ws + WS_WOUT), nullptr, RmId{0}, scr, it - J3, lane);
        else if (it < J5) tr_item(a.in[I_WQ], 1024, 1024, 16, (bf16_t*)(ws + WS_WQ), a.in[I_NX], RmId{0}, scr, it - J4, lane);
        else tr_item(a.in[I_WO], 1024, 1024, 16, (bf16_t*)(ws + WS_WO), nullptr, RmId{0}, scr, it - J5, lane);
    }
}
DI void late_w2(const Args& a, Frame& F) {
    const volatile LAS int* tp = (const volatile LAS int*)(F.lds + XTAB_OFF);
    const int rem = (tp[16] * 4) % F.G, busy = (2 * rem <= F.G) ? 2 * rem : rem, first = (busy > 0 && busy < F.G - 8) ? busy : 0, nw = F.G - first;
    if (F.vcu < first) return;
    unsigned char* ws = F.ws; LAS float* scr = (LAS float*)(F.lds + F.wave * 16640);
    const int gw = (F.vcu - first) * NWAVES + F.wave, NGW = nw * NWAVES, lane = F.lane;
    __syncthreads();
    for (int it = gw; it < 2048; it += NGW) { const int e = it >> 7;
        tr_item(a.in[I_W2] + (size_t)e * 512 * 1024, 512, 1024, 16, (bf16_t*)(ws + WS_W2T) + (size_t)e * 1024 * 512, nullptr, RmId{0}, scr, it & 127, lane); }
    asm volatile("s_waitcnt vmcnt(0)" ::: "memory");
    __syncthreads();
    if (F.tid == 0) { __builtin_amdgcn_fence(__ATOMIC_RELEASE, "agent"); asm volatile("s_waitcnt vmcnt(0)" ::: "memory"); (void)xb_add((unsigned*)(F.ctl + CW_BAR) + XB_W2CNT, 1u); }
}
DI void w2_wait(Frame& F) {
    const volatile LAS int* tp = (const volatile LAS int*)(F.lds + XTAB_OFF);
    const int rem = (tp[16] * 4) % F.G, busy = (2 * rem <= F.G) ? 2 * rem : rem, first = (busy > 0 && busy < F.G - 8) ? busy : 0, nw = F.G - first;
    if (F.tid == 0) {
        unsigned* bar = (unsigned*)(F.ctl + CW_BAR);
        XB_SPIN(xb_ld(&bar[XB_W2CNT]) < (unsigned)nw, bar);
        __builtin_amdgcn_fence(__ATOMIC_ACQUIRE, "agent");
        asm volatile("s_waitcnt vmcnt(0)" ::: "memory");
    }
    __syncthreads();
}
constexpr int N_STEPS = 15;
constexpr int GEMM_STEPS = 0x35E6;
#ifndef SKIPMASK
#define SKIPMASK 0
#endif
#ifndef SSM_NAIVE
#define SSM_NAIVE 0
#endif
#ifndef MFMA_MASK
#define MFMA_MASK 0x35E6
#endif
DI bool use_mfma(int s) { return ((MFMA_MASK >> s) & 1) != 0; }
DI bool seam_after(int s) { return s != 1 && s != 4 && s != 9 && s != N_STEPS - 1; }
DI bool seam_local(int s) { return s == 5 || s == 6 || s == 7 || s == 8 || s == 10 || s == 12; }
DI void grid_bar(CArgs* ap, int wave0, bool local = false, int k = -1) {
    const Args a = phase_args(ap);
    extern __shared__ __attribute__((aligned(16))) unsigned char lds[];
    XcdBarrier b; b.bar = (unsigned*)(a.ws + WS_CTL) + CW_BAR; b.x = xb_xcc_id(); b.st = (volatile LAS unsigned*)((LAS unsigned char*)lds + MISC_OFF) + 8;
    xcd_barrier(b, wave0 == 0, lane_id(), local, k);
}
DI void gemm_step(int s, const Args& a, Frame& F, pg8::Gemm& g, pg8::USched& S, UEpi& E) {
    unsigned char* ws = a.ws;
    const volatile LAS int* tp = (const volatile LAS int*)(F.lds + XTAB_OFF);
    size_t oA = WS_A, oB = WS_W1T, oA2 = 0, oB2 = 0, bstride = 0; int K = 1024, M = T, N = 1024, mode = 0, id = E_PROJ;
    if (s == 1)       { N = INW; }
    else if (s == 2)  { oA = WS_MEMN; oB = WS_WKV; M = MROWS; N = 2048; id = E_KV; }
    else if (s == 5)  { oA = WS_YG; oB = WS_WGLU; K = 512; N = 512; id = E_GLU; }
    else if (s == 6)  { oA = WS_YP; oB = WS_WBRP; oA2 = WS_YS2; oB2 = WS_WBRS; K = 512; mode = 1; id = use_mfma(6) ? E_BR : E_BRN; }
    else if (s == 7)  { oA = WS_MG; oB = WS_WOUT; id = E_WOUT; }
    else if (s == 8)  { oB = WS_WQ; id = E_Q; }
    else if (s == 10) { oA = WS_Q; oB = WS_WO; id = E_WO; }
    else if (s == 12) { oB = WS_W13; bstride = (size_t)1024 * 1024; mode = 2; id = E_UP; }
    else              { oA = WS_HID; oB = WS_W2T; K = 512; bstride = (size_t)1024 * 512; mode = 3; id = E_DOWN; }
    g.pts = (PROBE_ON && s == PROBE_GEMMSTEP && F.bid == 0 && F.tid == 0) ? (unsigned long long*)(ws + 512 * 1024) : nullptr;
    g.A = (const bf16_t*)(ws + oA); g.Bt = (const bf16_t*)(ws + oB); g.K = K; g.A2 = (const bf16_t*)(ws + oA2); g.Bt2 = (const bf16_t*)(ws + oB2); g.bstride = bstride;
    S.mode = mode; S.split = (s == 2 && F.G >= 128) ? 1 : 0; S.tp = tp; S.ptok = (const int*)(ws + WS_PTOK); S.nN = 4; S.one_pm = 0; S.one_pn = 0;
    S.so.init(M, N, F.G, mode >= 2 ? F.vcu : F.bid);
    E.id = id; E.tp = tp; E.ws = ws; E.x = a.in[I_X]; E.out = a.out; E.glub = a.in[I_GLUB];
}
DI bool is_gemm_step(int s) { return ((GEMM_STEPS >> s) & 1) != 0; }

template <int S_>
DI void run_step(CArgs* ap, int wave0) {
    const Args a = phase_args(ap); Frame F = make_frame(a, wave0);
    constexpr int s = S_;
    if constexpr (((GEMM_STEPS >> S_) & 1) != 0) {
        if constexpr (S_ >= 12) moe_prefix(F);
        if constexpr (S_ == 13) w2_wait(F);
        pg8::Gemm g; pg8::USched S; UEpi E;
        gemm_step(s, a, F, g, S, E);
        if constexpr (((MFMA_MASK >> S_) & 1) != 0) {
            unsigned char* ws = a.ws; const volatile LAS int* tp = E.tp; LAS unsigned char* ring = F.lds + RING_OFF; (void)tp;
            if constexpr (S_ == 1)  pg8::gemm_phase<false>(ring, g, S, FProj{(bf16_t*)(ws + WS_ZW), (bf16_t*)(ws + WS_VS), (bf16_t*)(ws + WS_G)}, F.tid);
            if constexpr (S_ == 2)  { pg8::gemm_phase<false, true>(ring, g, S, FKV{(bf16_t*)(ws + WS_KC), (bf16_t*)(ws + WS_VRM)}, F.tid); late_ssm_tables(a, F); early_w13(a, F); }
            if constexpr (S_ == 5)  pg8::gemm_phase<false>(ring, g, S, FGlu{(const bf16_t*)(ws + WS_YG), a.in[I_GLUB], (bf16_t*)(ws + WS_YS2)}, F.tid);
            if constexpr (S_ == 6)  pg8::gemm_phase<false>(ring, g, S, FBr{(const bf16_t*)(ws + WS_G), (bf16_t*)(ws + WS_MG)}, F.tid);
            if constexpr (S_ == 7)  pg8::gemm_phase<false>(ring, g, S, FWout{(const float*)(ws + WS_RMSX), (bf16_t*)(ws + WS_A), (float*)(ws + WS_SSQ8)}, F.tid);
            if constexpr (S_ == 8) {
                for (int L0 = F.vcu; L0 < (T / 256) * XH; L0 += F.G) {
                    int L = L0;
                    if (F.G == 256) {
                        const int u = (F.vcu & 31) + 32 * (L0 >> 8), pmq = 16 * (F.vcu >> 5) + (u & 15), hq = u >> 4;
                        L = (((pmq >> 5) * 4 + hq) << 5) | (pmq & 31);
                    }
                    const int bh = L >> 5, tq = L & 31;
                    S.mode = 4; S.one_pm = (bh >> 2) * 32 + tq; S.one_pn = bh & 3;
                    pg8::gemm_phase<false>(ring, g, S, FStoreBf{(bf16_t*)(ws + WS_Q)}, F.tid);
                    attn_unit(F, L);
                }
                __syncthreads();
            }
            if constexpr (S_ == 10) pg8::gemm_phase<false>(ring, g, S, FWo{(bf16_t*)(ws + WS_A)}, F.tid);
            if constexpr (S_ == 12) { pg8::gemm_phase<true, true>(ring, g, S, FUp{tp, (const float*)(ws + WS_PSCALE), (bf16_t*)(ws + WS_HID)}, F.tid); late_w2(a, F); }
            if constexpr (S_ == 13) pg8::gemm_phase<false, true>(ring, g, S, FDown{(bf16_t*)(ws + WS_PKR)}, F.tid);
        } else pg8::ngemm_phase(F.lds + RING_OFF, g, S, E, F.tid);
    } else if constexpr (S_ == 0) p0_prologue(a, F);
    else if constexpr (S_ == 3) {
        const int first = (F.G >= 2 * BATCH * NSG) ? BATCH * NSG : 0, count = F.G - first;
        if (F.vcu >= first) { build_vf(F, first, count); p2_pool(F, first, count); late_w13(a, F, first, count); late_dense(a, F, first, count); }
        if (first == 0 || F.vcu < first) ssm_seq(F);
    }
    else if constexpr (S_ == 4) { }
    else if constexpr (S_ == 9) { }
    else if constexpr (S_ == 11) p9_router(a, F);
    else { moe_prefix(F); p12_final(a, F); }
}

__global__ void __launch_bounds__(NWAVES * 64, 2) mk_fwd(Args args) {
    extern __shared__ __attribute__((aligned(16))) unsigned char lds[];
    CArgs* ap = (CArgs*)__builtin_amdgcn_kernarg_segment_ptr();
    const int lo = args.ph_lo, hi = args.ph_hi;
    const int wave0 = __builtin_amdgcn_readfirstlane((int)threadIdx.x >> 6);
    {
        LAS unsigned char* l = (LAS unsigned char*)lds;
        for (int u = wave0 * 64 + lane_id(); u < (LDS_BYTES - LDSCTL_OFF) / 4; u += NWAVES * 64) ((LAS unsigned*)(l + LDSCTL_OFF))[u] = 0u;
        __syncthreads();
        if (!MK_PER_PHASE) (void)xcd_barrier_post((unsigned*)(args.ws + WS_CTL) + CW_BAR, (volatile LAS unsigned*)(l + MISC_OFF) + 8, wave0 == 0 && lane_id() == 0);
    }
#if PROBE_ON
#define STAMP(k) do { if (blockIdx.x == 0 && wave0 == 0 && lane_id() == 0) ((unsigned long long*)(args.ws + WS_TS))[k] = __builtin_amdgcn_s_memrealtime(); } while (0)
#else
#define STAMP(k) do { } while (0)
#endif
#define STEP(k) do { if (lo <= (k) && (k) < hi) { STAMP(k); if (PROBE_ON && (k) == 14) { asm volatile("s_waitcnt vmcnt(0)" ::: "memory"); grid_bar(ap, wave0); } run_step<k>(ap, wave0); if (!MK_PER_PHASE && (k) + 1 < hi && seam_after(k)) { if (PROBE_ON && (k) == PROBE_BARSTEP) { const unsigned long long _b0 = __builtin_amdgcn_s_memrealtime(); grid_bar(ap, wave0); if (wave0 == 0 && lane_id() == 0) ((unsigned long long*)(args.ws + WS_TS))[128 + blockIdx.x] = __builtin_amdgcn_s_memrealtime() - _b0; } else grid_bar(ap, wave0, seam_local(k), (k)); } } } while (0)
    STEP(0); STEP(1); STEP(2); STEP(3); STEP(4); STEP(5); STEP(6); STEP(7); STEP(8); STEP(9); STEP(10); STEP(11); STEP(12); STEP(13); STEP(14);
#undef STEP
}

extern "C" void kernel_launch(void* const* d_in, const int* in_sizes, int n_in, void* d_out, int out_size, void* d_ws, size_t ws_size, hipStream_t stream) {
    static int grid = 0;
    if (grid == 0) {
        if (n_in != 33 || in_sizes[0] != T * D || out_size != T * D || ws_size < WS_END) {
            fprintf(stderr, "kernel_launch: shape/workspace mismatch (n_in %d, in0 %d, out %d, ws %zu, need %zu); nothing launched\n", n_in, n_in > 0 ? in_sizes[0] : -1, out_size, ws_size, (size_t)WS_END); grid = -1; return; }
        int dev = 0, cus = 0, per_cu = 0;
        if (hipGetDevice(&dev) != hipSuccess || hipDeviceGetAttribute(&cus, hipDeviceAttributeMultiprocessorCount, dev) != hipSuccess) { fprintf(stderr, "kernel_launch: device query failed\n"); grid = -1; return; }
        if (hipFuncSetAttribute((const void*)mk_fwd, hipFuncAttributeMaxDynamicSharedMemorySize, LDS_BYTES) != hipSuccess) { fprintf(stderr, "kernel_launch: hipFuncSetAttribute failed\n"); grid = -1; return; }
        if (hipOccupancyMaxActiveBlocksPerMultiprocessor(&per_cu, (const void*)mk_fwd, NWAVES * 64, LDS_BYTES) != hipSuccess || per_cu < 1) {
            fprintf(stderr, "kernel_launch: occupancy query reports %d workgroups per CU; nothing launched\n", per_cu); (void)hipGetLastError(); grid = -1; return; }
        grid = cus;
    }
    if (grid < 0) return;
    if (hipMemsetAsync((char*)d_ws + WS_CTL, 0, CTL_ZERO_BYTES, stream) != hipSuccess) { fprintf(stderr, "kernel_launch: memset failed\n"); return; }
    Args a{};
    for (int i = 0; i < 33; ++i) a.in[i] = (const float*)d_in[i];
    a.out = (float*)d_out; a.ws = (unsigned char*)d_ws;
    const int cuts[] = {0, 1, 3, 4, 5, 6, 7, 8, 9, 10, 11, 12, 13, 14, 15};
    const int nl = MK_PER_PHASE ? 14 : 1;
    for (int li = 0; li < nl; ++li) {
        a.ph_lo = MK_PER_PHASE ? cuts[li] : 0; a.ph_hi = MK_PER_PHASE ? cuts[li + 1] : N_STEPS; a.li = li;
        hipLaunchKernelGGL(mk_fwd, dim3(grid), dim3(NWAVES * 64), LDS_BYTES, stream, a);
        const hipError_t le = hipPeekAtLastError();
        if (le != hipSuccess) { fprintf(stderr, "kernel_launch: launch %d failed: %s\n", li, hipGetErrorName(le)); break; }
    }
}
```
